# Optimizing an MI355X kernel written in HIP

```python
import math
import jax, jax.numpy as jnp
from jax import lax
import numpy as np

D_MODEL = 2048
BATCH = 16
SEQ = 256
DEPTH = 2
DEC_BATCH = 4
DEC_SEQ = 1024
PAST_LEN = 256

GRID_W = 64
D_MIX = D_MODEL
D_RWKV = D_MIX // 2
D_HYENA = D_MIX - D_RWKV
HEAD_DIM = 64
N_HEADS = D_RWKV // HEAD_DIM
LORA_W = 64
LORA_A = 64
LORA_G = 160
D_FF = 4 * D_MODEL
FILT_BANDS = 16
FILT_EMB = 1 + 2 * FILT_BANDS
FILT_HIDDEN = 64
HYENA_ORDER = 2
N_DIR = 2
N_CONV = 3 * D_RWKV + 3 * D_HYENA
D_IN = N_CONV + LORA_W + LORA_A + LORA_G
ALPHA = (2 * DEPTH) ** 0.25
BETA = (8 * DEPTH) ** -0.25
LN_EPS = 1e-5
GN_EPS = 64e-5
FILT_TARGET = 1e-2
FAST_DECAY_PCT = 0.3
SLOW_DECAY_PCT = 1.5
DECAY_SCALE = math.exp(-0.5)

kernel_name = "hybrid_rwkv7_hyena_diffusion_step"


def layer_norm(x, g=None, b=None, eps=LN_EPS):
    xf = x.astype(jnp.float32)
    mu = jnp.mean(xf, axis=-1, keepdims=True)
    var = jnp.mean(jnp.square(xf - mu), axis=-1, keepdims=True)
    y = (xf - mu) * lax.rsqrt(var + eps)
    if g is not None:
        y = y * g.astype(jnp.float32) + b.astype(jnp.float32)
    return y.astype(x.dtype)


def short_conv(u, w, on_grid):
    bsz, seq, ch = u.shape
    if on_grid:
        rows = seq // GRID_W
        y = lax.conv_general_dilated(
            u.reshape(bsz, rows, GRID_W, ch), w[:, :, None, :].astype(u.dtype),
            window_strides=(1, 1), padding='SAME',
            dimension_numbers=('NHWC', 'HWIO', 'NHWC'), feature_group_count=ch)
        return y.reshape(bsz, seq, ch)
    wr = w[1].astype(u.dtype)
    up = jnp.pad(u, ((0, 0), (1, 1), (0, 0)))
    return up[:, :-2] * wr[0] + up[:, 1:-1] * wr[1] + up[:, 2:] * wr[2]


def wkv_scan(s0, r, w, k, v, kk, iclr, reverse):
    b = kk * iclr

    def step(S, inp):
        r_t, w_t, k_t, v_t, kk_t, b_t = inp
        sa = jnp.einsum('bhvk,bhk->bhv', S, kk_t)
        S = S * w_t[:, :, None, :] - sa[..., None] * b_t[:, :, None, :] + v_t[..., None] * k_t[:, :, None, :]
        o_t = jnp.einsum('bhvk,bhk->bhv', S, r_t)
        return S, o_t

    xs = tuple(jnp.moveaxis(t, 1, 0) for t in (r, w, k, v, kk, b))
    S, o = lax.scan(step, s0, xs, reverse=reverse)
    return S, jnp.moveaxis(o, 0, 1)


def rwkv_mixer(r, k, v, xw, xa, xg, p, s0):
    bsz, seq, _ = r.shape

    def heads(t):
        return t.reshape(bsz, seq, N_HEADS, HEAD_DIM)

    kk = heads(k * p['k_k'].astype(jnp.float32))
    kk = kk * lax.rsqrt(jnp.sum(kk * kk, axis=-1, keepdims=True) + 1e-12)
    g = jax.nn.sigmoid(xg) @ p['g_up'].astype(jnp.float32)
    rh, vh = heads(r), heads(v)
    r_k = p['r_k'].astype(jnp.float32)
    outs, states, bonus = [], [], []
    for d in range(N_DIR):
        logw = -DECAY_SCALE * jax.nn.sigmoid(p['w0'][d].astype(jnp.float32) + jnp.tanh(xw) @ p['w_up'][d].astype(jnp.float32))
        iclr = jax.nn.sigmoid(p['a0'][d].astype(jnp.float32) + xa @ p['a_up'][d].astype(jnp.float32))
        kd = heads(k * (1.0 + (iclr - 1.0) * p['k_a'].astype(jnp.float32)))
        S, o = wkv_scan(s0[:, d].astype(jnp.float32), rh, heads(jnp.exp(logw)), kd, vh, kk, heads(iclr), reverse=(d == 1))
        outs.append(o)
        states.append(S)
        bonus.append(jnp.sum(rh * kd * r_k, axis=-1, keepdims=True) * vh)
    o = outs[0] + outs[1]
    mu = jnp.mean(o, axis=-1, keepdims=True)
    var = jnp.mean(jnp.square(o - mu), axis=-1, keepdims=True)
    o = ((o - mu) * lax.rsqrt(var + GN_EPS)).reshape(bsz, seq, D_RWKV)
    o = o * p['ln_g'].astype(jnp.float32) + p['ln_b'].astype(jnp.float32)
    o = (o + (bonus[0] + bonus[1]).reshape(bsz, seq, D_RWKV)) * g
    return o, jnp.stack(states, axis=1)


def hyena_filters(seq, p):
    t = jnp.linspace(0.0, 1.0, seq, dtype=jnp.float32)[:, None]
    w = (2.0 * math.pi / seq) * jnp.arange(seq, dtype=jnp.float32)[:, None]
    f = jnp.linspace(1e-4, FILT_BANDS - 1, FILT_BANDS, dtype=jnp.float32)[None, :]
    z = jnp.concatenate([t, jnp.cos(f * w), -jnp.sin(f * w)], axis=-1)
    freq = p['filt_freq'].astype(jnp.float32)
    h = jnp.sin(freq[0] * (z @ p['filt_w1'].astype(jnp.float32) + p['filt_b1'].astype(jnp.float32)))
    h = jnp.sin(freq[1] * (h @ p['filt_w2'].astype(jnp.float32) + p['filt_b2'].astype(jnp.float32)))
    h = (h @ p['filt_w3'].astype(jnp.float32)).reshape(seq, HYENA_ORDER, N_DIR, D_HYENA)
    max_decay = math.log(FILT_TARGET) / FAST_DECAY_PCT
    min_decay = math.log(FILT_TARGET) / SLOW_DECAY_PCT
    deltas = jnp.abs(jnp.linspace(min_decay, max_decay, D_HYENA, dtype=jnp.float32))
    h = h * jnp.exp(-t * deltas)[:, None, None, :]
    return h / jnp.sum(jnp.abs(h), axis=(0, 2), keepdims=True)


def fft_long_conv(u, h_f, h_b, bias):
    seq, ch = h_f.shape
    k2 = jnp.concatenate([h_f, jnp.zeros((1, ch), jnp.float32), h_b[1:][::-1]], axis=0)
    y = jnp.fft.irfft(jnp.fft.rfft(u, n=2 * seq, axis=1) * jnp.fft.rfft(k2, axis=0)[None], n=2 * seq, axis=1)[:, :seq]
    return y + u * bias


def hyena_mixer(v, x1, x2, p):
    h = hyena_filters(v.shape[1], p)
    bias = p['hyena_bias'].astype(jnp.float32)
    z = x1 * fft_long_conv(v, h[:, 0, 0], h[:, 0, 1], bias[0])
    return x2 * fft_long_conv(z, h[:, 1, 0], h[:, 1, 1], bias[1])


def trunk_layer(x, cond, p, s0, on_grid):
    mod = (jax.nn.silu(cond) @ p['w_ada'] + p['b_ada'])[:, None, :]
    sh1, sc1, g1, sh2, sc2, g2 = jnp.split(mod, 6, axis=-1)
    h = layer_norm(x) * (1.0 + sc1) + sh1
    proj = h @ p['w_in']
    cv = short_conv(proj[..., :N_CONV], p['conv_w'], on_grid).astype(jnp.float32)
    r = cv[..., 0:D_RWKV]
    k = cv[..., D_RWKV:2 * D_RWKV]
    v = cv[..., 2 * D_RWKV:3 * D_RWKV]
    o3 = 3 * D_RWKV
    hv = cv[..., o3:o3 + D_HYENA]
    hx1 = cv[..., o3 + D_HYENA:o3 + 2 * D_HYENA]
    hx2 = cv[..., o3 + 2 * D_HYENA:o3 + 3 * D_HYENA]
    lo = proj[..., N_CONV:].astype(jnp.float32)
    xw = lo[..., :LORA_W]
    xa = lo[..., LORA_W:LORA_W + LORA_A]
    xg = lo[..., LORA_W + LORA_A:]
    a_out, S = rwkv_mixer(r, k, v, xw, xa, xg, p, s0)
    b_out = hyena_mixer(hv, hx1, hx2, p)
    mix = jnp.concatenate([a_out, b_out], axis=-1).astype(x.dtype) @ p['w_out']
    x = layer_norm(ALPHA * x + g1 * mix, p['ln1_g'], p['ln1_b'])
    h = layer_norm(x) * (1.0 + sc2) + sh2
    ff = jnp.square(jax.nn.relu(h @ p['mlp_w1'])) @ p['mlp_w2']
    x = layer_norm(ALPHA * x + g2 * ff, p['ln2_g'], p['ln2_b'])
    return x, S


def setup_inputs(seed: int = 0) -> dict:
    key = jax.random.key(seed)
    ks = jax.random.split(key, 40)

    def nrm(i, shape, scale):
        return scale * jax.random.normal(ks[i], shape, jnp.float32)

    col_scale = jnp.ones((D_IN,), jnp.float32)
    col_scale = col_scale.at[2 * D_RWKV:3 * D_RWKV].set(BETA).at[3 * D_RWKV:3 * D_RWKV + D_HYENA].set(BETA)
    w_in = nrm(7, (DEPTH, D_MODEL, D_IN), D_MODEL ** -0.5) * col_scale
    conv_w = nrm(8, (DEPTH, 3, 3, N_CONV), 0.2).at[:, 1, 1, :].add(1.0)
    return {
        'x_prompt': nrm(0, (BATCH, SEQ, D_MODEL), 1.0),
        'x_sample': nrm(1, (DEC_BATCH, DEC_SEQ, D_MODEL), 1.0),
        'c': nrm(2, (DEC_BATCH, D_MODEL), 1.0),
        'state_rwkv': nrm(3, (DEC_BATCH, DEPTH, N_DIR, N_HEADS, HEAD_DIM, HEAD_DIM), 0.3),
        'c_ctx': nrm(4, (D_MODEL,), 1.0),
        'w_ada': nrm(5, (DEPTH, D_MODEL, 6 * D_MODEL), 0.5 * D_MODEL ** -0.5),
        'b_ada': nrm(6, (DEPTH, 6 * D_MODEL), 0.02),
        'w_in': w_in,
        'conv_w': conv_w,
        'lora_w_up': nrm(9, (DEPTH, N_DIR, LORA_W, D_RWKV), 0.1),
        'lora_w0': nrm(10, (DEPTH, N_DIR, D_RWKV), 1.0),
        'lora_a_up': nrm(11, (DEPTH, N_DIR, LORA_A, D_RWKV), 0.5 * LORA_A ** -0.5),
        'lora_a0': nrm(12, (DEPTH, N_DIR, D_RWKV), 0.5),
        'lora_g_up': nrm(13, (DEPTH, LORA_G, D_RWKV), LORA_G ** -0.5),
        'rwkv_k_k': 0.85 + nrm(14, (DEPTH, D_RWKV), 0.1),
        'rwkv_k_a': 1.0 + nrm(15, (DEPTH, D_RWKV), 0.1),
        'rwkv_r_k': nrm(16, (DEPTH, N_HEADS, HEAD_DIM), 0.1),
        'rwkv_ln_g': 1.0 + nrm(17, (DEPTH, D_RWKV), 0.1),
        'rwkv_ln_b': nrm(18, (DEPTH, D_RWKV), 0.02),
        'filt_w1': nrm(19, (DEPTH, FILT_EMB, FILT_HIDDEN), FILT_EMB ** -0.5),
        'filt_b1': nrm(20, (DEPTH, FILT_HIDDEN), 0.1),
        'filt_w2': nrm(21, (DEPTH, FILT_HIDDEN, FILT_HIDDEN), FILT_HIDDEN ** -0.5),
        'filt_b2': nrm(22, (DEPTH, FILT_HIDDEN), 0.1),
        'filt_w3': nrm(23, (DEPTH, FILT_HIDDEN, HYENA_ORDER * N_DIR * D_HYENA), FILT_HIDDEN ** -0.5),
        'filt_freq': 1.0 + nrm(24, (DEPTH, 2, FILT_HIDDEN), 0.1),
        'hyena_bias': nrm(25, (DEPTH, HYENA_ORDER, D_HYENA), 0.5),
        'w_out': nrm(26, (DEPTH, D_MIX, D_MODEL), BETA * D_MIX ** -0.5),
        'ln1_g': 1.0 + nrm(27, (DEPTH, D_MODEL), 0.1),
        'ln1_b': nrm(28, (DEPTH, D_MODEL), 0.02),
        'ln2_g': 1.0 + nrm(29, (DEPTH, D_MODEL), 0.1),
        'ln2_b': nrm(30, (DEPTH, D_MODEL), 0.02),
        'mlp_w1': nrm(31, (DEPTH, D_MODEL, D_FF), D_MODEL ** -0.5),
        'mlp_w2': nrm(32, (DEPTH, D_FF, D_MODEL), BETA * D_FF ** -0.5),
    }


def reference(x_prompt, x_sample, c, state_rwkv, c_ctx, w_ada, b_ada, w_in, conv_w,
              lora_w_up, lora_w0, lora_a_up, lora_a0, lora_g_up, rwkv_k_k, rwkv_k_a, rwkv_r_k,
              rwkv_ln_g, rwkv_ln_b, filt_w1, filt_b1, filt_w2, filt_b2, filt_w3, filt_freq,
              hyena_bias, w_out, ln1_g, ln1_b, ln2_g, ln2_b, mlp_w1, mlp_w2):
    xp, xs = x_prompt, x_sample
    n_ctx_req = x_prompt.shape[0]
    ctx_states = []
    for i in range(DEPTH):
        p = {
            'w_ada': w_ada[i], 'b_ada': b_ada[i], 'w_in': w_in[i], 'conv_w': conv_w[i],
            'w_up': lora_w_up[i], 'w0': lora_w0[i], 'a_up': lora_a_up[i], 'a0': lora_a0[i],
            'g_up': lora_g_up[i], 'k_k': rwkv_k_k[i], 'k_a': rwkv_k_a[i], 'r_k': rwkv_r_k[i],
            'ln_g': rwkv_ln_g[i], 'ln_b': rwkv_ln_b[i],
            'filt_w1': filt_w1[i], 'filt_b1': filt_b1[i], 'filt_w2': filt_w2[i], 'filt_b2': filt_b2[i],
            'filt_w3': filt_w3[i], 'filt_freq': filt_freq[i], 'hyena_bias': hyena_bias[i],
            'w_out': w_out[i], 'ln1_g': ln1_g[i], 'ln1_b': ln1_b[i], 'ln2_g': ln2_g[i], 'ln2_b': ln2_b[i],
            'mlp_w1': mlp_w1[i], 'mlp_w2': mlp_w2[i],
        }
        s_zero = jnp.zeros((n_ctx_req, N_DIR, N_HEADS, HEAD_DIM, HEAD_DIM), jnp.float32)
        xp, s_ctx = trunk_layer(xp, c_ctx[None, :], p, s_zero, on_grid=False)
        ctx_states.append(s_ctx)
        xs, _ = trunk_layer(xs, c, p, state_rwkv[:, i], on_grid=True)
    new_state_rwkv = jnp.stack(ctx_states, axis=1).astype(x_prompt.dtype)
    return (xp, xs, new_state_rwkv)
```

```cpp
#include <hip/hip_runtime.h>
#include <hip/hip_cooperative_groups.h>
#include <cstdio>
#include <cstdint>
namespace cg = cooperative_groups;

namespace pg8 {
#define PG8_LAS __attribute__((address_space(3)))
typedef unsigned short bf16_t;
typedef short bf16x8 __attribute__((ext_vector_type(8)));
typedef float f32x4 __attribute__((ext_vector_type(4)));
typedef unsigned u32x4 __attribute__((ext_vector_type(4)));
constexpr int BM = 256, BK = 64, HALF = 128, HTB = HALF * BK * 2  , STAGE_BYTES = 8 * HTB, NXCD = 8, WGM = 8;

__host__ __device__ __forceinline__ int lds_byte(int r, int c) { const int st = (r >> 4) * 2 + (c >> 5), rr = r & 15, cc = c & 31, ob = rr * 64 + cc * 2; return st * 1024 + (ob ^ (((ob >> 9) & 1) << 5)); }
__host__ __device__ __forceinline__ void stage_rc(int b, int& R, int& C) { const int st = b / 1024, sb = b % 1024, swz = sb ^ (((sb >> 9) & 1) << 5); R = (st >> 1) * 16 + swz / 64; C = (st & 1) * 32 + (swz % 64) / 2; }
__host__ __device__ __forceinline__ int perm32(int rho) { const int n = rho >> 4, i = rho & 15; return 8 * (i >> 2) + 4 * n + (i & 3); }

struct Unit { int pm, pn; };
struct Gemm { const bf16_t* A; const bf16_t* Bt; int M, N, K; };

struct StaticOrder {
    int nM, nN, nwg, G, c;
    __host__ __device__ void init(int M, int N, int G_, int c_) { nM = M / BM; nN = N / BM; nwg = nM * nN; G = G_; c = c_; }
    __host__ __device__ bool next(int i, Unit& u) const {
        const long L = (long)i * G + c; if (L >= nwg) return false;
        int wgid = (int)L; { const int q = nwg / NXCD, r = nwg % NXCD, xcd = wgid % NXCD, off = wgid / NXCD; wgid = (xcd < r ? xcd * (q + 1) : r * (q + 1) + (xcd - r) * q) + off; }
        const int nig = WGM * nN, gid = wgid / nig, fm = gid * WGM, gsz = (nM - fm) < WGM ? (nM - fm) : WGM;
        u.pm = fm + ((wgid % nig) % gsz); u.pn = (wgid % nig) / gsz; return true;
    }
    __device__ __forceinline__ void a_ready(const Unit&) const {}
    __device__ __forceinline__ void done(const Unit&) const {}
};

__device__ __forceinline__ unsigned cvt_pk_bf16(float lo, float hi) { unsigned r; asm volatile("v_cvt_pk_bf16_f32 %0, %1, %2" : "=v"(r) : "v"(lo), "v"(hi)); return r; }
typedef float f32x2 __attribute__((ext_vector_type(2)));

__device__ __forceinline__ float sigm(float x) { return 1.f / (1.f + __expf(-x)); }
struct EpiProj {
    static constexpr bool PERM = false, AFTER_DRAIN = false;
    float* proj; bf16_t* lact;
    __device__ __forceinline__ void operator()(const f32x4 (&acc)[2][2][4][2], const Unit& u, int wr, int wc, int fr, int fq) const {
        const int row0 = u.pm * BM + wr * 64 + fr, col0 = u.pn * BM + wc * 32 + 4 * fq;
        if (u.pn < 24) {
#pragma unroll
            for (int ai = 0; ai < 2; ++ai)
#pragma unroll
                for (int m = 0; m < 4; ++m) { float* rowp = proj + (size_t)(row0 + ai * HALF + m * 16) * 6144 + col0;
#pragma unroll
                    for (int bj = 0; bj < 2; ++bj)
#pragma unroll
                        for (int n = 0; n < 2; ++n) *(f32x4*)(rowp + bj * HALF + n * 16) = acc[ai][bj][m][n]; }
        } else {
#pragma unroll
            for (int ai = 0; ai < 2; ++ai)
#pragma unroll
                for (int m = 0; m < 4; ++m) { bf16_t* rowp = lact + (size_t)(row0 + ai * HALF + m * 16) * 384;
#pragma unroll
                    for (int bj = 0; bj < 2; ++bj)
#pragma unroll
                        for (int n = 0; n < 2; ++n) {
                            const int cl = col0 - 6144 + bj * HALF + n * 16;
                            if (cl < 384) {
                                f32x4 v = acc[ai][bj][m][n];
                                if (cl < 64) { v[0] = tanhf(v[0]); v[1] = tanhf(v[1]); v[2] = tanhf(v[2]); v[3] = tanhf(v[3]); }
                                else if (cl < 128) { }
                                else if (cl < 288) { v[0] = sigm(v[0]); v[1] = sigm(v[1]); v[2] = sigm(v[2]); v[3] = sigm(v[3]); }
                                else { v = (f32x4){0.f, 0.f, 0.f, 0.f}; }
                                uint2 w; w.x = cvt_pk_bf16(v[0], v[1]); w.y = cvt_pk_bf16(v[2], v[3]);
                                *(uint2*)(rowp + cl) = w;
                            }
                        } }
        }
    }
};
struct EpiLora {
    static constexpr bool PERM = false, AFTER_DRAIN = false;
    float* arr0; size_t arr_stride;
    const float* w0; const float* a0;
    __device__ __forceinline__ void operator()(const f32x4 (&acc)[2][2][4][2], const Unit& u, int wr, int wc, int fr, int fq) const {
        const int which = u.pn >> 2;
        const int row0 = u.pm * BM + wr * 64 + fr, col0 = (u.pn & 3) * BM + wc * 32 + 4 * fq;
        float* base = arr0 + (size_t)which * arr_stride;
        const float* bptr = which < 2 ? w0 + which * 1024 : a0 + ((which - 2) & 1) * 1024;
        const float bsc = which < 4 ? 1.f : 0.f;
#pragma unroll
        for (int ai = 0; ai < 2; ++ai)
#pragma unroll
            for (int m = 0; m < 4; ++m) { float* rowp = base + (size_t)(row0 + ai * HALF + m * 16) * 1024 + col0;
#pragma unroll
                for (int bj = 0; bj < 2; ++bj)
#pragma unroll
                    for (int n = 0; n < 2; ++n) {
                        const f32x4 bvv = *(const f32x4*)(bptr + col0 + bj * HALF + n * 16);
                        f32x4 v = acc[ai][bj][m][n] + bvv * bsc;
#pragma unroll
                        for (int e = 0; e < 4; ++e) { const float sg = sigm(v[e]); const float ex = __expf(-0.6065306597126334f * sg); v[e] = which < 2 ? ex : (which < 4 ? sg : v[e]); }
                        *(f32x4*)(rowp + bj * HALF + n * 16) = v;
                    } }
    }
};
struct EpiRes {
    static constexpr bool PERM = false, AFTER_DRAIN = false;
    float* X; const float* gate;
    float alpha;
    __device__ __forceinline__ void operator()(const f32x4 (&acc)[2][2][4][2], const Unit& u, int wr, int wc, int fr, int fq) const {
        const int row0 = u.pm * BM + wr * 64 + fr, col0 = u.pn * BM + wc * 32 + 4 * fq;
        const int bidx = u.pm < 16 ? 0 : 1 + ((u.pm - 16) >> 2);
        const float* gp = gate + (size_t)bidx * 12288 + col0;
        f32x4 gv[2][2];
#pragma unroll
        for (int bj = 0; bj < 2; ++bj)
#pragma unroll
            for (int n = 0; n < 2; ++n) gv[bj][n] = *(const f32x4*)(gp + bj * HALF + n * 16);
#pragma unroll
        for (int ai = 0; ai < 2; ++ai)
#pragma unroll
            for (int m = 0; m < 4; ++m) { float* rowp = X + (size_t)(row0 + ai * HALF + m * 16) * 2048 + col0;
#pragma unroll
                for (int bj = 0; bj < 2; ++bj)
#pragma unroll
                    for (int n = 0; n < 2; ++n) {
                        f32x4* p = (f32x4*)(rowp + bj * HALF + n * 16);
                        const f32x4 xv = *p;
                        *p = xv * alpha + gv[bj][n] * acc[ai][bj][m][n];
                    } }
    }
};
struct EpiRelu2 {
    static constexpr bool PERM = true, AFTER_DRAIN = false;
    bf16_t* O; int ldc;
    __device__ __forceinline__ void operator()(const f32x4 (&acc)[2][2][4][2], const Unit& u, int wr, int wc, int fr, int fq) const {
        const int row0 = u.pm * BM + wr * 64 + fr, col0 = u.pn * BM + wc * 32 + 8 * fq;
#pragma unroll
        for (int ai = 0; ai < 2; ++ai)
#pragma unroll
            for (int m = 0; m < 4; ++m) { bf16_t* rowp = O + (size_t)(row0 + ai * HALF + m * 16) * ldc + col0;
#pragma unroll
                for (int bj = 0; bj < 2; ++bj) { f32x4 v0 = acc[ai][bj][m][0], v1 = acc[ai][bj][m][1];
#pragma unroll
                    for (int e = 0; e < 4; ++e) { const float a = fmaxf(v0[e], 0.f), b = fmaxf(v1[e], 0.f); v0[e] = a * a; v1[e] = b * b; }
                    u32x4 w; w.x = cvt_pk_bf16(v0[0], v0[1]); w.y = cvt_pk_bf16(v0[2], v0[3]); w.z = cvt_pk_bf16(v1[0], v1[1]); w.w = cvt_pk_bf16(v1[2], v1[3]);
                    *(u32x4*)(rowp + bj * HALF) = w; } }
    }
};

template <class Epi, class Sched, bool ALIGN_EPI = false, bool SP2 = false>
__device__ __forceinline__ void gemm_phase(PG8_LAS unsigned char* lds, const Gemm g, const Sched& S, const Epi& E) {
    int tid = threadIdx.x; asm volatile("" : "+v"(tid)); const int wid = __builtin_amdgcn_readfirstlane(tid >> 6), lane = tid & 63, wr = wid >> 2, wc = wid & 3, fr = lane & 15, fq = lane >> 4;
    const int K = g.K, nt = K / BK;
    unsigned voffA[2], voffB[2];
#pragma unroll
    for (int i = 0; i < 2; ++i) { int R, C; stage_rc(tid * 16 + i * 8192, R, C); const int Rb = Epi::PERM ? ((R & ~31) + perm32(R & 31)) : R;
        voffA[i] = (unsigned)(R * K + C) * 2u; voffB[i] = (unsigned)(Rb * K + C) * 2u; }
    const size_t kstep = (size_t)(BK * 2);
    const size_t hstep = (size_t)HALF * K * 2;
    const size_t tstep = 2 * hstep;
    const unsigned ldsw = (unsigned)wid * 1024u;
    const int aoff = lds_byte(wr * 64 + fr, fq * 8), boff = lds_byte(wc * 32 + fr, fq * 8);
#define PG8_SA(b, h) (((b) * 2 + (h)) * HTB)
#define PG8_SB(b, h) ((4 + (b) * 2 + (h)) * HTB)
#define PG8_STAGE(bufoff, gbase, voff) do { _Pragma("unroll") for (int _i = 0; _i < 2; ++_i) \
        __builtin_amdgcn_global_load_lds((const unsigned*)((const char*)(gbase) + (voff)[_i]), (PG8_LAS unsigned*)(lds + (bufoff) + ldsw + _i * 8192), 16, 0, 0); } while (0)
#define PG8_LDA(dst, b, h) do { _Pragma("unroll") for (int m = 0; m < 4; ++m) _Pragma("unroll") for (int k = 0; k < 2; ++k) dst[m][k] = *(const PG8_LAS bf16x8*)(lds + PG8_SA(b, h) + aoff + m * 2048 + k * 1024); } while (0)
#define PG8_LDB(dst, b, h) do { _Pragma("unroll") for (int n = 0; n < 2; ++n) _Pragma("unroll") for (int k = 0; k < 2; ++k) dst[n][k] = *(const PG8_LAS bf16x8*)(lds + PG8_SB(b, h) + boff + n * 2048 + k * 1024); } while (0)
#define PG8_MMA(ai, bj, At, Bt) do { __builtin_amdgcn_s_setprio(1); _Pragma("unroll") for (int m = 0; m < 4; ++m) _Pragma("unroll") for (int n = 0; n < 2; ++n) _Pragma("unroll") for (int k = 0; k < 2; ++k) \
        acc[ai][bj][m][n] = __builtin_amdgcn_mfma_f32_16x16x32_bf16(Bt[n][k], At[m][k], acc[ai][bj][m][n], 0, 0, 0); __builtin_amdgcn_s_setprio(0); } while (0)
#define PG8_WAIT_V(n) asm volatile("s_waitcnt vmcnt(" #n ")" ::: "memory")
#define PG8_WAIT_L(n) asm volatile("s_waitcnt lgkmcnt(" #n ")" ::: "memory")
#define PG8_BAR __builtin_amdgcn_s_barrier()
#define PG8_SCHED __builtin_amdgcn_sched_barrier(0)
    Unit cur, nxt; int ui = 0;
    if (!S.next(0, cur)) return;
    f32x4 acc[2][2][4][2];
#pragma unroll
    for (int a = 0; a < 2; ++a)
#pragma unroll
        for (int b = 0; b < 2; ++b)
#pragma unroll
            for (int m = 0; m < 4; ++m)
#pragma unroll
                for (int n = 0; n < 2; ++n) acc[a][b][m][n] = (f32x4){0.f, 0.f, 0.f, 0.f};
    bf16x8 At[4][2], B0[2][2], B1[2][2];
    const char* cA = (const char*)g.A + (size_t)cur.pm * tstep; const char* cB = (const char*)g.Bt + (size_t)cur.pn * tstep;
    S.a_ready(cur);
    if constexpr (SP2) {
        PG8_STAGE(PG8_SB(0, 0), cB, voffB); PG8_STAGE(PG8_SB(0, 1), cB + hstep, voffB); PG8_STAGE(PG8_SA(0, 0), cA, voffA); PG8_STAGE(PG8_SA(0, 1), cA + hstep, voffA);
        if (wr == 1) PG8_BAR;
        PG8_WAIT_V(2); PG8_BAR;
        PG8_STAGE(PG8_SB(1, 0), cB + kstep, voffB); PG8_STAGE(PG8_SA(1, 0), cA + kstep, voffA); PG8_STAGE(PG8_SB(1, 1), cB + hstep + kstep, voffB);
        PG8_WAIT_V(6); PG8_BAR;
    } else {
        PG8_STAGE(PG8_SB(0, 0), cB, voffB); PG8_STAGE(PG8_SA(0, 0), cA, voffA); PG8_STAGE(PG8_SB(0, 1), cB + hstep, voffB); PG8_STAGE(PG8_SA(0, 1), cA + hstep, voffA);
        if (wr == 1) PG8_BAR;
        PG8_WAIT_V(4); PG8_BAR;
        PG8_STAGE(PG8_SB(1, 0), cB + kstep, voffB); PG8_STAGE(PG8_SA(1, 0), cA + kstep, voffA); PG8_STAGE(PG8_SB(1, 1), cB + hstep + kstep, voffB);
        PG8_WAIT_V(6); PG8_BAR;
    }
    for (;;) {
        const bool has_next = S.next(ui + 1, nxt);
        const char* nA = has_next ? (const char*)g.A + (size_t)nxt.pm * tstep : cA; const char* nB = has_next ? (const char*)g.Bt + (size_t)nxt.pn * tstep : cB;
        for (int t = 0; t < nt; t += 2) {
            const bool last = (t == nt - 2);
            const char* a1 = cA + (size_t)(t + 1) * kstep;
            const char* a2 = last ? nA : cA + (size_t)(t + 2) * kstep; const char* b2 = last ? nB : cB + (size_t)(t + 2) * kstep;
            const char* a3 = a2 + kstep; const char* b3 = b2 + kstep;
            if (last && has_next) S.a_ready(nxt);
            if constexpr (SP2) {
            PG8_LDB(B0, 0, 0); PG8_LDB(B1, 0, 1); PG8_SCHED; PG8_LDA(At, 0, 0); PG8_STAGE(PG8_SA(1, 1), a1 + hstep, voffA);
            PG8_WAIT_V(8); PG8_WAIT_L(0); PG8_BAR; PG8_MMA(0, 0, At, B0); PG8_MMA(0, 1, At, B1); PG8_BAR; PG8_SCHED;
            PG8_LDA(At, 0, 1); PG8_STAGE(PG8_SB(0, 0), b2, voffB); PG8_STAGE(PG8_SB(0, 1), b2 + hstep, voffB); PG8_STAGE(PG8_SA(0, 0), a2, voffA);
            PG8_WAIT_V(8); PG8_WAIT_L(0); PG8_BAR; PG8_MMA(1, 0, At, B0); PG8_MMA(1, 1, At, B1); PG8_BAR; PG8_SCHED;
            PG8_LDB(B0, 1, 0); PG8_LDB(B1, 1, 1); PG8_SCHED; PG8_LDA(At, 1, 0); PG8_STAGE(PG8_SA(0, 1), a2 + hstep, voffA);
            PG8_WAIT_V(8); PG8_WAIT_L(0); PG8_BAR; PG8_MMA(0, 0, At, B0); PG8_MMA(0, 1, At, B1); PG8_BAR; PG8_SCHED;
            PG8_LDA(At, 1, 1); PG8_STAGE(PG8_SB(1, 0), b3, voffB); PG8_STAGE(PG8_SB(1, 1), b3 + hstep, voffB); PG8_STAGE(PG8_SA(1, 0), a3, voffA);
            PG8_WAIT_V(8); PG8_WAIT_L(0); PG8_BAR; PG8_MMA(1, 0, At, B0); PG8_MMA(1, 1, At, B1); PG8_BAR; PG8_SCHED;
            } else {
            PG8_LDB(B0, 0, 0); PG8_SCHED; PG8_LDA(At, 0, 0); PG8_STAGE(PG8_SA(1, 1), a1 + hstep, voffA);
            PG8_WAIT_L(8); PG8_BAR; PG8_WAIT_L(0); PG8_MMA(0, 0, At, B0); PG8_BAR; PG8_SCHED;
            PG8_LDB(B1, 0, 1); PG8_STAGE(PG8_SB(0, 0), b2, voffB);
            PG8_BAR; PG8_WAIT_L(0); PG8_MMA(0, 1, At, B1); PG8_BAR;
            PG8_LDA(At, 0, 1); PG8_STAGE(PG8_SA(0, 0), a2, voffA);
            PG8_BAR; PG8_WAIT_L(0); PG8_MMA(1, 0, At, B0); PG8_BAR; PG8_SCHED;
            PG8_STAGE(PG8_SB(0, 1), b2 + hstep, voffB);
            PG8_WAIT_V(6); PG8_BAR; PG8_MMA(1, 1, At, B1); PG8_BAR;
            PG8_LDB(B0, 1, 0); PG8_SCHED; PG8_LDA(At, 1, 0); PG8_STAGE(PG8_SA(0, 1), a2 + hstep, voffA);
            PG8_WAIT_L(8); PG8_BAR; PG8_WAIT_L(0); PG8_MMA(0, 0, At, B0); PG8_BAR; PG8_SCHED;
            PG8_LDB(B1, 1, 1); PG8_STAGE(PG8_SB(1, 0), b3, voffB);
            PG8_BAR; PG8_WAIT_L(0); PG8_MMA(0, 1, At, B1); PG8_BAR;
            PG8_LDA(At, 1, 1); PG8_STAGE(PG8_SA(1, 0), a3, voffA);
            PG8_BAR; PG8_WAIT_L(0); PG8_MMA(1, 0, At, B0); PG8_BAR; PG8_SCHED;
            PG8_STAGE(PG8_SB(1, 1), b3 + hstep, voffB);
            PG8_WAIT_V(6); PG8_BAR; PG8_MMA(1, 1, At, B1); PG8_BAR;
            }
        }
        if constexpr (ALIGN_EPI) { if (wr == 0) PG8_BAR; }
        if constexpr (!Epi::AFTER_DRAIN) { int fr2 = fr, fq2 = fq; asm volatile("" : "+v"(fr2), "+v"(fq2)); E(acc, cur, wr, wc, fr2, fq2); S.done(cur); }
        if (!has_next) break;
#pragma unroll
        for (int a = 0; a < 2; ++a)
#pragma unroll
            for (int b = 0; b < 2; ++b)
#pragma unroll
                for (int m = 0; m < 4; ++m)
#pragma unroll
                    for (int n = 0; n < 2; ++n) acc[a][b][m][n] = (f32x4){0.f, 0.f, 0.f, 0.f};
        cur = nxt; cA = nA; cB = nB; ++ui;
        if constexpr (ALIGN_EPI) { if (wr == 1) PG8_BAR; }
    }
    PG8_WAIT_V(0);
    if constexpr (!ALIGN_EPI) { if (wr == 0) PG8_BAR; }
    PG8_BAR;
    if constexpr (Epi::AFTER_DRAIN) { E.fused(acc, cur, wr, wc, fr, fq, lds, wid, lane); S.done(cur); }
#undef PG8_SA
#undef PG8_SB
#undef PG8_STAGE
#undef PG8_LDA
#undef PG8_LDB
#undef PG8_MMA
#undef PG8_WAIT_V
#undef PG8_WAIT_L
#undef PG8_BAR
#undef PG8_SCHED
}
}

using f4 = pg8::f32x4;
typedef unsigned short bf16_t;
constexpr int NT = 512;
constexpr int M = 8192, D = 2048, DR = 1024, NPAD = 6656, DFF = 8192, KL = 384, NL = 5120;
constexpr int DEPTH = 2;
constexpr float ALPHA = 1.4142135623730951f;
constexpr float LN_EPS = 1e-5f, GN_EPS = 64e-5f;
constexpr int LDS_BYTES = 147456;

constexpr size_t al256(size_t x) { return (x + 255) & ~(size_t)255; }
constexpr size_t FILT_CTX_PER = (size_t)2 * 1024 * 528, FILT_LAT_PER = (size_t)2 * 1024 * 2064;
constexpr size_t WS_MOD = 4096;
constexpr size_t WS_FH2 = al256(WS_MOD + (size_t)2 * 5 * 12288 * 4);
constexpr size_t WS_FILT = al256(WS_FH2 + (size_t)2 * 1280 * 64 * 4);
constexpr size_t WS_WIN = al256(WS_FILT + 2 * (FILT_CTX_PER + FILT_LAT_PER) * 4);
constexpr size_t WS_WOUT = WS_WIN + (size_t)NPAD * D * 2;
constexpr size_t WS_W1 = WS_WOUT + (size_t)D * D * 2;
constexpr size_t WS_W2 = WS_W1 + (size_t)DFF * D * 2;
constexpr size_t WS_WL = WS_W2 + (size_t)D * DFF * 2;
constexpr size_t WS_H = WS_WL + (size_t)NL * KL * 2;
constexpr size_t WS_MIX = WS_H + (size_t)M * D * 2;
constexpr size_t WS_LACT = WS_MIX + (size_t)M * D * 2;
constexpr size_t WS_PROJ = WS_LACT + (size_t)M * KL * 2;
constexpr size_t WS_RW = WS_PROJ + (size_t)M * 6144 * 4;
constexpr size_t WS_HT = WS_RW + (size_t)9 * M * 1024 * 4;
constexpr size_t WS_END = WS_HT + (size_t)3 * 1024 * M * 2;
static_assert(WS_END <= (size_t)805306368, "workspace map too large");
constexpr size_t AS = (size_t)M * 1024;
constexpr size_t OUT_STATE = (size_t)16777216;

__device__ __forceinline__ int tid_l() { int t = threadIdx.x; asm volatile("" : "+v"(t)); return t; }
struct Params { const float* in[33]; float* out; unsigned char* ws; int ph_lo, ph_hi; };
typedef const __attribute__((address_space(4))) Params CParams;

__device__ __forceinline__ float wave_sum(float v) {
#pragma unroll
    for (int o = 1; o < 64; o <<= 1) v += __shfl_xor(v, o);
    return v;
}
__device__ __forceinline__ unsigned pk2(float lo, float hi) { return pg8::cvt_pk_bf16(lo, hi); }
__device__ __forceinline__ bf16_t f2bf(float f) { unsigned u = __float_as_uint(f); u += 0x7FFFu + ((u >> 16) & 1u); return (bf16_t)(u >> 16); }
__device__ __forceinline__ float bf2f(unsigned short b) { return __uint_as_float(((unsigned)b) << 16); }
__device__ __forceinline__ float sigmf(float x) { return 1.f / (1.f + __expf(-x)); }

__device__ __forceinline__ void ph_mod(CParams& P, float* lds) {
    const int tid = tid_l();
    float* scond = lds;
    float* red = lds + 5 * 2048;
    const float* c = P.in[2]; const float* cctx = P.in[4];
    for (int i = tid; i < 5 * 2048; i += NT) { const int b = i >> 11, k = i & 2047; const float x = b == 0 ? cctx[k] : c[(b - 1) * 2048 + k]; scond[i] = x / (1.f + __expf(-x)); }
    __syncthreads();
    const float* w_ada = P.in[5]; const float* b_ada = P.in[6];
    float* mod = (float*)(P.ws + WS_MOD);
    const int kg = tid >> 5, c4 = tid & 31;
    for (int item = blockIdx.x; item < 192; item += gridDim.x) {
        const int l = item / 96, c0 = (item % 96) * 128;
        f4 acc[5];
#pragma unroll
        for (int b = 0; b < 5; ++b) acc[b] = (f4){0.f, 0.f, 0.f, 0.f};
        const float* wp = w_ada + ((size_t)l * 2048 + kg * 128) * 12288 + c0 + c4 * 4;
        const float* sc = scond + kg * 128;
#pragma unroll 8
        for (int k = 0; k < 128; ++k) {
            const f4 w = *(const f4*)(wp + (size_t)k * 12288);
#pragma unroll
            for (int b = 0; b < 5; ++b) acc[b] += w * sc[b * 2048 + k];
        }
#pragma unroll
        for (int b = 0; b < 5; ++b) *(f4*)(red + (kg * 5 + b) * 128 + c4 * 4) = acc[b];
        __syncthreads();
        for (int idx = tid; idx < 640; idx += NT) {
            const int b = idx >> 7, cc = idx & 127; float s = 0.f;
#pragma unroll
            for (int g = 0; g < 16; ++g) s += red[(g * 5 + b) * 128 + cc];
            mod[(size_t)(l * 5 + b) * 12288 + c0 + cc] = s + b_ada[(size_t)l * 12288 + c0 + cc];
        }
        __syncthreads();
    }
}

__device__ __forceinline__ void ph_filt_hidden(CParams& P) {
    const int lane = tid_l() & 63, wave = tid_l() >> 6;
    const int gw = blockIdx.x * 8 + wave, ngw = gridDim.x * 8;
    float* fh2 = (float*)(P.ws + WS_FH2);
    for (int it = gw; it < 2 * 1280; it += ngw) {
        const int l = it / 1280, q = it % 1280;
        const int seq = q < 256 ? 256 : 1024, p = q < 256 ? q : q - 256;
        const float t = (float)p / (float)(seq - 1);
        const float wang = (float)(6.283185307179586 / (double)seq) * (float)p;
        float z = 0.f;
        if (lane == 0) z = t;
        else if (lane <= 32) {
            const int fi = (lane - 1) & 15; const float st = (float)fi / 15.f; const float f = 1e-4f * (1.f - st) + 15.f * st;
            z = lane <= 16 ? cosf(f * wang) : -sinf(f * wang);
        }
        const float* w1 = P.in[19] + (size_t)l * 33 * 64; const float* b1 = P.in[20] + l * 64;
        const float* w2 = P.in[21] + (size_t)l * 64 * 64; const float* b2 = P.in[22] + l * 64;
        const float* fr = P.in[24] + l * 128;
        float a = b1[lane];
        for (int i = 0; i < 33; ++i) a += __shfl(z, i) * w1[i * 64 + lane];
        const float h1 = sinf(fr[lane] * a);
        float a2 = b2[lane];
        for (int i = 0; i < 64; ++i) a2 += __shfl(h1, i) * w2[i * 64 + lane];
        const float h2 = sinf(fr[64 + lane] * a2);
        fh2[((size_t)l * 1280 + q) * 64 + lane] = h2;
    }
}

__device__ __forceinline__ void transpose_item(const float* W, int K, int N, bf16_t* WT, float* scr, int item, int lane) {
    const int nblk = N / 32, kb = item / nblk, nb = item % nblk, k0 = 64 * kb, n0 = 32 * nb;
#pragma unroll 8
    for (int i = 0; i < 32; ++i) { const int kk = 2 * i + (lane >> 5); scr[kk * 33 + (lane & 31)] = W[(size_t)(k0 + kk) * N + n0 + (lane & 31)]; }
    asm volatile("s_waitcnt lgkmcnt(0)" ::: "memory");
    const int c = lane & 7;
#pragma unroll
    for (int j = 0; j < 4; ++j) { const int n = (lane >> 3) + 8 * j; const float* s = scr + (8 * c) * 33 + n;
        uint4 o; o.x = pk2(s[0 * 33], s[1 * 33]); o.y = pk2(s[2 * 33], s[3 * 33]); o.z = pk2(s[4 * 33], s[5 * 33]); o.w = pk2(s[6 * 33], s[7 * 33]);
        *(uint4*)(WT + (size_t)(n0 + n) * K + k0 + 8 * c) = o; }
    asm volatile("s_waitcnt lgkmcnt(0)" ::: "memory");
}
__device__ __forceinline__ void ph_convert(CParams& P, int l, float* lds) {
    const int lane = tid_l() & 63, wave = tid_l() >> 6;
    const int gw = blockIdx.x * 8 + wave, ngw = gridDim.x * 8;
    float* scr = lds + wave * (64 * 33);
    constexpr int I_IN = 32 * 201, I_OUT = 32 * 64, I_1 = 32 * 256, I_2 = 128 * 64;
    const float* w_in = P.in[7] + (size_t)l * 2048 * 6432; const float* w_out = P.in[26] + (size_t)l * 2048 * 2048;
    const float* w1 = P.in[31] + (size_t)l * 2048 * 8192; const float* w2 = P.in[32] + (size_t)l * 8192 * 2048;
    bf16_t* WIN = (bf16_t*)(P.ws + WS_WIN); bf16_t* WOUT = (bf16_t*)(P.ws + WS_WOUT); bf16_t* W1 = (bf16_t*)(P.ws + WS_W1); bf16_t* W2 = (bf16_t*)(P.ws + WS_W2);
    for (int it = gw; it < I_IN + I_OUT + I_1 + I_2; it += ngw) {
        int r = it;
        if (r < I_IN) { transpose_item(w_in, 2048, 6432, WIN, scr, r, lane); continue; } r -= I_IN;
        if (r < I_OUT) { transpose_item(w_out, 2048, 2048, WOUT, scr, r, lane); continue; } r -= I_OUT;
        if (r < I_1) { transpose_item(w1, 2048, 8192, W1, scr, r, lane); continue; } r -= I_1;
        transpose_item(w2, 8192, 2048, W2, scr, r, lane);
    }
    { uint4* z = (uint4*)(WIN + (size_t)6432 * 2048); const int n16 = 224 * 2048 * 2 / 16;
      for (int i = blockIdx.x * NT + tid_l(); i < n16; i += gridDim.x * NT) z[i] = make_uint4(0, 0, 0, 0); }
    { bf16_t* WL = (bf16_t*)(P.ws + WS_WL);
      const float* wup = P.in[9] + (size_t)l * 2 * 64 * 1024; const float* aup = P.in[11] + (size_t)l * 2 * 64 * 1024; const float* gup = P.in[13] + (size_t)l * 160 * 1024;
      for (int i = blockIdx.x * NT + tid_l(); i < NL * KL; i += gridDim.x * NT) {
          const int n = i / KL, k = i % KL; const int which = n >> 10, c = n & 1023; float v = 0.f;
          if (which < 2) { if (k < 64) v = wup[((size_t)which * 64 + k) * 1024 + c]; }
          else if (which < 4) { if (k >= 64 && k < 128) v = aup[((size_t)(which - 2) * 64 + (k - 64)) * 1024 + c]; }
          else { if (k >= 128 && k < 288) v = gup[(size_t)(k - 128) * 1024 + c]; }
          WL[i] = f2bf(v);
      } }
}

__device__ __forceinline__ void row_pass(const float* src, float* dstX, const float* ag, const float* ab, const float* msh, const float* msc, bf16_t* hrow, int lane) {
    f4 v[8]; float s = 0.f;
#pragma unroll
    for (int j = 0; j < 8; ++j) { v[j] = *(const f4*)(src + j * 256 + lane * 4); s += (v[j][0] + v[j][1]) + (v[j][2] + v[j][3]); }
    if (ag) {
        const float mean = wave_sum(s) * (1.f / 2048.f); float s2 = 0.f;
#pragma unroll
        for (int j = 0; j < 8; ++j) { v[j] = v[j] - mean; s2 += (v[j][0] * v[j][0] + v[j][1] * v[j][1]) + (v[j][2] * v[j][2] + v[j][3] * v[j][3]); }
        const float rstd = rsqrtf(wave_sum(s2) * (1.f / 2048.f) + LN_EPS);
        s = 0.f;
#pragma unroll
        for (int j = 0; j < 8; ++j) { const f4 g = *(const f4*)(ag + j * 256 + lane * 4), b = *(const f4*)(ab + j * 256 + lane * 4);
            v[j] = v[j] * rstd * g + b; s += (v[j][0] + v[j][1]) + (v[j][2] + v[j][3]); }
    }
#pragma unroll
    for (int j = 0; j < 8; ++j) *(f4*)(dstX + j * 256 + lane * 4) = v[j];
    if (msh) {
        const float mean = wave_sum(s) * (1.f / 2048.f); float s2 = 0.f;
#pragma unroll
        for (int j = 0; j < 8; ++j) { v[j] = v[j] - mean; s2 += (v[j][0] * v[j][0] + v[j][1] * v[j][1]) + (v[j][2] * v[j][2] + v[j][3] * v[j][3]); }
        const float rstd = rsqrtf(wave_sum(s2) * (1.f / 2048.f) + LN_EPS);
#pragma unroll
        for (int j = 0; j < 8; ++j) { const f4 sh = *(const f4*)(msh + j * 256 + lane * 4), sc = *(const f4*)(msc + j * 256 + lane * 4);
            const f4 h = v[j] * rstd * (sc + 1.f) + sh;
            uint2 w; w.x = pk2(h[0], h[1]); w.y = pk2(h[2], h[3]);
            *(uint2*)(hrow + j * 256 + lane * 4) = w; }
    }
}
__device__ __forceinline__ void ph_rowpass(CParams& P, int mode, int l) {
    const int lane = tid_l() & 63, wave = tid_l() >> 6;
    const int gw = blockIdx.x * 8 + wave, ngw = gridDim.x * 8;
    const float* mod = (const float*)(P.ws + WS_MOD);
    bf16_t* H = (bf16_t*)(P.ws + WS_H);
    for (int m = gw; m < M; m += ngw) {
        const int bidx = m < 4096 ? 0 : 1 + ((m - 4096) >> 10);
        const float* src; const float* ag = nullptr; const float* ab = nullptr; const float* msh = nullptr; const float* msc = nullptr;
        float* dst = P.out + (size_t)m * 2048;
        if (mode == 0) { src = m < 4096 ? P.in[0] + (size_t)m * 2048 : P.in[1] + (size_t)(m - 4096) * 2048;
            msh = mod + (size_t)(0 * 5 + bidx) * 12288; msc = msh + 2048; }
        else if (mode == 1) { src = dst; ag = P.in[27] + l * 2048; ab = P.in[28] + l * 2048;
            msh = mod + (size_t)(l * 5 + bidx) * 12288 + 3 * 2048; msc = msh + 2048; }
        else { src = dst; ag = P.in[29] + l * 2048; ab = P.in[30] + l * 2048;
            if (l + 1 < DEPTH) { msh = mod + (size_t)((l + 1) * 5 + bidx) * 12288; msc = msh + 2048; } }
        row_pass(src, dst, ag, ab, msh, msc, H + (size_t)m * 2048, lane);
    }
}

__device__ __forceinline__ void ph_filt_final(CParams& P, float* lds) {
    const int tid = tid_l(); const int cl = tid & 31, ps = tid >> 5;
    float* red = lds;
    for (int item = blockIdx.x; item < 256; item += gridDim.x) {
        const int cgp = item & 31, o = (item >> 5) & 1, ss = (item >> 6) & 1, l = item >> 7;
        const int L = ss ? 1024 : 256, GL = 2 * L + 16;
        const int c = cgp * 32 + cl;
        const float* h2 = (const float*)(P.ws + WS_FH2) + ((size_t)l * 1280 + (ss ? 256 : 0)) * 64;
        const float* w3 = P.in[23] + (size_t)l * 64 * 4096;
        float wf[64], wb[64];
#pragma unroll
        for (int j = 0; j < 64; ++j) { wf[j] = w3[(size_t)j * 4096 + (o * 2 + 0) * 1024 + c]; wb[j] = w3[(size_t)j * 4096 + (o * 2 + 1) * 1024 + c]; }
        const float st = (float)c / 1023.f;
        const float delta = fabsf(-3.0701134573253943f * (1.f - st) + -15.350567286626972f * st);
        float* gg = (float*)(P.ws + WS_FILT) + (size_t)l * (FILT_CTX_PER + FILT_LAT_PER) + (ss ? FILT_CTX_PER : 0) + ((size_t)o * 1024 + c) * GL;
        const float bias = P.in[25][(l * 2 + o) * 1024 + c];
        float asum = 0.f;
        for (int p = ps; p < L; p += 16) {
            const float* hp = h2 + (size_t)p * 64;
            float af = 0.f, ab = 0.f;
#pragma unroll
            for (int j4 = 0; j4 < 16; ++j4) { const f4 hv = *(const f4*)(hp + j4 * 4);
#pragma unroll
                for (int e = 0; e < 4; ++e) { af += hv[e] * wf[j4 * 4 + e]; ab += hv[e] * wb[j4 * 4 + e]; } }
            const float t = (float)p / (float)(L - 1);
            const float dec = expf(-t * delta);
            af *= dec; ab *= dec;
            asum += fabsf(af) + fabsf(ab);
            gg[p + L + 7] = af;
            if (p > 0) gg[L + 7 - p] = ab;
        }
        if (ps == 0) { for (int x = 0; x < 8; ++x) gg[x] = 0.f; for (int x = 2 * L + 7; x < GL; ++x) gg[x] = 0.f; }
        red[ps * 32 + cl] = asum;
        __syncthreads();
        float tot = 0.f;
#pragma unroll
        for (int g = 0; g < 16; ++g) tot += red[g * 32 + cl];
        const float inv = 1.f / tot;
        __syncthreads();
        for (int p = ps; p < L; p += 16) {
            float a = gg[p + L + 7] * inv; if (p == 0) a += bias; gg[p + L + 7] = a;
            if (p > 0) gg[L + 7 - p] *= inv;
        }
    }
}

__device__ __forceinline__ void ph_convprep(CParams& P, int l, float* lds) {
    const int tid = tid_l(), lane = tid & 63, wave = tid >> 6;
    float* tile = lds;
    const float* proj = (const float*)(P.ws + WS_PROJ);
    float* RW = (float*)(P.ws + WS_RW);
    bf16_t* HT = (bf16_t*)(P.ws + WS_HT);
    const float* cw = P.in[8] + (size_t)l * 9 * 6144;
    const float* k_k = P.in[14] + l * 1024;
    for (int item = blockIdx.x; item < 128 * 96; item += gridDim.x) {
        const int ct = item % 96, tt = item / 96;
        const int m0 = tt * 64; const int c = ct * 64 + lane;
        const bool lat = m0 >= 4096;
        float wgt[9];
#pragma unroll
        for (int q = 0; q < 9; ++q) wgt[q] = cw[q * 6144 + c];
        for (int i = 0; i < 8; ++i) {
            const int tl = wave * 8 + i; const int m = m0 + tl;
            const float* pc = proj + (size_t)m * 6144 + c;
            float y;
            if (!lat) { const int p = m & 255;
                y = pc[0] * wgt[4]; if (p > 0) y += pc[-6144] * wgt[3]; if (p < 255) y += pc[6144] * wgt[5]; }
            else { const int p = (m - 4096) & 1023; const int row = p >> 6, col = p & 63;
                y = 0.f;
#pragma unroll
                for (int dy = -1; dy <= 1; ++dy) { const int rr = row + dy; if (rr < 0 || rr > 15) continue;
#pragma unroll
                    for (int dx = -1; dx <= 1; ++dx) { const int cc = col + dx; if (cc < 0 || cc > 63) continue;
                        y += pc[(dy * 64 + dx) * 6144] * wgt[(dy + 1) * 3 + dx + 1]; } } }
            if (ct < 48) {
                const int arr = ct >> 4; const int cc = (ct & 15) * 64 + lane;
                RW[(size_t)arr * AS + (size_t)m * 1024 + cc] = y;
                if (arr == 1) { const float kr = y * k_k[cc]; const float ssq = wave_sum(kr * kr); RW[(size_t)3 * AS + (size_t)m * 1024 + cc] = kr * rsqrtf(ssq + 1e-12f); }
            } else tile[lane * 65 + tl] = y;
        }
        if (ct >= 48) {
            __syncthreads();
            const int which = (ct - 48) >> 4; const int cbase = ((ct - 48) & 15) * 64;
            for (int i = 0; i < 8; ++i) { const int ch = wave * 8 + i; HT[((size_t)which * 1024 + cbase + ch) * M + m0 + lane] = f2bf(tile[ch * 65 + lane]); }
            __syncthreads();
        }
    }
}

__device__ __forceinline__ void scan_item(CParams& P, int l, float* lds, int type, int b, int h) {
    const int tid = tid_l(); const int d = tid >> 8, ht = tid & 255, w4 = ht >> 6, lane = tid & 63;
    const int row = w4 * 16 + (lane >> 2), kc = lane & 3;
    const int L = type ? 256 : 1024; const int mbase = type ? b * 256 : 4096 + b * 1024;
    float* hb = lds + d * (7 * 1024);
    float *sR = hb, *sKD = hb + 1024, *sV = hb + 2048, *sKK = hb + 3072, *sW = hb + 4096, *sBB = hb + 5120, *sO = hb + 6144;
    f4 S[4];
    if (type == 0) { const float* s0 = P.in[3] + ((((size_t)b * 2 + l) * 2 + d) * 16 + h) * 4096 + row * 64 + kc * 16;
#pragma unroll
        for (int i = 0; i < 4; ++i) S[i] = *(const f4*)(s0 + i * 4); }
    else {
#pragma unroll
        for (int i = 0; i < 4; ++i) S[i] = (f4){0.f, 0.f, 0.f, 0.f}; }
    const float* RW = (const float*)(P.ws + WS_RW);
    const float *gR = RW, *gK = RW + AS, *gV = RW + 2 * AS, *gKK = RW + 3 * AS, *gW = RW + (4 + d) * AS, *gA = RW + (6 + d) * AS;
    float* gO = (float*)(P.ws + WS_PROJ) + (size_t)d * AS;
    const int tl_s = ht >> 4, j4 = (ht & 15) * 4;
    const f4 ka4 = *(const f4*)(P.in[15] + l * 1024 + h * 64 + j4);
    for (int ch = 0; ch < L / 16; ++ch) {
        const int i = ch * 16 + tl_s; const int p = d ? L - 1 - i : i; const size_t off = (size_t)(mbase + p) * 1024 + h * 64 + j4;
        { const f4 r4 = *(const f4*)(gR + off), k4 = *(const f4*)(gK + off), v4 = *(const f4*)(gV + off), kk4 = *(const f4*)(gKK + off), w4v = *(const f4*)(gW + off), a4 = *(const f4*)(gA + off);
          const f4 kd = k4 * ((a4 - 1.f) * ka4 + 1.f); const f4 bb = kk4 * a4;
          const int so = tl_s * 64 + j4;
          *(f4*)(sR + so) = r4; *(f4*)(sKD + so) = kd; *(f4*)(sV + so) = v4; *(f4*)(sKK + so) = kk4; *(f4*)(sW + so) = w4v; *(f4*)(sBB + so) = bb; }
        __syncthreads();
        for (int tl = 0; tl < 16; ++tl) {
            const int qo = tl * 64 + kc * 16;
            float sa = 0.f;
#pragma unroll
            for (int q = 0; q < 4; ++q) { const f4 kk = *(const f4*)(sKK + qo + q * 4); sa += (S[q][0] * kk[0] + S[q][1] * kk[1]) + (S[q][2] * kk[2] + S[q][3] * kk[3]); }
            sa += __shfl_xor(sa, 1); sa += __shfl_xor(sa, 2);
            const float vrow = sV[tl * 64 + row];
            float o = 0.f;
#pragma unroll
            for (int q = 0; q < 4; ++q) {
                const f4 w = *(const f4*)(sW + qo + q * 4), bb = *(const f4*)(sBB + qo + q * 4), kd = *(const f4*)(sKD + qo + q * 4), r = *(const f4*)(sR + qo + q * 4);
                S[q] = S[q] * w - bb * sa + kd * vrow;
                o += (S[q][0] * r[0] + S[q][1] * r[1]) + (S[q][2] * r[2] + S[q][3] * r[3]);
            }
            o += __shfl_xor(o, 1); o += __shfl_xor(o, 2);
            if (kc == 0) sO[tl * 64 + row] = o;
        }
        __syncthreads();
        *(f4*)(gO + off) = *(const f4*)(sO + tl_s * 64 + j4);
    }
    if (type == 1) { float* so = P.out + OUT_STATE + ((((size_t)b * 2 + l) * 2 + d) * 16 + h) * 4096 + row * 64 + kc * 16;
#pragma unroll
        for (int i = 0; i < 4; ++i) *(f4*)(so + i * 4) = S[i]; }
    __syncthreads();
}

template <int L>
__device__ __forceinline__ void hy_conv(const float* sU, const float* sG, int t0, float (&y)[8]) {
#pragma unroll
    for (int i = 0; i < 8; ++i) y[i] = 0.f;
    for (int s0 = 0; s0 < L; s0 += 8) {
        const f4 u0 = *(const f4*)(sU + s0), u1 = *(const f4*)(sU + s0 + 4);
        const float* gp = sG + (t0 - s0 + L);
        const f4 g0 = *(const f4*)(gp), g1 = *(const f4*)(gp + 4), g2 = *(const f4*)(gp + 8), g3 = *(const f4*)(gp + 12);
        const float u[8] = {u0[0], u0[1], u0[2], u0[3], u1[0], u1[1], u1[2], u1[3]};
        const float g[16] = {g0[0], g0[1], g0[2], g0[3], g1[0], g1[1], g1[2], g1[3], g2[0], g2[1], g2[2], g2[3], g3[0], g3[1], g3[2], g3[3]};
#pragma unroll
        for (int i = 0; i < 8; ++i)
#pragma unroll
            for (int j = 0; j < 8; ++j) y[i] += g[7 + i - j] * u[j];
    }
}
template <int L>
__device__ __forceinline__ void hyena_item(CParams& P, int l, float* lds, int b, int cgp) {
    constexpr int TT = L / 8, CG = NT / TT, GL = 2 * L + 16;
    const int tid = tid_l(); const int ch = tid / TT, tt = tid % TT, t0 = tt * 8;
    const int c = cgp * CG + ch;
    const int mbase = (L == 256) ? b * 256 : 4096 + b * 1024;
    float* sU = lds; float* sZ = lds + 4096; float* sG1 = lds + 8192; float* sG2 = sG1 + CG * GL;
    const bf16_t* HT = (const bf16_t*)(P.ws + WS_HT);
    const float* filt = (const float*)(P.ws + WS_FILT) + (size_t)l * (FILT_CTX_PER + FILT_LAT_PER) + ((L == 1024) ? FILT_CTX_PER : 0);
    for (int idx = tid; idx < CG * L; idx += NT) { const int cc = idx / L, t = idx % L; sU[idx] = bf2f(HT[((size_t)0 * 1024 + cgp * CG + cc) * M + mbase + t]); }
    { const float* g1 = filt + ((size_t)0 * 1024 + cgp * CG) * GL; const float* g2 = filt + ((size_t)1 * 1024 + cgp * CG) * GL;
      for (int idx = tid; idx < CG * GL; idx += NT) { sG1[idx] = g1[idx]; sG2[idx] = g2[idx]; } }
    __syncthreads();
    float y[8];
    hy_conv<L>(sU + ch * L, sG1 + ch * GL, t0, y);
    { const uint4 xv = *(const uint4*)(HT + ((size_t)1 * 1024 + c) * M + mbase + t0);
      const unsigned xs[4] = {xv.x, xv.y, xv.z, xv.w};
#pragma unroll
      for (int i = 0; i < 4; ++i) { sZ[ch * L + t0 + 2 * i] = y[2 * i] * __uint_as_float(xs[i] << 16); sZ[ch * L + t0 + 2 * i + 1] = y[2 * i + 1] * __uint_as_float(xs[i] & 0xffff0000u); } }
    __syncthreads();
    hy_conv<L>(sZ + ch * L, sG2 + ch * GL, t0, y);
    { const uint4 xv = *(const uint4*)(HT + ((size_t)2 * 1024 + c) * M + mbase + t0);
      const unsigned xs[4] = {xv.x, xv.y, xv.z, xv.w};
      bf16_t* mix = (bf16_t*)(P.ws + WS_MIX) + (size_t)(mbase + t0) * 2048 + 1024 + c;
#pragma unroll
      for (int i = 0; i < 4; ++i) { mix[(size_t)(2 * i) * 2048] = f2bf(y[2 * i] * __uint_as_float(xs[i] << 16)); mix[(size_t)(2 * i + 1) * 2048] = f2bf(y[2 * i + 1] * __uint_as_float(xs[i] & 0xffff0000u)); } }
    __syncthreads();
}

__device__ __forceinline__ void ph_scan_hyena(CParams& P, int l, float* lds) {
    const int G = gridDim.x; constexpr int total = 64 + 256 + 1024 + 1024;
    for (int r = 0; r * G < total; ++r) {
        const int pos = (r & 1) ? G - 1 - (int)blockIdx.x : (int)blockIdx.x; const int j = r * G + pos;
        if (j >= total) continue;
        if (j < 64) scan_item(P, l, lds, 0, j >> 4, j & 15);
        else if (j < 320) scan_item(P, l, lds, 1, (j - 64) >> 4, (j - 64) & 15);
        else if (j < 1344) hyena_item<1024>(P, l, lds, (j - 320) >> 8, (j - 320) & 255);
        else hyena_item<256>(P, l, lds, (j - 1344) >> 6, (j - 1344) & 63);
    }
}

__device__ __forceinline__ void ph_combine(CParams& P, int l) {
    const int lane = tid_l() & 63, wave = tid_l() >> 6;
    const int gw = blockIdx.x * 8 + wave, ngw = gridDim.x * 8;
    const float* RW = (const float*)(P.ws + WS_RW);
    const float* O = (const float*)(P.ws + WS_PROJ);
    bf16_t* mix = (bf16_t*)(P.ws + WS_MIX);
    for (int it = gw; it < M * 16; it += ngw) {
        const int m = it >> 4, h = it & 15; const int cc = h * 64 + lane; const size_t idx = (size_t)m * 1024 + cc;
        const float o = O[idx] + O[AS + idx];
        const float mu = wave_sum(o) * (1.f / 64.f); const float dv = o - mu; const float var = wave_sum(dv * dv) * (1.f / 64.f);
        const float yn = dv * rsqrtf(var + GN_EPS) * P.in[17][l * 1024 + cc] + P.in[18][l * 1024 + cc];
        const float r = RW[idx], k = RW[AS + idx], v = RW[2 * AS + idx], a0 = RW[6 * AS + idx], a1 = RW[7 * AS + idx], g = RW[8 * AS + idx];
        const float ka = P.in[15][l * 1024 + cc], rk = P.in[16][l * 1024 + cc];
        const float kd0 = k * (1.f + (a0 - 1.f) * ka), kd1 = k * (1.f + (a1 - 1.f) * ka);
        const float sb = wave_sum(r * (kd0 + kd1) * rk);
        mix[(size_t)m * 2048 + cc] = f2bf((yn + sb * v) * g);
    }
}

constexpr int NPH = 2 + 9 * DEPTH;
#ifndef PHM
#define PHM 1023
#endif
__global__ void __launch_bounds__(NT, 2) mega(Params Pv) {
    extern __shared__ __attribute__((aligned(16))) unsigned char lds_raw[];
    cg::grid_group grid = cg::this_grid();
    float* ldsf = (float*)lds_raw;
    PG8_LAS unsigned char* ldsg = (PG8_LAS unsigned char*)lds_raw;
    const int G = gridDim.x, bid = blockIdx.x;
    const int ph_lo = Pv.ph_lo, ph_hi = Pv.ph_hi;
    for (int ph = ph_lo; ph < ph_hi; ++ph) {
        CParams* kp = (CParams*)__builtin_amdgcn_kernarg_segment_ptr(); asm volatile("" : "+s"(kp));
        CParams& P = *kp;
        if (ph == 0 && (PHM & 1)) { ph_mod(P, ldsf); ph_filt_hidden(P); __syncthreads(); ph_convert(P, 0, ldsf); }
        else if (ph == 1 && (PHM & 2)) { ph_rowpass(P, 0, 0); ph_filt_final(P, ldsf); }
        else {
            const int l = (ph - 2) / 9, s = (ph - 2) % 9;
            const float* mod = (const float*)(P.ws + WS_MOD);
            if (s == 0 && (PHM & 4)) {
                pg8::Gemm g{(const bf16_t*)(P.ws + WS_H), (const bf16_t*)(P.ws + WS_WIN), M, NPAD, D}; pg8::StaticOrder S; S.init(M, NPAD, G, bid);
                pg8::EpiProj E{(float*)(P.ws + WS_PROJ), (bf16_t*)(P.ws + WS_LACT)};
                pg8::gemm_phase<pg8::EpiProj, pg8::StaticOrder, true, true>(ldsg, g, S, E);
            } else if (s == 1 && (PHM & 8)) {
                pg8::Gemm g{(const bf16_t*)(P.ws + WS_LACT), (const bf16_t*)(P.ws + WS_WL), M, NL, KL}; pg8::StaticOrder S; S.init(M, NL, G, bid);
                pg8::EpiLora E{(float*)(P.ws + WS_RW) + 4 * AS, AS, P.in[10] + l * 2048, P.in[12] + l * 2048};
                pg8::gemm_phase<pg8::EpiLora, pg8::StaticOrder, true, true>(ldsg, g, S, E);
                __syncthreads();
                ph_convprep(P, l, ldsf);
            } else if (s == 2 && (PHM & 16)) { ph_scan_hyena(P, l, ldsf); }
            else if (s == 3 && (PHM & 32)) { ph_combine(P, l); }
            else if ((s == 4 || s == 7) && (PHM & 64)) {
                pg8::Gemm g{(const bf16_t*)(P.ws + (s == 4 ? WS_MIX : WS_PROJ)), (const bf16_t*)(P.ws + (s == 4 ? WS_WOUT : WS_W2)), M, D, s == 4 ? D : DFF}; pg8::StaticOrder S; S.init(M, D, G, bid);
                pg8::EpiRes E{P.out, mod + (size_t)l * 5 * 12288 + (s == 4 ? 2 : 5) * 2048, ALPHA};
                pg8::gemm_phase<pg8::EpiRes, pg8::StaticOrder, true, true>(ldsg, g, S, E);
            } else if (s == 5 && (PHM & 128)) { ph_rowpass(P, 1, l); }
            else if (s == 6 && (PHM & 256)) {
                pg8::Gemm g{(const bf16_t*)(P.ws + WS_H), (const bf16_t*)(P.ws + WS_W1), M, DFF, D}; pg8::StaticOrder S; S.init(M, DFF, G, bid);
                pg8::EpiRelu2 E{(bf16_t*)(P.ws + WS_PROJ), DFF};
                pg8::gemm_phase<pg8::EpiRelu2, pg8::StaticOrder, true, true>(ldsg, g, S, E);
            } else if (PHM & 512) { ph_rowpass(P, 2, l); if (l + 1 < DEPTH) ph_convert(P, l + 1, ldsf); }
        }
        if (ph + 1 < ph_hi) grid.sync();
    }
}

#ifndef MK_MULTI
#define MK_MULTI 0
#endif
extern "C" void kernel_launch(void* const* d_in, const int* in_sizes, int n_in, void* d_out, int out_size, void* d_ws, size_t ws_size, hipStream_t stream) {
    static int grid = 0;
    if (grid == 0) {
        int dev = 0, cus = 0, per_cu = 0;
        if (n_in != 33 || ws_size < WS_END) { fprintf(stderr, "kernel_launch: unexpected n_in %d or ws_size %zu (< %zu)\n", n_in, ws_size, (size_t)WS_END); grid = -1; return; }
        hipGetDevice(&dev);
        hipDeviceGetAttribute(&cus, hipDeviceAttributeMultiprocessorCount, dev);
        if (hipFuncSetAttribute((const void*)mega, hipFuncAttributeMaxDynamicSharedMemorySize, LDS_BYTES) != hipSuccess) { fprintf(stderr, "hipFuncSetAttribute failed\n"); grid = -1; return; }
        if (hipOccupancyMaxActiveBlocksPerMultiprocessor(&per_cu, (const void*)mega, NT, LDS_BYTES) != hipSuccess || per_cu < 1) { fprintf(stderr, "occupancy query failed (%d)\n", per_cu); grid = -1; return; }
        grid = cus;
    }
    if (grid < 0) return;
    Params p{};
    for (int i = 0; i < 33; ++i) p.in[i] = (const float*)d_in[i];
    p.out = (float*)d_out; p.ws = (unsigned char*)d_ws;
#if MK_MULTI
    for (int ph = 0; ph < NPH; ++ph) { p.ph_lo = ph; p.ph_hi = ph + 1; hipLaunchKernelGGL(mega, dim3(grid), dim3(NT), LDS_BYTES, stream, p); }
#else
    p.ph_lo = 0; p.ph_hi = NPH;
    void* args[] = {&p};
    hipError_t e = hipLaunchCooperativeKernel((const void*)mega, dim3(grid), dim3(NT), args, LDS_BYTES, stream);
    if (e != hipSuccess) fprintf(stderr, "cooperative launch failed: %s (grid %d)\n", hipGetErrorString(e), grid);
#endif
}
```

```cpp
#include <hip/hip_runtime.h>
#include <hip/hip_cooperative_groups.h>
#include <cstdio>
#include <cstdint>
namespace cg = cooperative_groups;

namespace pg8 {
#define PG8_LAS __attribute__((address_space(3)))
typedef unsigned short bf16_t;
typedef short bf16x8 __attribute__((ext_vector_type(8)));
typedef float f32x4 __attribute__((ext_vector_type(4)));
typedef unsigned u32x4 __attribute__((ext_vector_type(4)));
constexpr int BM = 256, BK = 64, HALF = 128, HTB = HALF * BK * 2  , STAGE_BYTES = 8 * HTB, NXCD = 8, WGM = 8;

__host__ __device__ __forceinline__ int lds_byte(int r, int c) { const int st = (r >> 4) * 2 + (c >> 5), rr = r & 15, cc = c & 31, ob = rr * 64 + cc * 2; return st * 1024 + (ob ^ (((ob >> 9) & 1) << 5)); }
__host__ __device__ __forceinline__ void stage_rc(int b, int& R, int& C) { const int st = b / 1024, sb = b % 1024, swz = sb ^ (((sb >> 9) & 1) << 5); R = (st >> 1) * 16 + swz / 64; C = (st & 1) * 32 + (swz % 64) / 2; }
__host__ __device__ __forceinline__ int perm32(int rho) { const int n = rho >> 4, i = rho & 15; return 8 * (i >> 2) + 4 * n + (i & 3); }

struct Unit { int pm, pn; };
struct Gemm { const bf16_t* A; const bf16_t* Bt; int M, N, K; };

struct StaticOrder {
    int nM, nN, nwg, G, c;
    __host__ __device__ void init(int M, int N, int G_, int c_) { nM = M / BM; nN = N / BM; nwg = nM * nN; G = G_; c = c_; }
    __host__ __device__ bool next(int i, Unit& u) const {
        const long L = (long)i * G + c; if (L >= nwg) return false;
        int wgid = (int)L; { const int q = nwg / NXCD, r = nwg % NXCD, xcd = wgid % NXCD, off = wgid / NXCD; wgid = (xcd < r ? xcd * (q + 1) : r * (q + 1) + (xcd - r) * q) + off; }
        const int nig = WGM * nN, gid = wgid / nig, fm = gid * WGM, gsz = (nM - fm) < WGM ? (nM - fm) : WGM;
        u.pm = fm + ((wgid % nig) % gsz); u.pn = (wgid % nig) / gsz; return true;
    }
    __device__ __forceinline__ void a_ready(const Unit&) const {}
    __device__ __forceinline__ void done(const Unit&) const {}
};

__device__ __forceinline__ unsigned cvt_pk_bf16(float lo, float hi) { unsigned r; asm volatile("v_cvt_pk_bf16_f32 %0, %1, %2" : "=v"(r) : "v"(lo), "v"(hi)); return r; }
typedef float f32x2 __attribute__((ext_vector_type(2)));

__device__ __forceinline__ float sigm(float x) { return 1.f / (1.f + __expf(-x)); }
struct EpiProj {
    static constexpr bool PERM = false, AFTER_DRAIN = false;
    float* proj; bf16_t* lact;
    __device__ __forceinline__ void operator()(const f32x4 (&acc)[2][2][4][2], const Unit& u, int wr, int wc, int fr, int fq) const {
        const int row0 = u.pm * BM + wr * 64 + fr, col0 = u.pn * BM + wc * 32 + 4 * fq;
        if (u.pn < 24) {
#pragma unroll
            for (int ai = 0; ai < 2; ++ai)
#pragma unroll
                for (int m = 0; m < 4; ++m) { float* rowp = proj + (size_t)(row0 + ai * HALF + m * 16) * 6144 + col0;
#pragma unroll
                    for (int bj = 0; bj < 2; ++bj)
#pragma unroll
                        for (int n = 0; n < 2; ++n) *(f32x4*)(rowp + bj * HALF + n * 16) = acc[ai][bj][m][n]; }
        } else {
#pragma unroll
            for (int ai = 0; ai < 2; ++ai)
#pragma unroll
                for (int m = 0; m < 4; ++m) { bf16_t* rowp = lact + (size_t)(row0 + ai * HALF + m * 16) * 384;
#pragma unroll
                    for (int bj = 0; bj < 2; ++bj)
#pragma unroll
                        for (int n = 0; n < 2; ++n) {
                            const int cl = col0 - 6144 + bj * HALF + n * 16;
                            if (cl < 384) {
                                f32x4 v = acc[ai][bj][m][n];
                                if (cl < 64) { v[0] = tanhf(v[0]); v[1] = tanhf(v[1]); v[2] = tanhf(v[2]); v[3] = tanhf(v[3]); }
                                else if (cl < 128) { }
                                else if (cl < 288) { v[0] = sigm(v[0]); v[1] = sigm(v[1]); v[2] = sigm(v[2]); v[3] = sigm(v[3]); }
                                else { v = (f32x4){0.f, 0.f, 0.f, 0.f}; }
                                uint2 w; w.x = cvt_pk_bf16(v[0], v[1]); w.y = cvt_pk_bf16(v[2], v[3]);
                                *(uint2*)(rowp + cl) = w;
                            }
                        } }
        }
    }
};
struct EpiLora {
    static constexpr bool PERM = false, AFTER_DRAIN = false;
    float* arr0; size_t arr_stride;
    const float* w0; const float* a0;
    __device__ __forceinline__ void operator()(const f32x4 (&acc)[2][2][4][2], const Unit& u, int wr, int wc, int fr, int fq) const {
        const int which = u.pn >> 2;
        const int row0 = u.pm * BM + wr * 64 + fr, col0 = (u.pn & 3) * BM + wc * 32 + 4 * fq;
        float* base = arr0 + (size_t)which * arr_stride;
        const float* bptr = which < 2 ? w0 + which * 1024 : a0 + ((which - 2) & 1) * 1024;
        const float bsc = which < 4 ? 1.f : 0.f;
#pragma unroll
        for (int ai = 0; ai < 2; ++ai)
#pragma unroll
            for (int m = 0; m < 4; ++m) { float* rowp = base + (size_t)(row0 + ai * HALF + m * 16) * 1024 + col0;
#pragma unroll
                for (int bj = 0; bj < 2; ++bj)
#pragma unroll
                    for (int n = 0; n < 2; ++n) {
                        const f32x4 bvv = *(const f32x4*)(bptr + col0 + bj * HALF + n * 16);
                        f32x4 v = acc[ai][bj][m][n] + bvv * bsc;
#pragma unroll
                        for (int e = 0; e < 4; ++e) { const float sg = sigm(v[e]); const float ex = __expf(-0.6065306597126334f * sg); v[e] = which < 2 ? ex : (which < 4 ? sg : v[e]); }
                        *(f32x4*)(rowp + bj * HALF + n * 16) = v;
                    } }
    }
};
struct EpiRes {
    static constexpr bool PERM = false, AFTER_DRAIN = false;
    float* X; const float* gate;
    float alpha;
    __device__ __forceinline__ void operator()(const f32x4 (&acc)[2][2][4][2], const Unit& u, int wr, int wc, int fr, int fq) const {
        const int row0 = u.pm * BM + wr * 64 + fr, col0 = u.pn * BM + wc * 32 + 4 * fq;
        const int bidx = u.pm < 16 ? 0 : 1 + ((u.pm - 16) >> 2);
        const float* gp = gate + (size_t)bidx * 12288 + col0;
        f32x4 gv[2][2];
#pragma unroll
        for (int bj = 0; bj < 2; ++bj)
#pragma unroll
            for (int n = 0; n < 2; ++n) gv[bj][n] = *(const f32x4*)(gp + bj * HALF + n * 16);
#pragma unroll
        for (int ai = 0; ai < 2; ++ai)
#pragma unroll
            for (int m = 0; m < 4; ++m) { float* rowp = X + (size_t)(row0 + ai * HALF + m * 16) * 2048 + col0;
#pragma unroll
                for (int bj = 0; bj < 2; ++bj)
#pragma unroll
                    for (int n = 0; n < 2; ++n) {
                        f32x4* p = (f32x4*)(rowp + bj * HALF + n * 16);
                        const f32x4 xv = *p;
                        *p = xv * alpha + gv[bj][n] * acc[ai][bj][m][n];
                    } }
    }
};
struct EpiRelu2 {
    static constexpr bool PERM = true, AFTER_DRAIN = false;
    bf16_t* O; int ldc;
    __device__ __forceinline__ void operator()(const f32x4 (&acc)[2][2][4][2], const Unit& u, int wr, int wc, int fr, int fq) const {
        const int row0 = u.pm * BM + wr * 64 + fr, col0 = u.pn * BM + wc * 32 + 8 * fq;
#pragma unroll
        for (int ai = 0; ai < 2; ++ai)
#pragma unroll
            for (int m = 0; m < 4; ++m) { bf16_t* rowp = O + (size_t)(row0 + ai * HALF + m * 16) * ldc + col0;
#pragma unroll
                for (int bj = 0; bj < 2; ++bj) { f32x4 v0 = acc[ai][bj][m][0], v1 = acc[ai][bj][m][1];
#pragma unroll
                    for (int e = 0; e < 4; ++e) { const float a = fmaxf(v0[e], 0.f), b = fmaxf(v1[e], 0.f); v0[e] = a * a; v1[e] = b * b; }
                    u32x4 w; w.x = cvt_pk_bf16(v0[0], v0[1]); w.y = cvt_pk_bf16(v0[2], v0[3]); w.z = cvt_pk_bf16(v1[0], v1[1]); w.w = cvt_pk_bf16(v1[2], v1[3]);
                    *(u32x4*)(rowp + bj * HALF) = w; } }
    }
};

template <class Epi, class Sched, bool ALIGN_EPI = false, bool SP2 = false>
__device__ __forceinline__ void gemm_phase(PG8_LAS unsigned char* lds, const Gemm g, const Sched& S, const Epi& E) {
    int tid = threadIdx.x; asm volatile("" : "+v"(tid)); const int wid = __builtin_amdgcn_readfirstlane(tid >> 6), lane = tid & 63, wr = wid >> 2, wc = wid & 3, fr = lane & 15, fq = lane >> 4;
    const int K = g.K, nt = K / BK;
    unsigned voffA[2], voffB[2];
#pragma unroll
    for (int i = 0; i < 2; ++i) { int R, C; stage_rc(tid * 16 + i * 8192, R, C); const int Rb = Epi::PERM ? ((R & ~31) + perm32(R & 31)) : R;
        voffA[i] = (unsigned)(R * K + C) * 2u; voffB[i] = (unsigned)(Rb * K + C) * 2u; }
    const size_t kstep = (size_t)(BK * 2);
    const size_t hstep = (size_t)HALF * K * 2;
    const size_t tstep = 2 * hstep;
    const unsigned ldsw = (unsigned)wid * 1024u;
    const int aoff = lds_byte(wr * 64 + fr, fq * 8), boff = lds_byte(wc * 32 + fr, fq * 8);
#define PG8_SA(b, h) (((b) * 2 + (h)) * HTB)
#define PG8_SB(b, h) ((4 + (b) * 2 + (h)) * HTB)
#define PG8_STAGE(bufoff, gbase, voff) do { _Pragma("unroll") for (int _i = 0; _i < 2; ++_i) \
        __builtin_amdgcn_global_load_lds((const unsigned*)((const char*)(gbase) + (voff)[_i]), (PG8_LAS unsigned*)(lds + (bufoff) + ldsw + _i * 8192), 16, 0, 0); } while (0)
#define PG8_LDA(dst, b, h) do { _Pragma("unroll") for (int m = 0; m < 4; ++m) _Pragma("unroll") for (int k = 0; k < 2; ++k) dst[m][k] = *(const PG8_LAS bf16x8*)(lds + PG8_SA(b, h) + aoff + m * 2048 + k * 1024); } while (0)
#define PG8_LDB(dst, b, h) do { _Pragma("unroll") for (int n = 0; n < 2; ++n) _Pragma("unroll") for (int k = 0; k < 2; ++k) dst[n][k] = *(const PG8_LAS bf16x8*)(lds + PG8_SB(b, h) + boff + n * 2048 + k * 1024); } while (0)
#define PG8_MMA(ai, bj, At, Bt) do { __builtin_amdgcn_s_setprio(1); _Pragma("unroll") for (int m = 0; m < 4; ++m) _Pragma("unroll") for (int n = 0; n < 2; ++n) _Pragma("unroll") for (int k = 0; k < 2; ++k) \
        acc[ai][bj][m][n] = __builtin_amdgcn_mfma_f32_16x16x32_bf16(Bt[n][k], At[m][k], acc[ai][bj][m][n], 0, 0, 0); __builtin_amdgcn_s_setprio(0); } while (0)
#define PG8_WAIT_V(n) asm volatile("s_waitcnt vmcnt(" #n ")" ::: "memory")
#define PG8_WAIT_L(n) asm volatile("s_waitcnt lgkmcnt(" #n ")" ::: "memory")
#define PG8_BAR __builtin_amdgcn_s_barrier()
#define PG8_SCHED __builtin_amdgcn_sched_barrier(0)
    Unit cur, nxt; int ui = 0;
    if (!S.next(0, cur)) return;
    f32x4 acc[2][2][4][2];
#pragma unroll
    for (int a = 0; a < 2; ++a)
#pragma unroll
        for (int b = 0; b < 2; ++b)
#pragma unroll
            for (int m = 0; m < 4; ++m)
#pragma unroll
                for (int n = 0; n < 2; ++n) acc[a][b][m][n] = (f32x4){0.f, 0.f, 0.f, 0.f};
    bf16x8 At[4][2], B0[2][2], B1[2][2];
    const char* cA = (const char*)g.A + (size_t)cur.pm * tstep; const char* cB = (const char*)g.Bt + (size_t)cur.pn * tstep;
    S.a_ready(cur);
    if constexpr (SP2) {
        PG8_STAGE(PG8_SB(0, 0), cB, voffB); PG8_STAGE(PG8_SB(0, 1), cB + hstep, voffB); PG8_STAGE(PG8_SA(0, 0), cA, voffA); PG8_STAGE(PG8_SA(0, 1), cA + hstep, voffA);
        if (wr == 1) PG8_BAR;
        PG8_WAIT_V(2); PG8_BAR;
        PG8_STAGE(PG8_SB(1, 0), cB + kstep, voffB); PG8_STAGE(PG8_SA(1, 0), cA + kstep, voffA); PG8_STAGE(PG8_SB(1, 1), cB + hstep + kstep, voffB);
        PG8_WAIT_V(6); PG8_BAR;
    } else {
        PG8_STAGE(PG8_SB(0, 0), cB, voffB); PG8_STAGE(PG8_SA(0, 0), cA, voffA); PG8_STAGE(PG8_SB(0, 1), cB + hstep, voffB); PG8_STAGE(PG8_SA(0, 1), cA + hstep, voffA);
        if (wr == 1) PG8_BAR;
        PG8_WAIT_V(4); PG8_BAR;
        PG8_STAGE(PG8_SB(1, 0), cB + kstep, voffB); PG8_STAGE(PG8_SA(1, 0), cA + kstep, voffA); PG8_STAGE(PG8_SB(1, 1), cB + hstep + kstep, voffB);
        PG8_WAIT_V(6); PG8_BAR;
    }
    for (;;) {
        const bool has_next = S.next(ui + 1, nxt);
        const char* nA = has_next ? (const char*)g.A + (size_t)nxt.pm * tstep : cA; const char* nB = has_next ? (const char*)g.Bt + (size_t)nxt.pn * tstep : cB;
        for (int t = 0; t < nt; t += 2) {
            const bool last = (t == nt - 2);
            const char* a1 = cA + (size_t)(t + 1) * kstep;
            const char* a2 = last ? nA : cA + (size_t)(t + 2) * kstep; const char* b2 = last ? nB : cB + (size_t)(t + 2) * kstep;
            const char* a3 = a2 + kstep; const char* b3 = b2 + kstep;
            if (last && has_next) S.a_ready(nxt);
            if constexpr (SP2) {
            PG8_LDB(B0, 0, 0); PG8_LDB(B1, 0, 1); PG8_SCHED; PG8_LDA(At, 0, 0); PG8_STAGE(PG8_SA(1, 1), a1 + hstep, voffA);
            PG8_WAIT_V(8); PG8_WAIT_L(0); PG8_BAR; PG8_MMA(0, 0, At, B0); PG8_MMA(0, 1, At, B1); PG8_BAR; PG8_SCHED;
            PG8_LDA(At, 0, 1); PG8_STAGE(PG8_SB(0, 0), b2, voffB); PG8_STAGE(PG8_SB(0, 1), b2 + hstep, voffB); PG8_STAGE(PG8_SA(0, 0), a2, voffA);
            PG8_WAIT_V(8); PG8_WAIT_L(0); PG8_BAR; PG8_MMA(1, 0, At, B0); PG8_MMA(1, 1, At, B1); PG8_BAR; PG8_SCHED;
            PG8_LDB(B0, 1, 0); PG8_LDB(B1, 1, 1); PG8_SCHED; PG8_LDA(At, 1, 0); PG8_STAGE(PG8_SA(0, 1), a2 + hstep, voffA);
            PG8_WAIT_V(8); PG8_WAIT_L(0); PG8_BAR; PG8_MMA(0, 0, At, B0); PG8_MMA(0, 1, At, B1); PG8_BAR; PG8_SCHED;
            PG8_LDA(At, 1, 1); PG8_STAGE(PG8_SB(1, 0), b3, voffB); PG8_STAGE(PG8_SB(1, 1), b3 + hstep, voffB); PG8_STAGE(PG8_SA(1, 0), a3, voffA);
            PG8_WAIT_V(8); PG8_WAIT_L(0); PG8_BAR; PG8_MMA(1, 0, At, B0); PG8_MMA(1, 1, At, B1); PG8_BAR; PG8_SCHED;
            } else {
            PG8_LDB(B0, 0, 0); PG8_SCHED; PG8_LDA(At, 0, 0); PG8_STAGE(PG8_SA(1, 1), a1 + hstep, voffA);
            PG8_WAIT_L(8); PG8_BAR; PG8_WAIT_L(0); PG8_MMA(0, 0, At, B0); PG8_BAR; PG8_SCHED;
            PG8_LDB(B1, 0, 1); PG8_STAGE(PG8_SB(0, 0), b2, voffB);
            PG8_BAR; PG8_WAIT_L(0); PG8_MMA(0, 1, At, B1); PG8_BAR;
            PG8_LDA(At, 0, 1); PG8_STAGE(PG8_SA(0, 0), a2, voffA);
            PG8_BAR; PG8_WAIT_L(0); PG8_MMA(1, 0, At, B0); PG8_BAR; PG8_SCHED;
            PG8_STAGE(PG8_SB(0, 1), b2 + hstep, voffB);
            PG8_WAIT_V(6); PG8_BAR; PG8_MMA(1, 1, At, B1); PG8_BAR;
            PG8_LDB(B0, 1, 0); PG8_SCHED; PG8_LDA(At, 1, 0); PG8_STAGE(PG8_SA(0, 1), a2 + hstep, voffA);
            PG8_WAIT_L(8); PG8_BAR; PG8_WAIT_L(0); PG8_MMA(0, 0, At, B0); PG8_BAR; PG8_SCHED;
            PG8_LDB(B1, 1, 1); PG8_STAGE(PG8_SB(1, 0), b3, voffB);
            PG8_BAR; PG8_WAIT_L(0); PG8_MMA(0, 1, At, B1); PG8_BAR;
            PG8_LDA(At, 1, 1); PG8_STAGE(PG8_SA(1, 0), a3, voffA);
            PG8_BAR; PG8_WAIT_L(0); PG8_MMA(1, 0, At, B0); PG8_BAR; PG8_SCHED;
            PG8_STAGE(PG8_SB(1, 1), b3 + hstep, voffB);
            PG8_WAIT_V(6); PG8_BAR; PG8_MMA(1, 1, At, B1); PG8_BAR;
            }
        }
        if constexpr (ALIGN_EPI) { if (wr == 0) PG8_BAR; }
        if constexpr (!Epi::AFTER_DRAIN) { int fr2 = fr, fq2 = fq; asm volatile("" : "+v"(fr2), "+v"(fq2)); E(acc, cur, wr, wc, fr2, fq2); S.done(cur); }
        if (!has_next) break;
#pragma unroll
        for (int a = 0; a < 2; ++a)
#pragma unroll
            for (int b = 0; b < 2; ++b)
#pragma unroll
                for (int m = 0; m < 4; ++m)
#pragma unroll
                    for (int n = 0; n < 2; ++n) acc[a][b][m][n] = (f32x4){0.f, 0.f, 0.f, 0.f};
        cur = nxt; cA = nA; cB = nB; ++ui;
        if constexpr (ALIGN_EPI) { if (wr == 1) PG8_BAR; }
    }
    PG8_WAIT_V(0);
    if constexpr (!ALIGN_EPI) { if (wr == 0) PG8_BAR; }
    PG8_BAR;
    if constexpr (Epi::AFTER_DRAIN) { E.fused(acc, cur, wr, wc, fr, fq, lds, wid, lane); S.done(cur); }
#undef PG8_SA
#undef PG8_SB
#undef PG8_STAGE
#undef PG8_LDA
#undef PG8_LDB
#undef PG8_MMA
#undef PG8_WAIT_V
#undef PG8_WAIT_L
#undef PG8_BAR
#undef PG8_SCHED
}
}

using f4 = pg8::f32x4;
typedef unsigned short bf16_t;
constexpr int NT = 512;
constexpr int M = 8192, D = 2048, DR = 1024, NPAD = 6656, DFF = 8192, KL = 384, NL = 5120;
constexpr int DEPTH = 2;
constexpr float ALPHA = 1.4142135623730951f;
constexpr float LN_EPS = 1e-5f, GN_EPS = 64e-5f;
constexpr int LDS_BYTES = 147456;

constexpr size_t al256(size_t x) { return (x + 255) & ~(size_t)255; }
constexpr size_t FILT_CTX_PER = (size_t)2 * 1024 * 528, FILT_LAT_PER = (size_t)2 * 1024 * 2064;
constexpr size_t WS_MOD = 4096;
constexpr size_t WS_FH2 = al256(WS_MOD + (size_t)2 * 5 * 12288 * 4);
constexpr size_t WS_FILT = al256(WS_FH2 + (size_t)2 * 1280 * 64 * 4);
constexpr size_t WS_WIN = al256(WS_FILT + 2 * (FILT_CTX_PER + FILT_LAT_PER) * 4);
constexpr size_t WS_WOUT = WS_WIN + (size_t)NPAD * D * 2;
constexpr size_t WS_W1 = WS_WOUT + (size_t)D * D * 2;
constexpr size_t WS_W2 = WS_W1 + (size_t)DFF * D * 2;
constexpr size_t WS_WL = WS_W2 + (size_t)D * DFF * 2;
constexpr size_t WS_H = WS_WL + (size_t)NL * KL * 2;
constexpr size_t WS_MIX = WS_H + (size_t)M * D * 2;
constexpr size_t WS_LACT = WS_MIX + (size_t)M * D * 2;
constexpr size_t WS_PROJ = WS_LACT + (size_t)M * KL * 2;
constexpr size_t WS_RW = WS_PROJ + (size_t)M * 6144 * 4;
constexpr size_t WS_HT = WS_RW + (size_t)9 * M * 1024 * 4;
constexpr size_t WS_FILTB = WS_HT + (size_t)3 * 1024 * M * 2;
constexpr size_t FILTB_CTX = (size_t)2 * 1024 * 520, FILTB_LAT = (size_t)2 * 1024 * 2056, FILTB_PER = FILTB_CTX + FILTB_LAT;
constexpr size_t WS_END = WS_FILTB + 2 * FILTB_PER * 2;
static_assert(WS_END <= (size_t)805306368, "workspace map too large");
constexpr size_t AS = (size_t)M * 1024;
constexpr size_t OUT_STATE = (size_t)16777216;

__device__ __forceinline__ int tid_l() { int t = threadIdx.x; asm volatile("" : "+v"(t)); return t; }
struct Params { const float* in[33]; float* out; unsigned char* ws; int ph_lo, ph_hi; };
typedef const __attribute__((address_space(4))) Params CParams;

__device__ __forceinline__ float wave_sum(float v) {
#pragma unroll
    for (int o = 1; o < 64; o <<= 1) v += __shfl_xor(v, o);
    return v;
}
typedef __bf16 bf16x2_t __attribute__((ext_vector_type(2)));
typedef float f32x2_t __attribute__((ext_vector_type(2)));
__device__ __forceinline__ unsigned pk2(float lo, float hi) { const f32x2_t v = {lo, hi}; const bf16x2_t b = __builtin_convertvector(v, bf16x2_t); return __builtin_bit_cast(unsigned, b); }
__device__ __forceinline__ bf16_t f2bf(float f) { unsigned u = __float_as_uint(f); u += 0x7FFFu + ((u >> 16) & 1u); return (bf16_t)(u >> 16); }
__device__ __forceinline__ float bf2f(unsigned short b) { return __uint_as_float(((unsigned)b) << 16); }
__device__ __forceinline__ float sigmf(float x) { return 1.f / (1.f + __expf(-x)); }

__device__ __forceinline__ void ph_mod(CParams& P, float* lds) {
    const int tid = tid_l();
    float* scond = lds;
    float* red = lds + 5 * 2048;
    const float* c = P.in[2]; const float* cctx = P.in[4];
    for (int i = tid; i < 5 * 2048; i += NT) { const int b = i >> 11, k = i & 2047; const float x = b == 0 ? cctx[k] : c[(b - 1) * 2048 + k]; scond[i] = x / (1.f + __expf(-x)); }
    __syncthreads();
    const float* w_ada = P.in[5]; const float* b_ada = P.in[6];
    float* mod = (float*)(P.ws + WS_MOD);
    const int kg = tid >> 5, c4 = tid & 31;
    for (int item = blockIdx.x; item < 192; item += gridDim.x) {
        const int l = item / 96, c0 = (item % 96) * 128;
        f4 acc[5];
#pragma unroll
        for (int b = 0; b < 5; ++b) acc[b] = (f4){0.f, 0.f, 0.f, 0.f};
        const float* wp = w_ada + ((size_t)l * 2048 + kg * 128) * 12288 + c0 + c4 * 4;
        const float* sc = scond + kg * 128;
#pragma unroll 8
        for (int k = 0; k < 128; ++k) {
            const f4 w = *(const f4*)(wp + (size_t)k * 12288);
#pragma unroll
            for (int b = 0; b < 5; ++b) acc[b] += w * sc[b * 2048 + k];
        }
#pragma unroll
        for (int b = 0; b < 5; ++b) *(f4*)(red + (kg * 5 + b) * 128 + c4 * 4) = acc[b];
        __syncthreads();
        for (int idx = tid; idx < 640; idx += NT) {
            const int b = idx >> 7, cc = idx & 127; float s = 0.f;
#pragma unroll
            for (int g = 0; g < 16; ++g) s += red[(g * 5 + b) * 128 + cc];
            mod[(size_t)(l * 5 + b) * 12288 + c0 + cc] = s + b_ada[(size_t)l * 12288 + c0 + cc];
        }
        __syncthreads();
    }
}

__device__ __forceinline__ void ph_filt_hidden(CParams& P) {
    const int lane = tid_l() & 63, wave = tid_l() >> 6;
    const int gw = blockIdx.x * 8 + wave, ngw = gridDim.x * 8;
    float* fh2 = (float*)(P.ws + WS_FH2);
    for (int it = gw; it < 2 * 1280; it += ngw) {
        const int l = it / 1280, q = it % 1280;
        const int seq = q < 256 ? 256 : 1024, p = q < 256 ? q : q - 256;
        const float t = (float)p / (float)(seq - 1);
        const float wang = (float)(6.283185307179586 / (double)seq) * (float)p;
        float z = 0.f;
        if (lane == 0) z = t;
        else if (lane <= 32) {
            const int fi = (lane - 1) & 15; const float st = (float)fi / 15.f; const float f = 1e-4f * (1.f - st) + 15.f * st;
            z = lane <= 16 ? cosf(f * wang) : -sinf(f * wang);
        }
        const float* w1 = P.in[19] + (size_t)l * 33 * 64; const float* b1 = P.in[20] + l * 64;
        const float* w2 = P.in[21] + (size_t)l * 64 * 64; const float* b2 = P.in[22] + l * 64;
        const float* fr = P.in[24] + l * 128;
        float a = b1[lane];
        for (int i = 0; i < 33; ++i) a += __shfl(z, i) * w1[i * 64 + lane];
        const float h1 = sinf(fr[lane] * a);
        float a2 = b2[lane];
        for (int i = 0; i < 64; ++i) a2 += __shfl(h1, i) * w2[i * 64 + lane];
        const float h2 = sinf(fr[64 + lane] * a2);
        fh2[((size_t)l * 1280 + q) * 64 + lane] = h2;
    }
}

__device__ __forceinline__ void transpose_item(const float* W, int K, int N, bf16_t* WT, float* scr, int item, int lane) {
    const int nblk = N / 32, kb = item / nblk, nb = item % nblk, k0 = 64 * kb, n0 = 32 * nb;
#pragma unroll 8
    for (int i = 0; i < 32; ++i) { const int kk = 2 * i + (lane >> 5); scr[kk * 33 + (lane & 31)] = W[(size_t)(k0 + kk) * N + n0 + (lane & 31)]; }
    asm volatile("s_waitcnt lgkmcnt(0)" ::: "memory");
    const int c = lane & 7;
#pragma unroll
    for (int j = 0; j < 4; ++j) { const int n = (lane >> 3) + 8 * j; const float* s = scr + (8 * c) * 33 + n;
        uint4 o; o.x = pk2(s[0 * 33], s[1 * 33]); o.y = pk2(s[2 * 33], s[3 * 33]); o.z = pk2(s[4 * 33], s[5 * 33]); o.w = pk2(s[6 * 33], s[7 * 33]);
        *(uint4*)(WT + (size_t)(n0 + n) * K + k0 + 8 * c) = o; }
    asm volatile("s_waitcnt lgkmcnt(0)" ::: "memory");
}
__device__ __forceinline__ void ph_convert(CParams& P, int l, float* lds) {
    const int lane = tid_l() & 63, wave = tid_l() >> 6;
    const int gw = blockIdx.x * 8 + wave, ngw = gridDim.x * 8;
    float* scr = lds + wave * (64 * 33);
    constexpr int I_IN = 32 * 201, I_OUT = 32 * 64, I_1 = 32 * 256, I_2 = 128 * 64;
    const float* w_in = P.in[7] + (size_t)l * 2048 * 6432; const float* w_out = P.in[26] + (size_t)l * 2048 * 2048;
    const float* w1 = P.in[31] + (size_t)l * 2048 * 8192; const float* w2 = P.in[32] + (size_t)l * 8192 * 2048;
    bf16_t* WIN = (bf16_t*)(P.ws + WS_WIN); bf16_t* WOUT = (bf16_t*)(P.ws + WS_WOUT); bf16_t* W1 = (bf16_t*)(P.ws + WS_W1); bf16_t* W2 = (bf16_t*)(P.ws + WS_W2);
    for (int it = gw; it < I_IN + I_OUT + I_1 + I_2; it += ngw) {
        int r = it;
        if (r < I_IN) { transpose_item(w_in, 2048, 6432, WIN, scr, r, lane); continue; } r -= I_IN;
        if (r < I_OUT) { transpose_item(w_out, 2048, 2048, WOUT, scr, r, lane); continue; } r -= I_OUT;
        if (r < I_1) { transpose_item(w1, 2048, 8192, W1, scr, r, lane); continue; } r -= I_1;
        transpose_item(w2, 8192, 2048, W2, scr, r, lane);
    }
    { uint4* z = (uint4*)(WIN + (size_t)6432 * 2048); const int n16 = 224 * 2048 * 2 / 16;
      for (int i = blockIdx.x * NT + tid_l(); i < n16; i += gridDim.x * NT) z[i] = make_uint4(0, 0, 0, 0); }
    { bf16_t* WL = (bf16_t*)(P.ws + WS_WL);
      const float* wup = P.in[9] + (size_t)l * 2 * 64 * 1024; const float* aup = P.in[11] + (size_t)l * 2 * 64 * 1024; const float* gup = P.in[13] + (size_t)l * 160 * 1024;
      for (int i = blockIdx.x * NT + tid_l(); i < NL * KL; i += gridDim.x * NT) {
          const int n = i / KL, k = i % KL; const int which = n >> 10, c = n & 1023; float v = 0.f;
          if (which < 2) { if (k < 64) v = wup[((size_t)which * 64 + k) * 1024 + c]; }
          else if (which < 4) { if (k >= 64 && k < 128) v = aup[((size_t)(which - 2) * 64 + (k - 64)) * 1024 + c]; }
          else { if (k >= 128 && k < 288) v = gup[(size_t)(k - 128) * 1024 + c]; }
          WL[i] = f2bf(v);
      } }
}

__device__ __forceinline__ void row_pass(const float* src, float* dstX, const float* ag, const float* ab, const float* msh, const float* msc, bf16_t* hrow, int lane) {
    f4 v[8]; float s = 0.f;
#pragma unroll
    for (int j = 0; j < 8; ++j) { v[j] = *(const f4*)(src + j * 256 + lane * 4); s += (v[j][0] + v[j][1]) + (v[j][2] + v[j][3]); }
    if (ag) {
        const float mean = wave_sum(s) * (1.f / 2048.f); float s2 = 0.f;
#pragma unroll
        for (int j = 0; j < 8; ++j) { v[j] = v[j] - mean; s2 += (v[j][0] * v[j][0] + v[j][1] * v[j][1]) + (v[j][2] * v[j][2] + v[j][3] * v[j][3]); }
        const float rstd = rsqrtf(wave_sum(s2) * (1.f / 2048.f) + LN_EPS);
        s = 0.f;
#pragma unroll
        for (int j = 0; j < 8; ++j) { const f4 g = *(const f4*)(ag + j * 256 + lane * 4), b = *(const f4*)(ab + j * 256 + lane * 4);
            v[j] = v[j] * rstd * g + b; s += (v[j][0] + v[j][1]) + (v[j][2] + v[j][3]); }
    }
#pragma unroll
    for (int j = 0; j < 8; ++j) *(f4*)(dstX + j * 256 + lane * 4) = v[j];
    if (msh) {
        const float mean = wave_sum(s) * (1.f / 2048.f); float s2 = 0.f;
#pragma unroll
        for (int j = 0; j < 8; ++j) { v[j] = v[j] - mean; s2 += (v[j][0] * v[j][0] + v[j][1] * v[j][1]) + (v[j][2] * v[j][2] + v[j][3] * v[j][3]); }
        const float rstd = rsqrtf(wave_sum(s2) * (1.f / 2048.f) + LN_EPS);
#pragma unroll
        for (int j = 0; j < 8; ++j) { const f4 sh = *(const f4*)(msh + j * 256 + lane * 4), sc = *(const f4*)(msc + j * 256 + lane * 4);
            const f4 h = v[j] * rstd * (sc + 1.f) + sh;
            uint2 w; w.x = pk2(h[0], h[1]); w.y = pk2(h[2], h[3]);
            *(uint2*)(hrow + j * 256 + lane * 4) = w; }
    }
}
__device__ __forceinline__ void ph_rowpass(CParams& P, int mode, int l) {
    const int lane = tid_l() & 63, wave = tid_l() >> 6;
    const int gw = blockIdx.x * 8 + wave, ngw = gridDim.x * 8;
    const float* mod = (const float*)(P.ws + WS_MOD);
    bf16_t* H = (bf16_t*)(P.ws + WS_H);
    for (int m = gw; m < M; m += ngw) {
        const int bidx = m < 4096 ? 0 : 1 + ((m - 4096) >> 10);
        const float* src; const float* ag = nullptr; const float* ab = nullptr; const float* msh = nullptr; const float* msc = nullptr;
        float* dst = P.out + (size_t)m * 2048;
        if (mode == 0) { src = m < 4096 ? P.in[0] + (size_t)m * 2048 : P.in[1] + (size_t)(m - 4096) * 2048;
            msh = mod + (size_t)(0 * 5 + bidx) * 12288; msc = msh + 2048; }
        else if (mode == 1) { src = dst; ag = P.in[27] + l * 2048; ab = P.in[28] + l * 2048;
            msh = mod + (size_t)(l * 5 + bidx) * 12288 + 3 * 2048; msc = msh + 2048; }
        else { src = dst; ag = P.in[29] + l * 2048; ab = P.in[30] + l * 2048;
            if (l + 1 < DEPTH) { msh = mod + (size_t)((l + 1) * 5 + bidx) * 12288; msc = msh + 2048; } }
        row_pass(src, dst, ag, ab, msh, msc, H + (size_t)m * 2048, lane);
    }
}

__device__ __forceinline__ void ph_filt_final(CParams& P, float* lds) {
    const int tid = tid_l(); const int cl = tid & 31, ps = tid >> 5;
    float* red = lds;
    for (int item = blockIdx.x; item < 256; item += gridDim.x) {
        const int cgp = item & 31, o = (item >> 5) & 1, ss = (item >> 6) & 1, l = item >> 7;
        const int L = ss ? 1024 : 256, GL = 2 * L + 16;
        const int c = cgp * 32 + cl;
        const float* h2 = (const float*)(P.ws + WS_FH2) + ((size_t)l * 1280 + (ss ? 256 : 0)) * 64;
        const float* w3 = P.in[23] + (size_t)l * 64 * 4096;
        float wf[64], wb[64];
#pragma unroll
        for (int j = 0; j < 64; ++j) { wf[j] = w3[(size_t)j * 4096 + (o * 2 + 0) * 1024 + c]; wb[j] = w3[(size_t)j * 4096 + (o * 2 + 1) * 1024 + c]; }
        const float st = (float)c / 1023.f;
        const float delta = fabsf(-3.0701134573253943f * (1.f - st) + -15.350567286626972f * st);
        float* gg = (float*)(P.ws + WS_FILT) + (size_t)l * (FILT_CTX_PER + FILT_LAT_PER) + (ss ? FILT_CTX_PER : 0) + ((size_t)o * 1024 + c) * GL;
        float asum = 0.f;
        for (int p = ps; p < L; p += 16) {
            const float* hp = h2 + (size_t)p * 64;
            float af = 0.f, ab = 0.f;
#pragma unroll
            for (int j4 = 0; j4 < 16; ++j4) { const f4 hv = *(const f4*)(hp + j4 * 4);
#pragma unroll
                for (int e = 0; e < 4; ++e) { af += hv[e] * wf[j4 * 4 + e]; ab += hv[e] * wb[j4 * 4 + e]; } }
            const float t = (float)p / (float)(L - 1);
            const float dec = expf(-t * delta);
            af *= dec; ab *= dec;
            asum += fabsf(af) + fabsf(ab);
            gg[p + L + 7] = af;
            if (p > 0) gg[L + 7 - p] = ab;
        }
        if (ps == 0) { for (int x = 0; x < 8; ++x) gg[x] = 0.f; for (int x = 2 * L + 7; x < GL; ++x) gg[x] = 0.f; }
        red[ps * 32 + cl] = asum;
        __syncthreads();
        float tot = 0.f;
#pragma unroll
        for (int g = 0; g < 16; ++g) tot += red[g * 32 + cl];
        const float inv = 1.f / tot;
        __syncthreads();
        bf16_t* gr = (bf16_t*)(P.ws + WS_FILTB) + (size_t)l * FILTB_PER + (ss ? FILTB_CTX : 0) + ((size_t)o * 1024 + c) * (2 * L + 8);
        for (int p = ps; p < L; p += 16) {
            gr[L - 1 - p] = f2bf(gg[p + L + 7] * inv);
            if (p > 0) gr[L - 1 + p] = f2bf(gg[L + 7 - p] * inv);
        }
        if (ps == 0) { for (int x = 2 * L - 1; x < 2 * L + 8; ++x) gr[x] = 0; }
    }
}

template <bool LAT>
__device__ __forceinline__ void convprep_item(CParams& P, int l, float* tile, int ct, int m0, int lane, int wave) {
    constexpr int NR = LAT ? 3 : 1;
    const float* proj = (const float*)(P.ws + WS_PROJ);
    float* RW = (float*)(P.ws + WS_RW);
    const float* cw = P.in[8] + (size_t)l * 9 * 6144;
    const int c = ct * 64 + lane;
    float wgt[9];
#pragma unroll
    for (int q = 0; q < 9; ++q) wgt[q] = cw[q * 6144 + c];
    const int row = LAT ? (((m0 - 4096) & 1023) >> 6) : 0;
    const int p0 = LAT ? wave * 8 : (m0 & 255) + wave * 8;
    constexpr int PMAX = LAT ? 63 : 255;
    const float* pc = proj + (size_t)(m0 + wave * 8) * 6144 + c;
    float u[NR][10];
#pragma unroll
    for (int ry = 0; ry < NR; ++ry) {
        const int dy = LAT ? ry - 1 : 0;
        const bool rok = LAT ? (row + dy >= 0 && row + dy <= 15) : true;
#pragma unroll
        for (int xx = 0; xx < 10; ++xx) {
            const int pp = p0 + xx - 1;
            const bool ok = rok && pp >= 0 && pp <= PMAX;
            u[ry][xx] = ok ? pc[(ptrdiff_t)(dy * 64 + xx - 1) * 6144] : 0.f;
        }
    }
    float y[8];
#pragma unroll
    for (int i = 0; i < 8; ++i) {
        float a = 0.f;
#pragma unroll
        for (int ry = 0; ry < NR; ++ry)
#pragma unroll
            for (int dx = 0; dx < 3; ++dx) a += u[ry][i + dx] * wgt[(LAT ? ry : 1) * 3 + dx];
        y[i] = a;
    }
    if (ct < 48) {
        const int arr = ct >> 4; const int cc = (ct & 15) * 64 + lane;
        float* dst = RW + (size_t)arr * AS + (size_t)(m0 + wave * 8) * 1024 + cc;
#pragma unroll
        for (int i = 0; i < 8; ++i) dst[(size_t)i * 1024] = y[i];
        if (arr == 1) {
            const float kkw = P.in[14][l * 1024 + cc];
            float* dk = RW + (size_t)3 * AS + (size_t)(m0 + wave * 8) * 1024 + cc;
#pragma unroll
            for (int i = 0; i < 8; ++i) { const float kr = y[i] * kkw; const float ssq = wave_sum(kr * kr); dk[(size_t)i * 1024] = kr * rsqrtf(ssq + 1e-12f); }
        }
    } else {
#pragma unroll
        for (int i = 0; i < 8; ++i) tile[lane * 65 + wave * 8 + i] = y[i];
    }
}
__device__ __forceinline__ void ph_convprep(CParams& P, int l, float* lds) {
    const int tid = tid_l(), lane = tid & 63, wave = tid >> 6;
    float* tile = lds;
    bf16_t* HT = (bf16_t*)(P.ws + WS_HT);
    for (int item = blockIdx.x; item < 128 * 96; item += gridDim.x) {
        const int ct = item % 96, tt = item / 96;
        const int m0 = tt * 64;
        if (m0 >= 4096) convprep_item<true>(P, l, tile, ct, m0, lane, wave);
        else convprep_item<false>(P, l, tile, ct, m0, lane, wave);
        if (ct >= 48) {
            __syncthreads();
            const int which = (ct - 48) >> 4; const int cbase = ((ct - 48) & 15) * 64;
#pragma unroll
            for (int i = 0; i < 8; ++i) { const int ch = wave * 8 + i; HT[((size_t)which * 1024 + cbase + ch) * M + m0 + lane] = f2bf(tile[ch * 65 + lane]); }
            __syncthreads();
        }
    }
}

typedef float f32x16 __attribute__((ext_vector_type(16)));
typedef short s16x8 __attribute__((ext_vector_type(8)));
typedef short s16x4 __attribute__((ext_vector_type(4)));
typedef unsigned u32x4_t __attribute__((ext_vector_type(4)));
#define MFMA16(a, b, c) __builtin_amdgcn_mfma_f32_16x16x32_bf16((a), (b), (c), 0, 0, 0)
__device__ __forceinline__ s16x8 mk8(unsigned a, unsigned b, unsigned c, unsigned d) { u32x4_t v = {a, b, c, d}; return __builtin_bit_cast(s16x8, v); }
__device__ __forceinline__ s16x8 pack_lo(f4 x) { return mk8(pk2(x[0], x[1]), pk2(x[2], x[3]), 0u, 0u); }
__device__ __forceinline__ s16x8 pack_2(f4 lo, f4 hi) { return mk8(pk2(lo[0], lo[1]), pk2(lo[2], lo[3]), pk2(hi[0], hi[1]), pk2(hi[2], hi[3])); }
constexpr int SC_KQ = 0, SC_RQ = 2304, SC_KD = 4608, SC_BD = 6912, SC_KDCT = 9216, SC_NBDCT = 11264, SC_VT = 13312, SC_GC = 15360, SC_BUF = 15616;

__device__ __forceinline__ void chain_chunk(const unsigned char* buf, f4 (&H)[4][4], float* gO, int mrow0, int mstep, int lane) {
    const int r = lane & 15, g = lane >> 4;
    const f4 z = (f4){0.f, 0.f, 0.f, 0.f};
    const unsigned char* rb = buf + r * 144 + g * 16;
    const s16x8 fKq0 = *(const s16x8*)(rb + SC_KQ), fKq1 = *(const s16x8*)(rb + SC_KQ + 64);
    const s16x8 fRq0 = *(const s16x8*)(rb + SC_RQ), fRq1 = *(const s16x8*)(rb + SC_RQ + 64);
    const s16x8 fKd0 = *(const s16x8*)(rb + SC_KD), fKd1 = *(const s16x8*)(rb + SC_KD + 64);
    const s16x8 fBd0 = *(const s16x8*)(rb + SC_BD), fBd1 = *(const s16x8*)(rb + SC_BD + 64);
    f4 Xd = MFMA16(fKq1, fBd1, MFMA16(fKq0, fBd0, z));
    f4 XTd = MFMA16(fBd1, fKq1, MFMA16(fBd0, fKq0, z));
    f4 MkkT = MFMA16(fKd1, fKq1, MFMA16(fKd0, fKq0, z));
    f4 MrkT = MFMA16(fKd1, fRq1, MFMA16(fKd0, fRq0, z));
    f4 MrbT = MFMA16(fBd1, fRq1, MFMA16(fBd0, fRq0, z));
    f4 eye;
#pragma unroll
    for (int q = 0; q < 4; ++q) { const int ri = 4 * g + q;
        Xd[q] = ri > r ? -Xd[q] : 0.f; XTd[q] = ri < r ? -XTd[q] : 0.f; MkkT[q] = ri < r ? MkkT[q] : 0.f;
        MrkT[q] = ri <= r ? MrkT[q] : 0.f; MrbT[q] = ri <= r ? -MrbT[q] : 0.f; eye[q] = ri == r ? 1.f : 0.f; }
    const s16x8 pX = pack_lo(Xd), pXT = pack_lo(XTd);
    const f4 X2d = MFMA16(pXT, pX, z), X2Td = MFMA16(pX, pXT, z);
    const s16x8 pX2 = pack_lo(X2d), pX2T = pack_lo(X2Td);
    const f4 X4d = MFMA16(pX2T, pX2, z), X4Td = MFMA16(pX2, pX2T, z);
    const f4 X8d = MFMA16(pack_lo(X4Td), pack_lo(X4d), z);
    const f4 U1T = MFMA16(pack_lo(X2d + eye), pack_lo(XTd + eye), z);
    const f4 U2T = MFMA16(pack_lo(X4d + eye), pack_lo(U1T), z);
    const f4 TT = MFMA16(pack_lo(X8d + eye), pack_lo(U2T), z);
    const s16x8 fTT = pack_lo(TT), fMkkT = pack_lo(MkkT), fOrb = pack_2(MrkT, MrbT);
    const unsigned char* pb = buf + r * 144 + g * 8;
    const uint2 k0l = *(const uint2*)(pb + SC_KQ), k0h = *(const uint2*)(pb + SC_KQ + 32), k1l = *(const uint2*)(pb + SC_KQ + 64), k1h = *(const uint2*)(pb + SC_KQ + 96);
    const uint2 r0l = *(const uint2*)(pb + SC_RQ), r0h = *(const uint2*)(pb + SC_RQ + 32), r1l = *(const uint2*)(pb + SC_RQ + 64), r1h = *(const uint2*)(pb + SC_RQ + 96);
    const s16x8 aK0 = mk8(k0l.x, k0l.y, k0h.x, k0h.y), aK1 = mk8(k1l.x, k1l.y, k1h.x, k1h.y);
    const s16x8 aR0 = mk8(r0l.x, r0l.y, r0h.x, r0h.y), aR1 = mk8(r1l.x, r1l.y, r1h.x, r1h.y);
#pragma unroll
    for (int vt = 0; vt < 4; ++vt) {
        const s16x8 h0 = pack_2(H[0][vt], H[1][vt]), h1 = pack_2(H[2][vt], H[3][vt]);
        f4 P0 = MFMA16(aK1, h1, MFMA16(aK0, h0, z));
        f4 O = MFMA16(aR1, h1, MFMA16(aR0, h0, z));
        const uint2 vv = *(const uint2*)(buf + SC_VT + (16 * vt + r) * 32 + g * 8);
        P0 = MFMA16(fMkkT, mk8(vv.x, vv.y, 0u, 0u), P0);
        const f4 Pm = MFMA16(fTT, pack_lo(P0), z);
        const s16x8 fB = mk8(vv.x, vv.y, pk2(Pm[0], Pm[1]), pk2(Pm[2], Pm[3]));
        O = MFMA16(fOrb, fB, O);
#pragma unroll
        for (int q = 0; q < 4; ++q) gO[(ptrdiff_t)(mrow0 + mstep * (4 * g + q)) * 1024 + 16 * vt + r] = O[q];
#pragma unroll
        for (int kt = 0; kt < 4; ++kt) {
            const unsigned char* pk = buf + SC_KDCT + (16 * kt + r) * 32 + g * 8;
            const uint2 al = *(const uint2*)pk, ah = *(const uint2*)(pk + 2048);
            const f4 gc = *(const f4*)(buf + SC_GC + (16 * kt + 4 * g) * 4);
            H[kt][vt] = MFMA16(mk8(al.x, al.y, ah.x, ah.y), fB, H[kt][vt] * gc);
        }
    }
}
typedef float f32x8 __attribute__((ext_vector_type(8)));
struct RawH { f32x16 w; f32x8 r, k, v, kk, a; };
__device__ __forceinline__ void prep_load(RawH& R, const float* RW, int d, int hf, int mrow0, int mstep, int colx) {
#pragma unroll
    for (int t = 0; t < 16; ++t) R.w[t] = RW[(4 + d) * AS + (size_t)(mrow0 + mstep * t) * 1024 + colx];
#pragma unroll
    for (int j = 0; j < 8; ++j) { const size_t off = (size_t)(mrow0 + mstep * (8 * hf + j)) * 1024 + colx;
        R.r[j] = RW[off]; R.k[j] = RW[AS + off]; R.v[j] = RW[2 * AS + off]; R.kk[j] = RW[3 * AS + off]; R.a[j] = RW[(6 + d) * AS + off]; }
}
__device__ __forceinline__ void prep_proc(const RawH& R, unsigned char* buf, int hf, float ka, int lane) {
    float G = 1.f;
    if (hf) {
#pragma unroll
        for (int t = 0; t < 8; ++t) G *= R.w[t]; }
    float GC = 1.f;
#pragma unroll
    for (int t = 0; t < 16; ++t) GC *= R.w[t];
    f32x8 kdi, bdi;
#pragma unroll
    for (int j = 0; j < 8; ++j) {
        const int t = 8 * hf + j;
        *(bf16_t*)(buf + SC_KQ + t * 144 + lane * 2) = f2bf(R.kk[j] * G);
        G *= hf ? R.w[8 + j] : R.w[j];
        *(bf16_t*)(buf + SC_RQ + t * 144 + lane * 2) = f2bf(R.r[j] * G);
        const float iG = __builtin_amdgcn_rcpf(G);
        const float kd = R.k[j] * (1.f + (R.a[j] - 1.f) * ka), bb = R.kk[j] * R.a[j];
        kdi[j] = kd * iG; bdi[j] = bb * iG;
        *(bf16_t*)(buf + SC_KD + t * 144 + lane * 2) = f2bf(kdi[j]);
        *(bf16_t*)(buf + SC_BD + t * 144 + lane * 2) = f2bf(bdi[j]);
    }
    uint4 o1, o2, o3;
    o1.x = pk2(kdi[0] * GC, kdi[1] * GC); o1.y = pk2(kdi[2] * GC, kdi[3] * GC); o1.z = pk2(kdi[4] * GC, kdi[5] * GC); o1.w = pk2(kdi[6] * GC, kdi[7] * GC);
    o2.x = pk2(-bdi[0] * GC, -bdi[1] * GC); o2.y = pk2(-bdi[2] * GC, -bdi[3] * GC); o2.z = pk2(-bdi[4] * GC, -bdi[5] * GC); o2.w = pk2(-bdi[6] * GC, -bdi[7] * GC);
    o3.x = pk2(R.v[0], R.v[1]); o3.y = pk2(R.v[2], R.v[3]); o3.z = pk2(R.v[4], R.v[5]); o3.w = pk2(R.v[6], R.v[7]);
    *(uint4*)(buf + SC_KDCT + lane * 32 + hf * 16) = o1;
    *(uint4*)(buf + SC_NBDCT + lane * 32 + hf * 16) = o2;
    *(uint4*)(buf + SC_VT + lane * 32 + hf * 16) = o3;
    if (hf) *(float*)(buf + SC_GC + lane * 4) = GC;
}
__device__ __forceinline__ void scan_item(CParams& P, int l, float* ldsf, int type, int b, int h) {
    unsigned char* lds = (unsigned char*)ldsf;
    const int tid = tid_l(), lane = tid & 63, wave = __builtin_amdgcn_readfirstlane(tid >> 6);
    const int L = type ? 256 : 1024, NCH = L / 16; const int mbase = type ? b * 256 : 4096 + b * 1024;
    if (wave < 2) {
        const int d = wave; const int mstep = d ? -1 : 1; const int mfirst = mbase + (d ? L - 1 : 0);
        const unsigned char* cbuf = lds + d * 2 * SC_BUF;
        float* gO = (float*)(P.ws + WS_PROJ) + (size_t)d * AS + h * 64;
        const int r = lane & 15, g = lane >> 4;
        f4 H[4][4];
        if (type == 0) { const float* s0 = P.in[3] + ((((size_t)b * 2 + l) * 2 + d) * 16 + h) * 4096;
#pragma unroll
            for (int kt = 0; kt < 4; ++kt)
#pragma unroll
                for (int vt = 0; vt < 4; ++vt) H[kt][vt] = *(const f4*)(s0 + (16 * vt + r) * 64 + 16 * kt + 4 * g); }
        else {
#pragma unroll
            for (int kt = 0; kt < 4; ++kt)
#pragma unroll
                for (int vt = 0; vt < 4; ++vt) H[kt][vt] = (f4){0.f, 0.f, 0.f, 0.f}; }
        __syncthreads();
        for (int c = 0; c < NCH; ++c) {
            chain_chunk(cbuf + (c & 1) * SC_BUF, H, gO, mfirst + mstep * 16 * c, mstep, lane);
            __syncthreads();
        }
        if (type == 1) { float* so = P.out + OUT_STATE + ((((size_t)b * 2 + l) * 2 + d) * 16 + h) * 4096;
#pragma unroll
            for (int kt = 0; kt < 4; ++kt)
#pragma unroll
                for (int vt = 0; vt < 4; ++vt) *(f4*)(so + (16 * vt + r) * 64 + 16 * kt + 4 * g) = H[kt][vt]; }
    } else if (wave < 6) {
        const int d = (wave - 2) >> 1, hf = (wave - 2) & 1; const int mstep = d ? -1 : 1; const int mfirst = mbase + (d ? L - 1 : 0);
        unsigned char* cbuf = lds + d * 2 * SC_BUF;
        const float* RW = (const float*)(P.ws + WS_RW);
        const int colx = h * 64 + lane;
        const float ka = P.in[15][l * 1024 + colx];
        RawH RA, RB;
        prep_load(RA, RW, d, hf, mfirst, mstep, colx);
        for (int c = 0; c < NCH; c += 2) {
            prep_load(RB, RW, d, hf, mfirst + mstep * 16 * (c + 1), mstep, colx);
            prep_proc(RA, cbuf, hf, ka, lane);
            __syncthreads();
            if (c + 2 < NCH) prep_load(RA, RW, d, hf, mfirst + mstep * 16 * (c + 2), mstep, colx);
            prep_proc(RB, cbuf + SC_BUF, hf, ka, lane);
            __syncthreads();
        }
        __syncthreads();
    } else {
        for (int c = 0; c <= NCH; ++c) __syncthreads();
    }
}

template <int L>
__device__ __forceinline__ void hym_conv(const bf16_t* cps, const bf16_t* ubs, f32x16& acc) {
    constexpr int ND = (L == 1024) ? 39 : 15;
#pragma unroll 3
    for (int dd = 0; dd < ND; ++dd) {
#pragma unroll
        for (int kh = 0; kh < 2; ++kh) {
            const bf16_t* ap = cps - 32 * dd + 16 * kh; const bf16_t* bp = ubs - 32 * dd + 16 * kh;
            const s16x4 alo = *(const s16x4*)ap, ahi = *(const s16x4*)(ap + 4);
            const s16x8 av = __builtin_shufflevector(alo, ahi, 0, 1, 2, 3, 4, 5, 6, 7);
            const s16x8 bv = *(const s16x8*)bp;
            acc = __builtin_amdgcn_mfma_f32_32x32x16_bf16(av, bv, acc, 0, 0, 0);
        }
    }
}
template <int L>
__device__ __forceinline__ void hyena_item(CParams& P, int l, float* ldsf, int cp2) {
    constexpr bool LAT = (L == 1024); constexpr int NB = LAT ? 4 : 16; constexpr int GRL = 2 * L + 8; constexpr int ROWL = L + 448;
    bf16_t* sCP = (bf16_t*)ldsf;
    bf16_t* sU = sCP + 16 * GRL;
    bf16_t* sZ = sU + 2 * NB * ROWL;
    const int tid = tid_l(), lane = tid & 63, wave = tid >> 6;
    const int c0 = cp2 * 2; const int mbase = LAT ? 4096 : 0;
    bf16_t* HT = (bf16_t*)(P.ws + WS_HT);
    const bf16_t* filtb = (const bf16_t*)(P.ws + WS_FILTB) + (size_t)l * FILTB_PER + (LAT ? FILTB_CTX : 0);
    for (int idx = tid; idx < 2 * NB * 56; idx += NT) { const int row = idx / 56, q = idx % 56;
        const int off = row * ROWL + (q < 28 ? q * 8 : 224 + L + (q - 28) * 8);
        *(uint4*)(sU + off) = make_uint4(0, 0, 0, 0); *(uint4*)(sZ + off) = make_uint4(0, 0, 0, 0); }
    for (int idx = tid; idx < 2 * 512; idx += NT) { const int ch = idx >> 9, q = idx & 511;
        const uint4 v = *(const uint4*)(HT + (size_t)(c0 + ch) * M + mbase + 8 * q);
        const int b = (8 * q) / L, t = (8 * q) % L; *(uint4*)(sU + (ch * NB + b) * ROWL + 224 + t) = v; }
    for (int idx = tid; idx < 16 * GRL; idx += NT) { const int y = idx % GRL, k = idx / GRL; const int sft = k & 3, o = (k >> 2) & 1, ch = k >> 3;
        const bf16_t* src = filtb + ((size_t)o * 1024 + c0 + ch) * GRL;
        sCP[idx] = (y + sft < GRL) ? src[y + sft] : (bf16_t)0; }
    __syncthreads();
    const int ch = wave >> 2, nt = wave & 3; const int c = c0 + ch;
    const int r = lane & 31, h = lane >> 5; const int Il = r >> 2, bl = r & 3;
    const int I = LAT ? 8 * nt + Il : Il; const int b = LAT ? bl : 4 * nt + bl;
    const int dlo = LAT ? 8 * nt - 31 : -7;
    const int X0 = L - 1 - (32 * dlo + r - 8 * h); const int sft = X0 & 3;
    const int urow = (ch * NB + b) * ROWL + 224;
    const int uoff = urow + 32 * (I - dlo) + 8 * h;
    f32x16 acc;
#pragma unroll
    for (int i = 0; i < 16; ++i) acc[i] = 0.f;
    hym_conv<L>(sCP + ((ch * 2 + 0) * 4 + sft) * GRL + (X0 - sft), sU + uoff, acc);
    const float bias1 = P.in[25][(l * 2 + 0) * 1024 + c], bias2 = P.in[25][(l * 2 + 1) * 1024 + c];
    const size_t gcol = (size_t)c * M + mbase + b * L + 32 * I + 4 * h;
    float z[16];
#pragma unroll
    for (int g4 = 0; g4 < 4; ++g4) {
        const int t0 = 32 * I + 8 * g4 + 4 * h;
        const uint2 xv = *(const uint2*)(HT + (size_t)1 * 1024 * M + gcol + 8 * g4);
        const uint2 uv = *(const uint2*)(sU + urow + t0);
        const float x1[4] = {__uint_as_float(xv.x << 16), __uint_as_float(xv.x & 0xffff0000u), __uint_as_float(xv.y << 16), __uint_as_float(xv.y & 0xffff0000u)};
        const float uu[4] = {__uint_as_float(uv.x << 16), __uint_as_float(uv.x & 0xffff0000u), __uint_as_float(uv.y << 16), __uint_as_float(uv.y & 0xffff0000u)};
#pragma unroll
        for (int e = 0; e < 4; ++e) z[4 * g4 + e] = x1[e] * (acc[4 * g4 + e] + bias1 * uu[e]);
        uint2 w; w.x = pk2(z[4 * g4], z[4 * g4 + 1]); w.y = pk2(z[4 * g4 + 2], z[4 * g4 + 3]);
        *(uint2*)(sZ + urow + t0) = w;
    }
    __syncthreads();
#pragma unroll
    for (int i = 0; i < 16; ++i) acc[i] = 0.f;
    hym_conv<L>(sCP + ((ch * 2 + 1) * 4 + sft) * GRL + (X0 - sft), sZ + uoff, acc);
#pragma unroll
    for (int g4 = 0; g4 < 4; ++g4) {
        const uint2 xv = *(const uint2*)(HT + (size_t)2 * 1024 * M + gcol + 8 * g4);
        const float x2[4] = {__uint_as_float(xv.x << 16), __uint_as_float(xv.x & 0xffff0000u), __uint_as_float(xv.y << 16), __uint_as_float(xv.y & 0xffff0000u)};
        float o4[4];
#pragma unroll
        for (int e = 0; e < 4; ++e) o4[e] = x2[e] * (acc[4 * g4 + e] + bias2 * z[4 * g4 + e]);
        uint2 w; w.x = pk2(o4[0], o4[1]); w.y = pk2(o4[2], o4[3]);
        *(uint2*)(HT + gcol + 8 * g4) = w;
    }
    __syncthreads();
}

__device__ __forceinline__ void ph_scan_hyena(CParams& P, int l, float* lds) {
    const int G = gridDim.x; constexpr int total = 64 + 256 + 512 + 512;
    for (int r = 0; r * G < total; ++r) {
        const int pos = (r & 1) ? G - 1 - (int)blockIdx.x : (int)blockIdx.x; const int j = r * G + pos;
        if (j >= total) continue;
        if (j < 64) scan_item(P, l, lds, 0, j >> 4, j & 15);
        else if (j < 320) scan_item(P, l, lds, 1, (j - 64) >> 4, (j - 64) & 15);
        else if (j < 832) hyena_item<1024>(P, l, lds, j - 320);
        else hyena_item<256>(P, l, lds, j - 832);
    }
}

__device__ __forceinline__ void ph_combine(CParams& P, int l, float* lds) {
    const int lane = tid_l() & 63, wave = tid_l() >> 6;
    const int gw = blockIdx.x * 8 + wave, ngw = gridDim.x * 8;
    const float* RW = (const float*)(P.ws + WS_RW);
    const float* O = (const float*)(P.ws + WS_PROJ);
    bf16_t* mix = (bf16_t*)(P.ws + WS_MIX);
    for (int it = gw; it < M * 16; it += ngw) {
        const int m = it >> 4, h = it & 15; const int cc = h * 64 + lane; const size_t idx = (size_t)m * 1024 + cc;
        const float o = O[idx] + O[AS + idx];
        const float mu = wave_sum(o) * (1.f / 64.f); const float dv = o - mu; const float var = wave_sum(dv * dv) * (1.f / 64.f);
        const float yn = dv * rsqrtf(var + GN_EPS) * P.in[17][l * 1024 + cc] + P.in[18][l * 1024 + cc];
        const float r = RW[idx], k = RW[AS + idx], v = RW[2 * AS + idx], a0 = RW[6 * AS + idx], a1 = RW[7 * AS + idx], g = RW[8 * AS + idx];
        const float ka = P.in[15][l * 1024 + cc], rk = P.in[16][l * 1024 + cc];
        const float kd0 = k * (1.f + (a0 - 1.f) * ka), kd1 = k * (1.f + (a1 - 1.f) * ka);
        const float sb = wave_sum(r * (kd0 + kd1) * rk);
        mix[(size_t)m * 2048 + cc] = f2bf((yn + sb * v) * g);
    }
    bf16_t* tile = (bf16_t*)lds;
    const bf16_t* HT = (const bf16_t*)(P.ws + WS_HT);
    for (int item = blockIdx.x; item < 16 * 128; item += gridDim.x) {
        const int c0 = (item & 15) * 64, m0 = (item >> 4) * 64;
#pragma unroll
        for (int i = 0; i < 8; ++i) { const int ci = wave * 8 + i; tile[ci * 66 + lane] = HT[(size_t)(c0 + ci) * M + m0 + lane]; }
        __syncthreads();
#pragma unroll
        for (int i = 0; i < 8; ++i) { const int mi = wave * 8 + i; mix[(size_t)(m0 + mi) * 2048 + 1024 + c0 + lane] = tile[lane * 66 + mi]; }
        __syncthreads();
    }
}

constexpr int NPH = 2 + 9 * DEPTH;
#ifndef PHM
#define PHM 1023
#endif
#ifndef DUPM
#define DUPM 0
#endif
__global__ void __launch_bounds__(NT, 2) mega(Params Pv) {
    extern __shared__ __attribute__((aligned(16))) unsigned char lds_raw[];
    cg::grid_group grid = cg::this_grid();
    float* ldsf = (float*)lds_raw;
    PG8_LAS unsigned char* ldsg = (PG8_LAS unsigned char*)lds_raw;
    const int G = gridDim.x, bid = blockIdx.x;
    const int ph_lo = Pv.ph_lo, ph_hi = Pv.ph_hi;
    for (int ph = ph_lo; ph < ph_hi; ++ph) {
        const int nrep = (ph >= 2 && ((DUPM >> ((ph - 2) % 9)) & 1)) ? 2 : ((ph < 2 && ((DUPM >> (10 + ph)) & 1)) ? 2 : 1);
        for (int rep = 0; rep < nrep; ++rep) {
        CParams* kp = (CParams*)__builtin_amdgcn_kernarg_segment_ptr(); asm volatile("" : "+s"(kp));
        CParams& P = *kp;
        if (ph == 0 && (PHM & 1)) { ph_mod(P, ldsf); ph_filt_hidden(P); __syncthreads(); ph_convert(P, 0, ldsf); }
        else if (ph == 1 && (PHM & 2)) { ph_rowpass(P, 0, 0); ph_filt_final(P, ldsf); }
        else {
            const int l = (ph - 2) / 9, s = (ph - 2) % 9;
            const float* mod = (const float*)(P.ws + WS_MOD);
            if (s == 0 && (PHM & 4)) {
                pg8::Gemm g{(const bf16_t*)(P.ws + WS_H), (const bf16_t*)(P.ws + WS_WIN), M, NPAD, D}; pg8::StaticOrder S; S.init(M, NPAD, G, bid);
                pg8::EpiProj E{(float*)(P.ws + WS_PROJ), (bf16_t*)(P.ws + WS_LACT)};
                pg8::gemm_phase<pg8::EpiProj, pg8::StaticOrder, true, true>(ldsg, g, S, E);
            } else if (s == 1 && (PHM & 8)) {
                pg8::Gemm g{(const bf16_t*)(P.ws + WS_LACT), (const bf16_t*)(P.ws + WS_WL), M, NL, KL}; pg8::StaticOrder S; S.init(M, NL, G, bid);
                pg8::EpiLora E{(float*)(P.ws + WS_RW) + 4 * AS, AS, P.in[10] + l * 2048, P.in[12] + l * 2048};
                pg8::gemm_phase<pg8::EpiLora, pg8::StaticOrder, true, true>(ldsg, g, S, E);
                __syncthreads();
                ph_convprep(P, l, ldsf);
            } else if (s == 2 && (PHM & 16)) { ph_scan_hyena(P, l, ldsf); }
            else if (s == 3 && (PHM & 32)) { ph_combine(P, l, ldsf); }
            else if ((s == 4 || s == 7) && (PHM & 64)) {
                pg8::Gemm g{(const bf16_t*)(P.ws + (s == 4 ? WS_MIX : WS_PROJ)), (const bf16_t*)(P.ws + (s == 4 ? WS_WOUT : WS_W2)), M, D, s == 4 ? D : DFF}; pg8::StaticOrder S; S.init(M, D, G, bid);
                pg8::EpiRes E{P.out, mod + (size_t)l * 5 * 12288 + (s == 4 ? 2 : 5) * 2048, ALPHA};
                pg8::gemm_phase<pg8::EpiRes, pg8::StaticOrder, true, true>(ldsg, g, S, E);
            } else if (s == 5 && (PHM & 128)) { ph_rowpass(P, 1, l); }
            else if (s == 6 && (PHM & 256)) {
                pg8::Gemm g{(const bf16_t*)(P.ws + WS_H), (const bf16_t*)(P.ws + WS_W1), M, DFF, D}; pg8::StaticOrder S; S.init(M, DFF, G, bid);
                pg8::EpiRelu2 E{(bf16_t*)(P.ws + WS_PROJ), DFF};
                pg8::gemm_phase<pg8::EpiRelu2, pg8::StaticOrder, true, true>(ldsg, g, S, E);
            } else if (PHM & 512) { ph_rowpass(P, 2, l); if (l + 1 < DEPTH) ph_convert(P, l + 1, ldsf); }
        }
        if (ph + 1 < ph_hi || rep + 1 < nrep) grid.sync();
        }
    }
}

#ifndef MK_MULTI
#define MK_MULTI 0
#endif
extern "C" void kernel_launch(void* const* d_in, const int* in_sizes, int n_in, void* d_out, int out_size, void* d_ws, size_t ws_size, hipStream_t stream) {
    static int grid = 0;
    if (grid == 0) {
        int dev = 0, cus = 0, per_cu = 0;
        if (n_in != 33 || ws_size < WS_END) { fprintf(stderr, "kernel_launch: unexpected n_in %d or ws_size %zu (< %zu)\n", n_in, ws_size, (size_t)WS_END); grid = -1; return; }
        hipGetDevice(&dev);
        hipDeviceGetAttribute(&cus, hipDeviceAttributeMultiprocessorCount, dev);
        if (hipFuncSetAttribute((const void*)mega, hipFuncAttributeMaxDynamicSharedMemorySize, LDS_BYTES) != hipSuccess) { fprintf(stderr, "hipFuncSetAttribute failed\n"); grid = -1; return; }
        if (hipOccupancyMaxActiveBlocksPerMultiprocessor(&per_cu, (const void*)mega, NT, LDS_BYTES) != hipSuccess || per_cu < 1) { fprintf(stderr, "occupancy query failed (%d)\n", per_cu); grid = -1; return; }
        grid = cus;
    }
    if (grid < 0) return;
    Params p{};
    for (int i = 0; i < 33; ++i) p.in[i] = (const float*)d_in[i];
    p.out = (float*)d_out; p.ws = (unsigned char*)d_ws;
#if MK_MULTI
    for (int ph = 0; ph < NPH; ++ph) { p.ph_lo = ph; p.ph_hi = ph + 1; hipLaunchKernelGGL(mega, dim3(grid), dim3(NT), LDS_BYTES, stream, p); }
#else
    p.ph_lo = 0; p.ph_hi = NPH;
    void* args[] = {&p};
    hipError_t e = hipLaunchCooperativeKernel((const void*)mega, dim3(grid), dim3(NT), args, LDS_BYTES, stream);
    if (e != hipSuccess) fprintf(stderr, "cooperative launch failed: %s (grid %d)\n", hipGetErrorString(e), grid);
#endif
}
```

```cpp
#include <hip/hip_runtime.h>
#include <hip/hip_cooperative_groups.h>
#include <cstdio>
#include <cstdint>
namespace cg = cooperative_groups;

namespace pg8 {
#define PG8_LAS __attribute__((address_space(3)))
typedef unsigned short bf16_t;
typedef short bf16x8 __attribute__((ext_vector_type(8)));
typedef float f32x4 __attribute__((ext_vector_type(4)));
typedef unsigned u32x4 __attribute__((ext_vector_type(4)));
constexpr int BM = 256, BK = 64, HALF = 128, HTB = HALF * BK * 2  , STAGE_BYTES = 8 * HTB, NXCD = 8, WGM = 8;

__host__ __device__ __forceinline__ int lds_byte(int r, int c) { const int st = (r >> 4) * 2 + (c >> 5), rr = r & 15, cc = c & 31, ob = rr * 64 + cc * 2; return st * 1024 + (ob ^ (((ob >> 9) & 1) << 5)); }
__host__ __device__ __forceinline__ void stage_rc(int b, int& R, int& C) { const int st = b / 1024, sb = b % 1024, swz = sb ^ (((sb >> 9) & 1) << 5); R = (st >> 1) * 16 + swz / 64; C = (st & 1) * 32 + (swz % 64) / 2; }
__host__ __device__ __forceinline__ int perm32(int rho) { const int n = rho >> 4, i = rho & 15; return 8 * (i >> 2) + 4 * n + (i & 3); }

struct Unit { int pm, pn; };
struct Gemm { const bf16_t* A; const bf16_t* Bt; int M, N, K; };

struct StaticOrder {
    int nM, nN, nwg, G, c;
    __host__ __device__ void init(int M, int N, int G_, int c_) { nM = M / BM; nN = N / BM; nwg = nM * nN; G = G_; c = c_; }
    __host__ __device__ bool next(int i, Unit& u) const {
        const long L = (long)i * G + c; if (L >= nwg) return false;
        int wgid = (int)L; { const int q = nwg / NXCD, r = nwg % NXCD, xcd = wgid % NXCD, off = wgid / NXCD; wgid = (xcd < r ? xcd * (q + 1) : r * (q + 1) + (xcd - r) * q) + off; }
        const int nig = WGM * nN, gid = wgid / nig, fm = gid * WGM, gsz = (nM - fm) < WGM ? (nM - fm) : WGM;
        u.pm = fm + ((wgid % nig) % gsz); u.pn = (wgid % nig) / gsz; return true;
    }
    __device__ __forceinline__ void a_ready(const Unit&) const {}
    __device__ __forceinline__ void done(const Unit&) const {}
};

typedef __bf16 bf16x2v __attribute__((ext_vector_type(2)));
typedef float f32x2v __attribute__((ext_vector_type(2)));
__device__ __forceinline__ unsigned cvt_pk_bf16(float lo, float hi) { const f32x2v v = {lo, hi}; const bf16x2v b = __builtin_convertvector(v, bf16x2v); return __builtin_bit_cast(unsigned, b); }
typedef float f32x2 __attribute__((ext_vector_type(2)));

__device__ __forceinline__ float sigm(float x) { return 1.f / (1.f + __expf(-x)); }
struct EpiProj {
    static constexpr bool PERM = false, AFTER_DRAIN = false;
    float* proj; bf16_t* lact;
    __device__ __forceinline__ void operator()(const f32x4 (&acc)[2][2][4][2], const Unit& u, int wr, int wc, int fr, int fq) const {
        const int row0 = u.pm * BM + wr * 64 + fr, col0 = u.pn * BM + wc * 32 + 4 * fq;
        if (u.pn < 24) {
#pragma unroll
            for (int ai = 0; ai < 2; ++ai)
#pragma unroll
                for (int m = 0; m < 4; ++m) { float* rowp = proj + (size_t)(row0 + ai * HALF + m * 16) * 6144 + col0;
#pragma unroll
                    for (int bj = 0; bj < 2; ++bj)
#pragma unroll
                        for (int n = 0; n < 2; ++n) *(f32x4*)(rowp + bj * HALF + n * 16) = acc[ai][bj][m][n]; }
        } else {
#pragma unroll
            for (int ai = 0; ai < 2; ++ai)
#pragma unroll
                for (int m = 0; m < 4; ++m) { bf16_t* rowp = lact + (size_t)(row0 + ai * HALF + m * 16) * 384;
#pragma unroll
                    for (int bj = 0; bj < 2; ++bj)
#pragma unroll
                        for (int n = 0; n < 2; ++n) {
                            const int cl = col0 - 6144 + bj * HALF + n * 16;
                            if (cl < 384) {
                                f32x4 v = acc[ai][bj][m][n];
                                if (cl < 64) { v[0] = tanhf(v[0]); v[1] = tanhf(v[1]); v[2] = tanhf(v[2]); v[3] = tanhf(v[3]); }
                                else if (cl < 128) { }
                                else if (cl < 288) { v[0] = sigm(v[0]); v[1] = sigm(v[1]); v[2] = sigm(v[2]); v[3] = sigm(v[3]); }
                                else { v = (f32x4){0.f, 0.f, 0.f, 0.f}; }
                                uint2 w; w.x = cvt_pk_bf16(v[0], v[1]); w.y = cvt_pk_bf16(v[2], v[3]);
                                *(uint2*)(rowp + cl) = w;
                            }
                        } }
        }
    }
};
struct EpiLora {
    static constexpr bool PERM = false, AFTER_DRAIN = false;
    float* arr0; size_t arr_stride;
    const float* w0; const float* a0;
    __device__ __forceinline__ void operator()(const f32x4 (&acc)[2][2][4][2], const Unit& u, int wr, int wc, int fr, int fq) const {
        const int which = u.pn >> 2;
        const int row0 = u.pm * BM + wr * 64 + fr, col0 = (u.pn & 3) * BM + wc * 32 + 4 * fq;
        float* base = arr0 + (size_t)which * arr_stride;
        const float* bptr = which < 2 ? w0 + which * 1024 : a0 + ((which - 2) & 1) * 1024;
        const float bsc = which < 4 ? 1.f : 0.f;
#pragma unroll
        for (int ai = 0; ai < 2; ++ai)
#pragma unroll
            for (int m = 0; m < 4; ++m) { float* rowp = base + (size_t)(row0 + ai * HALF + m * 16) * 1024 + col0;
#pragma unroll
                for (int bj = 0; bj < 2; ++bj)
#pragma unroll
                    for (int n = 0; n < 2; ++n) {
                        const f32x4 bvv = *(const f32x4*)(bptr + col0 + bj * HALF + n * 16);
                        f32x4 v = acc[ai][bj][m][n] + bvv * bsc;
#pragma unroll
                        for (int e = 0; e < 4; ++e) { const float sg = sigm(v[e]); const float ex = __expf(-0.6065306597126334f * sg); v[e] = which < 2 ? ex : (which < 4 ? sg : v[e]); }
                        *(f32x4*)(rowp + bj * HALF + n * 16) = v;
                    } }
    }
};
struct EpiRes {
    static constexpr bool PERM = false, AFTER_DRAIN = false;
    float* X; const float* gate;
    float alpha;
    __device__ __forceinline__ void operator()(const f32x4 (&acc)[2][2][4][2], const Unit& u, int wr, int wc, int fr, int fq) const {
        const int row0 = u.pm * BM + wr * 64 + fr, col0 = u.pn * BM + wc * 32 + 4 * fq;
        const int bidx = u.pm < 16 ? 0 : 1 + ((u.pm - 16) >> 2);
        const float* gp = gate + (size_t)bidx * 12288 + col0;
        f32x4 gv[2][2];
#pragma unroll
        for (int bj = 0; bj < 2; ++bj)
#pragma unroll
            for (int n = 0; n < 2; ++n) gv[bj][n] = *(const f32x4*)(gp + bj * HALF + n * 16);
#pragma unroll
        for (int ai = 0; ai < 2; ++ai)
#pragma unroll
            for (int m = 0; m < 4; ++m) { float* rowp = X + (size_t)(row0 + ai * HALF + m * 16) * 2048 + col0;
#pragma unroll
                for (int bj = 0; bj < 2; ++bj)
#pragma unroll
                    for (int n = 0; n < 2; ++n) {
                        f32x4* p = (f32x4*)(rowp + bj * HALF + n * 16);
                        const f32x4 xv = *p;
                        *p = xv * alpha + gv[bj][n] * acc[ai][bj][m][n];
                    } }
    }
};
struct EpiRelu2 {
    static constexpr bool PERM = true, AFTER_DRAIN = false;
    bf16_t* O; int ldc;
    __device__ __forceinline__ void operator()(const f32x4 (&acc)[2][2][4][2], const Unit& u, int wr, int wc, int fr, int fq) const {
        const int row0 = u.pm * BM + wr * 64 + fr, col0 = u.pn * BM + wc * 32 + 8 * fq;
#pragma unroll
        for (int ai = 0; ai < 2; ++ai)
#pragma unroll
            for (int m = 0; m < 4; ++m) { bf16_t* rowp = O + (size_t)(row0 + ai * HALF + m * 16) * ldc + col0;
#pragma unroll
                for (int bj = 0; bj < 2; ++bj) { f32x4 v0 = acc[ai][bj][m][0], v1 = acc[ai][bj][m][1];
#pragma unroll
                    for (int e = 0; e < 4; ++e) { const float a = fmaxf(v0[e], 0.f), b = fmaxf(v1[e], 0.f); v0[e] = a * a; v1[e] = b * b; }
                    u32x4 w; w.x = cvt_pk_bf16(v0[0], v0[1]); w.y = cvt_pk_bf16(v0[2], v0[3]); w.z = cvt_pk_bf16(v1[0], v1[1]); w.w = cvt_pk_bf16(v1[2], v1[3]);
                    *(u32x4*)(rowp + bj * HALF) = w; } }
    }
};

template <class Epi, class Sched, bool ALIGN_EPI = false, bool SP2 = false>
__device__ __forceinline__ void gemm_phase(PG8_LAS unsigned char* lds, const Gemm g, const Sched& S, const Epi& E) {
    int tid = threadIdx.x; asm volatile("" : "+v"(tid)); const int wid = __builtin_amdgcn_readfirstlane(tid >> 6), lane = tid & 63, wr = wid >> 2, wc = wid & 3, fr = lane & 15, fq = lane >> 4;
    const int K = g.K, nt = K / BK;
    unsigned voffA[2], voffB[2];
#pragma unroll
    for (int i = 0; i < 2; ++i) { int R, C; stage_rc(tid * 16 + i * 8192, R, C); const int Rb = Epi::PERM ? ((R & ~31) + perm32(R & 31)) : R;
        voffA[i] = (unsigned)(R * K + C) * 2u; voffB[i] = (unsigned)(Rb * K + C) * 2u; }
    const size_t kstep = (size_t)(BK * 2);
    const size_t hstep = (size_t)HALF * K * 2;
    const size_t tstep = 2 * hstep;
    const unsigned ldsw = (unsigned)wid * 1024u;
    const int aoff = lds_byte(wr * 64 + fr, fq * 8), boff = lds_byte(wc * 32 + fr, fq * 8);
#define PG8_SA(b, h) (((b) * 2 + (h)) * HTB)
#define PG8_SB(b, h) ((4 + (b) * 2 + (h)) * HTB)
#define PG8_STAGE(bufoff, gbase, voff) do { _Pragma("unroll") for (int _i = 0; _i < 2; ++_i) \
        __builtin_amdgcn_global_load_lds((const unsigned*)((const char*)(gbase) + (voff)[_i]), (PG8_LAS unsigned*)(lds + (bufoff) + ldsw + _i * 8192), 16, 0, 0); } while (0)
#define PG8_LDA(dst, b, h) do { _Pragma("unroll") for (int m = 0; m < 4; ++m) _Pragma("unroll") for (int k = 0; k < 2; ++k) dst[m][k] = *(const PG8_LAS bf16x8*)(lds + PG8_SA(b, h) + aoff + m * 2048 + k * 1024); } while (0)
#define PG8_LDB(dst, b, h) do { _Pragma("unroll") for (int n = 0; n < 2; ++n) _Pragma("unroll") for (int k = 0; k < 2; ++k) dst[n][k] = *(const PG8_LAS bf16x8*)(lds + PG8_SB(b, h) + boff + n * 2048 + k * 1024); } while (0)
#define PG8_MMA(ai, bj, At, Bt) do { __builtin_amdgcn_s_setprio(1); _Pragma("unroll") for (int m = 0; m < 4; ++m) _Pragma("unroll") for (int n = 0; n < 2; ++n) _Pragma("unroll") for (int k = 0; k < 2; ++k) \
        acc[ai][bj][m][n] = __builtin_amdgcn_mfma_f32_16x16x32_bf16(Bt[n][k], At[m][k], acc[ai][bj][m][n], 0, 0, 0); __builtin_amdgcn_s_setprio(0); } while (0)
#define PG8_WAIT_V(n) asm volatile("s_waitcnt vmcnt(" #n ")" ::: "memory")
#define PG8_WAIT_L(n) asm volatile("s_waitcnt lgkmcnt(" #n ")" ::: "memory")
#define PG8_BAR __builtin_amdgcn_s_barrier()
#define PG8_SCHED __builtin_amdgcn_sched_barrier(0)
    Unit cur, nxt; int ui = 0;
    if (!S.next(0, cur)) return;
    f32x4 acc[2][2][4][2];
#pragma unroll
    for (int a = 0; a < 2; ++a)
#pragma unroll
        for (int b = 0; b < 2; ++b)
#pragma unroll
            for (int m = 0; m < 4; ++m)
#pragma unroll
                for (int n = 0; n < 2; ++n) acc[a][b][m][n] = (f32x4){0.f, 0.f, 0.f, 0.f};
    bf16x8 At[4][2], B0[2][2], B1[2][2];
    const char* cA = (const char*)g.A + (size_t)cur.pm * tstep; const char* cB = (const char*)g.Bt + (size_t)cur.pn * tstep;
    S.a_ready(cur);
    if constexpr (SP2) {
        PG8_STAGE(PG8_SB(0, 0), cB, voffB); PG8_STAGE(PG8_SB(0, 1), cB + hstep, voffB); PG8_STAGE(PG8_SA(0, 0), cA, voffA); PG8_STAGE(PG8_SA(0, 1), cA + hstep, voffA);
        if (wr == 1) PG8_BAR;
        PG8_WAIT_V(2); PG8_BAR;
        PG8_STAGE(PG8_SB(1, 0), cB + kstep, voffB); PG8_STAGE(PG8_SA(1, 0), cA + kstep, voffA); PG8_STAGE(PG8_SB(1, 1), cB + hstep + kstep, voffB);
        PG8_WAIT_V(6); PG8_BAR;
    } else {
        PG8_STAGE(PG8_SB(0, 0), cB, voffB); PG8_STAGE(PG8_SA(0, 0), cA, voffA); PG8_STAGE(PG8_SB(0, 1), cB + hstep, voffB); PG8_STAGE(PG8_SA(0, 1), cA + hstep, voffA);
        if (wr == 1) PG8_BAR;
        PG8_WAIT_V(4); PG8_BAR;
        PG8_STAGE(PG8_SB(1, 0), cB + kstep, voffB); PG8_STAGE(PG8_SA(1, 0), cA + kstep, voffA); PG8_STAGE(PG8_SB(1, 1), cB + hstep + kstep, voffB);
        PG8_WAIT_V(6); PG8_BAR;
    }
    for (;;) {
        const bool has_next = S.next(ui + 1, nxt);
        const char* nA = has_next ? (const char*)g.A + (size_t)nxt.pm * tstep : cA; const char* nB = has_next ? (const char*)g.Bt + (size_t)nxt.pn * tstep : cB;
        for (int t = 0; t < nt; t += 2) {
            const bool last = (t == nt - 2);
            const char* a1 = cA + (size_t)(t + 1) * kstep;
            const char* a2 = last ? nA : cA + (size_t)(t + 2) * kstep; const char* b2 = last ? nB : cB + (size_t)(t + 2) * kstep;
            const char* a3 = a2 + kstep; const char* b3 = b2 + kstep;
            if (last && has_next) S.a_ready(nxt);
            if constexpr (SP2) {
            PG8_LDB(B0, 0, 0); PG8_LDB(B1, 0, 1); PG8_SCHED; PG8_LDA(At, 0, 0); PG8_STAGE(PG8_SA(1, 1), a1 + hstep, voffA);
            PG8_WAIT_V(8); PG8_WAIT_L(0); PG8_BAR; PG8_MMA(0, 0, At, B0); PG8_MMA(0, 1, At, B1); PG8_BAR; PG8_SCHED;
            PG8_LDA(At, 0, 1); PG8_STAGE(PG8_SB(0, 0), b2, voffB); PG8_STAGE(PG8_SB(0, 1), b2 + hstep, voffB); PG8_STAGE(PG8_SA(0, 0), a2, voffA);
            PG8_WAIT_V(8); PG8_WAIT_L(0); PG8_BAR; PG8_MMA(1, 0, At, B0); PG8_MMA(1, 1, At, B1); PG8_BAR; PG8_SCHED;
            PG8_LDB(B0, 1, 0); PG8_LDB(B1, 1, 1); PG8_SCHED; PG8_LDA(At, 1, 0); PG8_STAGE(PG8_SA(0, 1), a2 + hstep, voffA);
            PG8_WAIT_V(8); PG8_WAIT_L(0); PG8_BAR; PG8_MMA(0, 0, At, B0); PG8_MMA(0, 1, At, B1); PG8_BAR; PG8_SCHED;
            PG8_LDA(At, 1, 1); PG8_STAGE(PG8_SB(1, 0), b3, voffB); PG8_STAGE(PG8_SB(1, 1), b3 + hstep, voffB); PG8_STAGE(PG8_SA(1, 0), a3, voffA);
            PG8_WAIT_V(8); PG8_WAIT_L(0); PG8_BAR; PG8_MMA(1, 0, At, B0); PG8_MMA(1, 1, At, B1); PG8_BAR; PG8_SCHED;
            } else {
            PG8_LDB(B0, 0, 0); PG8_SCHED; PG8_LDA(At, 0, 0); PG8_STAGE(PG8_SA(1, 1), a1 + hstep, voffA);
            PG8_WAIT_L(8); PG8_BAR; PG8_WAIT_L(0); PG8_MMA(0, 0, At, B0); PG8_BAR; PG8_SCHED;
            PG8_LDB(B1, 0, 1); PG8_STAGE(PG8_SB(0, 0), b2, voffB);
            PG8_BAR; PG8_WAIT_L(0); PG8_MMA(0, 1, At, B1); PG8_BAR;
            PG8_LDA(At, 0, 1); PG8_STAGE(PG8_SA(0, 0), a2, voffA);
            PG8_BAR; PG8_WAIT_L(0); PG8_MMA(1, 0, At, B0); PG8_BAR; PG8_SCHED;
            PG8_STAGE(PG8_SB(0, 1), b2 + hstep, voffB);
            PG8_WAIT_V(6); PG8_BAR; PG8_MMA(1, 1, At, B1); PG8_BAR;
            PG8_LDB(B0, 1, 0); PG8_SCHED; PG8_LDA(At, 1, 0); PG8_STAGE(PG8_SA(0, 1), a2 + hstep, voffA);
            PG8_WAIT_L(8); PG8_BAR; PG8_WAIT_L(0); PG8_MMA(0, 0, At, B0); PG8_BAR; PG8_SCHED;
            PG8_LDB(B1, 1, 1); PG8_STAGE(PG8_SB(1, 0), b3, voffB);
            PG8_BAR; PG8_WAIT_L(0); PG8_MMA(0, 1, At, B1); PG8_BAR;
            PG8_LDA(At, 1, 1); PG8_STAGE(PG8_SA(1, 0), a3, voffA);
            PG8_BAR; PG8_WAIT_L(0); PG8_MMA(1, 0, At, B0); PG8_BAR; PG8_SCHED;
            PG8_STAGE(PG8_SB(1, 1), b3 + hstep, voffB);
            PG8_WAIT_V(6); PG8_BAR; PG8_MMA(1, 1, At, B1); PG8_BAR;
            }
        }
        if constexpr (ALIGN_EPI) { if (wr == 0) PG8_BAR; }
        if constexpr (!Epi::AFTER_DRAIN) { int fr2 = fr, fq2 = fq; asm volatile("" : "+v"(fr2), "+v"(fq2)); E(acc, cur, wr, wc, fr2, fq2); S.done(cur); }
        if (!has_next) break;
#pragma unroll
        for (int a = 0; a < 2; ++a)
#pragma unroll
            for (int b = 0; b < 2; ++b)
#pragma unroll
                for (int m = 0; m < 4; ++m)
#pragma unroll
                    for (int n = 0; n < 2; ++n) acc[a][b][m][n] = (f32x4){0.f, 0.f, 0.f, 0.f};
        cur = nxt; cA = nA; cB = nB; ++ui;
        if constexpr (ALIGN_EPI) { if (wr == 1) PG8_BAR; }
    }
    PG8_WAIT_V(0);
    if constexpr (!ALIGN_EPI) { if (wr == 0) PG8_BAR; }
    PG8_BAR;
    if constexpr (Epi::AFTER_DRAIN) { E.fused(acc, cur, wr, wc, fr, fq, lds, wid, lane); S.done(cur); }
#undef PG8_SA
#undef PG8_SB
#undef PG8_STAGE
#undef PG8_LDA
#undef PG8_LDB
#undef PG8_MMA
#undef PG8_WAIT_V
#undef PG8_WAIT_L
#undef PG8_BAR
#undef PG8_SCHED
}
}

using f4 = pg8::f32x4;
typedef unsigned short bf16_t;
constexpr int NT = 512;
constexpr int M = 8192, D = 2048, DR = 1024, NPAD = 6656, DFF = 8192, KL = 384, NL = 5120;
constexpr int DEPTH = 2;
constexpr float ALPHA = 1.4142135623730951f;
constexpr float LN_EPS = 1e-5f, GN_EPS = 64e-5f;
constexpr int LDS_BYTES = 147456;

constexpr size_t al256(size_t x) { return (x + 255) & ~(size_t)255; }
constexpr size_t FILT_CTX_PER = (size_t)2 * 1024 * 528, FILT_LAT_PER = (size_t)2 * 1024 * 2064;
constexpr size_t WS_MOD = 16384;
constexpr size_t WS_FH2 = al256(WS_MOD + (size_t)2 * 5 * 12288 * 4);
constexpr size_t WS_FILT = al256(WS_FH2 + (size_t)2 * 1280 * 64 * 4);
constexpr size_t WS_WIN = al256(WS_FILT + 2 * (FILT_CTX_PER + FILT_LAT_PER) * 4);
constexpr size_t WS_WOUT = WS_WIN + (size_t)NPAD * D * 2;
constexpr size_t WS_W1 = WS_WOUT + (size_t)D * D * 2;
constexpr size_t WS_W2 = WS_W1 + (size_t)DFF * D * 2;
constexpr size_t WS_WL = WS_W2 + (size_t)D * DFF * 2;
constexpr size_t WS_H = WS_WL + (size_t)NL * KL * 2;
constexpr size_t WS_MIX = WS_H + (size_t)M * D * 2;
constexpr size_t WS_LACT = WS_MIX + (size_t)M * D * 2;
constexpr size_t WS_PROJ = WS_LACT + (size_t)M * KL * 2;
constexpr size_t WS_RW = WS_PROJ + (size_t)M * 6144 * 4;
constexpr size_t WS_HT = WS_RW + (size_t)9 * M * 1024 * 4;
constexpr size_t WS_FILTB = WS_HT + (size_t)3 * 1024 * M * 2;
constexpr size_t FILTB_CTX = (size_t)2 * 1024 * 520, FILTB_LAT = (size_t)2 * 1024 * 2056, FILTB_PER = FILTB_CTX + FILTB_LAT;
constexpr size_t WS_END = WS_FILTB + 2 * FILTB_PER * 2;
static_assert(WS_END <= (size_t)805306368, "workspace map too large");
constexpr size_t AS = (size_t)M * 1024;
constexpr size_t OUT_STATE = (size_t)16777216;

__device__ __forceinline__ int tid_l() { int t = threadIdx.x; asm volatile("" : "+v"(t)); return t; }
struct Params { const float* in[33]; float* out; unsigned char* ws; int ph_lo, ph_hi; };
typedef const __attribute__((address_space(4))) Params CParams;

__device__ __forceinline__ float wave_sum(float v) {
#pragma unroll
    for (int o = 1; o < 64; o <<= 1) v += __shfl_xor(v, o);
    return v;
}
typedef __bf16 bf16x2_t __attribute__((ext_vector_type(2)));
typedef float f32x2_t __attribute__((ext_vector_type(2)));
__device__ __forceinline__ unsigned pk2(float lo, float hi) { const f32x2_t v = {lo, hi}; const bf16x2_t b = __builtin_convertvector(v, bf16x2_t); return __builtin_bit_cast(unsigned, b); }
__device__ __forceinline__ bf16_t f2bf(float f) { unsigned u = __float_as_uint(f); u += 0x7FFFu + ((u >> 16) & 1u); return (bf16_t)(u >> 16); }
__device__ __forceinline__ float bf2f(unsigned short b) { return __uint_as_float(((unsigned)b) << 16); }
__device__ __forceinline__ float sigmf(float x) { return 1.f / (1.f + __expf(-x)); }

__device__ __forceinline__ void ph_mod(CParams& P, float* lds) {
    const int tid = tid_l();
    float* scond = lds;
    float* red = lds + 5 * 2048;
    const float* c = P.in[2]; const float* cctx = P.in[4];
    for (int i = tid; i < 5 * 2048; i += NT) { const int b = i >> 11, k = i & 2047; const float x = b == 0 ? cctx[k] : c[(b - 1) * 2048 + k]; scond[i] = x / (1.f + __expf(-x)); }
    __syncthreads();
    const float* w_ada = P.in[5]; const float* b_ada = P.in[6];
    float* mod = (float*)(P.ws + WS_MOD);
    const int kg = tid >> 5, c4 = tid & 31;
    for (int item = blockIdx.x; item < 192; item += gridDim.x) {
        const int l = item / 96, c0 = (item % 96) * 128;
        f4 acc[5];
#pragma unroll
        for (int b = 0; b < 5; ++b) acc[b] = (f4){0.f, 0.f, 0.f, 0.f};
        const float* wp = w_ada + ((size_t)l * 2048 + kg * 128) * 12288 + c0 + c4 * 4;
        const float* sc = scond + kg * 128;
#pragma unroll 8
        for (int k = 0; k < 128; ++k) {
            const f4 w = *(const f4*)(wp + (size_t)k * 12288);
#pragma unroll
            for (int b = 0; b < 5; ++b) acc[b] += w * sc[b * 2048 + k];
        }
#pragma unroll
        for (int b = 0; b < 5; ++b) *(f4*)(red + (kg * 5 + b) * 128 + c4 * 4) = acc[b];
        __syncthreads();
        for (int idx = tid; idx < 640; idx += NT) {
            const int b = idx >> 7, cc = idx & 127; float s = 0.f;
#pragma unroll
            for (int g = 0; g < 16; ++g) s += red[(g * 5 + b) * 128 + cc];
            mod[(size_t)(l * 5 + b) * 12288 + c0 + cc] = s + b_ada[(size_t)l * 12288 + c0 + cc];
        }
        __syncthreads();
    }
}

__device__ __forceinline__ void ph_filt_hidden(CParams& P) {
    const int lane = tid_l() & 63, wave = tid_l() >> 6;
    const int gw = blockIdx.x * 8 + wave, ngw = gridDim.x * 8;
    float* fh2 = (float*)(P.ws + WS_FH2);
    for (int it = gw; it < 2 * 1280; it += ngw) {
        const int l = it / 1280, q = it % 1280;
        const int seq = q < 256 ? 256 : 1024, p = q < 256 ? q : q - 256;
        const float t = (float)p / (float)(seq - 1);
        const float wang = (float)(6.283185307179586 / (double)seq) * (float)p;
        float z = 0.f;
        if (lane == 0) z = t;
        else if (lane <= 32) {
            const int fi = (lane - 1) & 15; const float st = (float)fi / 15.f; const float f = 1e-4f * (1.f - st) + 15.f * st;
            z = lane <= 16 ? cosf(f * wang) : -sinf(f * wang);
        }
        const float* w1 = P.in[19] + (size_t)l * 33 * 64; const float* b1 = P.in[20] + l * 64;
        const float* w2 = P.in[21] + (size_t)l * 64 * 64; const float* b2 = P.in[22] + l * 64;
        const float* fr = P.in[24] + l * 128;
        float a = b1[lane];
        for (int i = 0; i < 33; ++i) a += __shfl(z, i) * w1[i * 64 + lane];
        const float h1 = sinf(fr[lane] * a);
        float a2 = b2[lane];
        for (int i = 0; i < 64; ++i) a2 += __shfl(h1, i) * w2[i * 64 + lane];
        const float h2 = sinf(fr[64 + lane] * a2);
        fh2[((size_t)l * 1280 + q) * 64 + lane] = h2;
    }
}

__device__ __forceinline__ void transpose_item(const float* W, int K, int N, bf16_t* WT, float* scr, int item, int lane) {
    const int nblk = N / 32, kb = item / nblk, nb = item % nblk, k0 = 64 * kb, n0 = 32 * nb;
#pragma unroll 8
    for (int i = 0; i < 32; ++i) { const int kk = 2 * i + (lane >> 5); scr[kk * 33 + (lane & 31)] = W[(size_t)(k0 + kk) * N + n0 + (lane & 31)]; }
    asm volatile("s_waitcnt lgkmcnt(0)" ::: "memory");
    const int c = lane & 7;
#pragma unroll
    for (int j = 0; j < 4; ++j) { const int n = (lane >> 3) + 8 * j; const float* s = scr + (8 * c) * 33 + n;
        uint4 o; o.x = pk2(s[0 * 33], s[1 * 33]); o.y = pk2(s[2 * 33], s[3 * 33]); o.z = pk2(s[4 * 33], s[5 * 33]); o.w = pk2(s[6 * 33], s[7 * 33]);
        *(uint4*)(WT + (size_t)(n0 + n) * K + k0 + 8 * c) = o; }
    asm volatile("s_waitcnt lgkmcnt(0)" ::: "memory");
}
__device__ __forceinline__ void ph_convert(CParams& P, int l, float* lds) {
    const int lane = tid_l() & 63, wave = tid_l() >> 6;
    const int gw = blockIdx.x * 8 + wave, ngw = gridDim.x * 8;
    float* scr = lds + wave * (64 * 33);
    constexpr int I_IN = 32 * 201, I_OUT = 32 * 64, I_1 = 32 * 256, I_2 = 128 * 64;
    const float* w_in = P.in[7] + (size_t)l * 2048 * 6432; const float* w_out = P.in[26] + (size_t)l * 2048 * 2048;
    const float* w1 = P.in[31] + (size_t)l * 2048 * 8192; const float* w2 = P.in[32] + (size_t)l * 8192 * 2048;
    bf16_t* WIN = (bf16_t*)(P.ws + WS_WIN); bf16_t* WOUT = (bf16_t*)(P.ws + WS_WOUT); bf16_t* W1 = (bf16_t*)(P.ws + WS_W1); bf16_t* W2 = (bf16_t*)(P.ws + WS_W2);
    for (int it = gw; it < I_IN + I_OUT + I_1 + I_2; it += ngw) {
        int r = it;
        if (r < I_IN) { transpose_item(w_in, 2048, 6432, WIN, scr, r, lane); continue; } r -= I_IN;
        if (r < I_OUT) { transpose_item(w_out, 2048, 2048, WOUT, scr, r, lane); continue; } r -= I_OUT;
        if (r < I_1) { transpose_item(w1, 2048, 8192, W1, scr, r, lane); continue; } r -= I_1;
        transpose_item(w2, 8192, 2048, W2, scr, r, lane);
    }
    { uint4* z = (uint4*)(WIN + (size_t)6432 * 2048); const int n16 = 224 * 2048 * 2 / 16;
      for (int i = blockIdx.x * NT + tid_l(); i < n16; i += gridDim.x * NT) z[i] = make_uint4(0, 0, 0, 0); }
    { bf16_t* WL = (bf16_t*)(P.ws + WS_WL);
      const float* wup = P.in[9] + (size_t)l * 2 * 64 * 1024; const float* aup = P.in[11] + (size_t)l * 2 * 64 * 1024; const float* gup = P.in[13] + (size_t)l * 160 * 1024;
      for (int i = blockIdx.x * NT + tid_l(); i < NL * KL; i += gridDim.x * NT) {
          const int n = i / KL, k = i % KL; const int which = n >> 10, c = n & 1023; float v = 0.f;
          if (which < 2) { if (k < 64) v = wup[((size_t)which * 64 + k) * 1024 + c]; }
          else if (which < 4) { if (k >= 64 && k < 128) v = aup[((size_t)(which - 2) * 64 + (k - 64)) * 1024 + c]; }
          else { if (k >= 128 && k < 288) v = gup[(size_t)(k - 128) * 1024 + c]; }
          WL[i] = f2bf(v);
      } }
}

__device__ __forceinline__ void row_pass(const float* src, float* dstX, const float* ag, const float* ab, const float* msh, const float* msc, bf16_t* hrow, int lane) {
    f4 v[8]; float s = 0.f;
#pragma unroll
    for (int j = 0; j < 8; ++j) { v[j] = *(const f4*)(src + j * 256 + lane * 4); s += (v[j][0] + v[j][1]) + (v[j][2] + v[j][3]); }
    if (ag) {
        const float mean = wave_sum(s) * (1.f / 2048.f); float s2 = 0.f;
#pragma unroll
        for (int j = 0; j < 8; ++j) { v[j] = v[j] - mean; s2 += (v[j][0] * v[j][0] + v[j][1] * v[j][1]) + (v[j][2] * v[j][2] + v[j][3] * v[j][3]); }
        const float rstd = rsqrtf(wave_sum(s2) * (1.f / 2048.f) + LN_EPS);
        s = 0.f;
#pragma unroll
        for (int j = 0; j < 8; ++j) { const f4 g = *(const f4*)(ag + j * 256 + lane * 4), b = *(const f4*)(ab + j * 256 + lane * 4);
            v[j] = v[j] * rstd * g + b; s += (v[j][0] + v[j][1]) + (v[j][2] + v[j][3]); }
    }
#pragma unroll
    for (int j = 0; j < 8; ++j) *(f4*)(dstX + j * 256 + lane * 4) = v[j];
    if (msh) {
        const float mean = wave_sum(s) * (1.f / 2048.f); float s2 = 0.f;
#pragma unroll
        for (int j = 0; j < 8; ++j) { v[j] = v[j] - mean; s2 += (v[j][0] * v[j][0] + v[j][1] * v[j][1]) + (v[j][2] * v[j][2] + v[j][3] * v[j][3]); }
        const float rstd = rsqrtf(wave_sum(s2) * (1.f / 2048.f) + LN_EPS);
#pragma unroll
        for (int j = 0; j < 8; ++j) { const f4 sh = *(const f4*)(msh + j * 256 + lane * 4), sc = *(const f4*)(msc + j * 256 + lane * 4);
            const f4 h = v[j] * rstd * (sc + 1.f) + sh;
            uint2 w; w.x = pk2(h[0], h[1]); w.y = pk2(h[2], h[3]);
            *(uint2*)(hrow + j * 256 + lane * 4) = w; }
    }
}
__device__ __forceinline__ void ph_rowpass(CParams& P, int mode, int l) {
    const int lane = tid_l() & 63, wave = tid_l() >> 6;
    const int gw = blockIdx.x * 8 + wave, ngw = gridDim.x * 8;
    const float* mod = (const float*)(P.ws + WS_MOD);
    bf16_t* H = (bf16_t*)(P.ws + WS_H);
    for (int m = gw; m < M; m += ngw) {
        const int bidx = m < 4096 ? 0 : 1 + ((m - 4096) >> 10);
        const float* src; const float* ag = nullptr; const float* ab = nullptr; const float* msh = nullptr; const float* msc = nullptr;
        float* dst = P.out + (size_t)m * 2048;
        if (mode == 0) { src = m < 4096 ? P.in[0] + (size_t)m * 2048 : P.in[1] + (size_t)(m - 4096) * 2048;
            msh = mod + (size_t)(0 * 5 + bidx) * 12288; msc = msh + 2048; }
        else if (mode == 1) { src = dst; ag = P.in[27] + l * 2048; ab = P.in[28] + l * 2048;
            msh = mod + (size_t)(l * 5 + bidx) * 12288 + 3 * 2048; msc = msh + 2048; }
        else { src = dst; ag = P.in[29] + l * 2048; ab = P.in[30] + l * 2048;
            if (l + 1 < DEPTH) { msh = mod + (size_t)((l + 1) * 5 + bidx) * 12288; msc = msh + 2048; } }
        row_pass(src, dst, ag, ab, msh, msc, H + (size_t)m * 2048, lane);
    }
}

__device__ __forceinline__ void ph_filt_final(CParams& P, float* lds) {
    const int tid = tid_l(); const int cl = tid & 31, ps = tid >> 5;
    float* red = lds;
    for (int item = blockIdx.x; item < 256; item += gridDim.x) {
        const int cgp = item & 31, o = (item >> 5) & 1, ss = (item >> 6) & 1, l = item >> 7;
        const int L = ss ? 1024 : 256, GL = 2 * L + 16;
        const int c = cgp * 32 + cl;
        const float* h2 = (const float*)(P.ws + WS_FH2) + ((size_t)l * 1280 + (ss ? 256 : 0)) * 64;
        const float* w3 = P.in[23] + (size_t)l * 64 * 4096;
        float wf[64], wb[64];
#pragma unroll
        for (int j = 0; j < 64; ++j) { wf[j] = w3[(size_t)j * 4096 + (o * 2 + 0) * 1024 + c]; wb[j] = w3[(size_t)j * 4096 + (o * 2 + 1) * 1024 + c]; }
        const float st = (float)c / 1023.f;
        const float delta = fabsf(-3.0701134573253943f * (1.f - st) + -15.350567286626972f * st);
        float* gg = (float*)(P.ws + WS_FILT) + (size_t)l * (FILT_CTX_PER + FILT_LAT_PER) + (ss ? FILT_CTX_PER : 0) + ((size_t)o * 1024 + c) * GL;
        float asum = 0.f;
        for (int p = ps; p < L; p += 16) {
            const float* hp = h2 + (size_t)p * 64;
            float af = 0.f, ab = 0.f;
#pragma unroll
            for (int j4 = 0; j4 < 16; ++j4) { const f4 hv = *(const f4*)(hp + j4 * 4);
#pragma unroll
                for (int e = 0; e < 4; ++e) { af += hv[e] * wf[j4 * 4 + e]; ab += hv[e] * wb[j4 * 4 + e]; } }
            const float t = (float)p / (float)(L - 1);
            const float dec = expf(-t * delta);
            af *= dec; ab *= dec;
            asum += fabsf(af) + fabsf(ab);
            gg[p + L + 7] = af;
            if (p > 0) gg[L + 7 - p] = ab;
        }
        if (ps == 0) { for (int x = 0; x < 8; ++x) gg[x] = 0.f; for (int x = 2 * L + 7; x < GL; ++x) gg[x] = 0.f; }
        red[ps * 32 + cl] = asum;
        __syncthreads();
        float tot = 0.f;
#pragma unroll
        for (int g = 0; g < 16; ++g) tot += red[g * 32 + cl];
        const float inv = 1.f / tot;
        __syncthreads();
        bf16_t* gr = (bf16_t*)(P.ws + WS_FILTB) + (size_t)l * FILTB_PER + (ss ? FILTB_CTX : 0) + ((size_t)o * 1024 + c) * (2 * L + 8);
        for (int p = ps; p < L; p += 16) {
            gr[L - 1 - p] = f2bf(gg[p + L + 7] * inv);
            if (p > 0) gr[L - 1 + p] = f2bf(gg[L + 7 - p] * inv);
        }
        if (ps == 0) { for (int x = 2 * L - 1; x < 2 * L + 8; ++x) gr[x] = 0; }
    }
}

template <bool LAT>
__device__ __forceinline__ void convprep_item(CParams& P, int l, float* tile, int ct, int m0, int lane, int wave) {
    constexpr int NR = LAT ? 3 : 1;
    const float* proj = (const float*)(P.ws + WS_PROJ);
    float* RW = (float*)(P.ws + WS_RW);
    const float* cw = P.in[8] + (size_t)l * 9 * 6144;
    const int c = ct * 64 + lane;
    float wgt[9];
#pragma unroll
    for (int q = 0; q < 9; ++q) wgt[q] = cw[q * 6144 + c];
    const int row = LAT ? (((m0 - 4096) & 1023) >> 6) : 0;
    const int p0 = LAT ? wave * 8 : (m0 & 255) + wave * 8;
    constexpr int PMAX = LAT ? 63 : 255;
    const float* pc = proj + (size_t)(m0 + wave * 8) * 6144 + c;
    float u[NR][10];
#pragma unroll
    for (int ry = 0; ry < NR; ++ry) {
        const int dy = LAT ? ry - 1 : 0;
        const bool rok = LAT ? (row + dy >= 0 && row + dy <= 15) : true;
#pragma unroll
        for (int xx = 0; xx < 10; ++xx) {
            const int pp = p0 + xx - 1;
            const bool ok = rok && pp >= 0 && pp <= PMAX;
            u[ry][xx] = ok ? pc[(ptrdiff_t)(dy * 64 + xx - 1) * 6144] : 0.f;
        }
    }
    float y[8];
#pragma unroll
    for (int i = 0; i < 8; ++i) {
        float a = 0.f;
#pragma unroll
        for (int ry = 0; ry < NR; ++ry)
#pragma unroll
            for (int dx = 0; dx < 3; ++dx) a += u[ry][i + dx] * wgt[(LAT ? ry : 1) * 3 + dx];
        y[i] = a;
    }
    if (ct < 48) {
        const int arr = ct >> 4; const int cc = (ct & 15) * 64 + lane;
        float* dst = RW + (size_t)arr * AS + (size_t)(m0 + wave * 8) * 1024 + cc;
#pragma unroll
        for (int i = 0; i < 8; ++i) dst[(size_t)i * 1024] = y[i];
        if (arr == 1) {
            const float kkw = P.in[14][l * 1024 + cc];
            float* dk = RW + (size_t)3 * AS + (size_t)(m0 + wave * 8) * 1024 + cc;
#pragma unroll
            for (int i = 0; i < 8; ++i) { const float kr = y[i] * kkw; const float ssq = wave_sum(kr * kr); dk[(size_t)i * 1024] = kr * rsqrtf(ssq + 1e-12f); }
        }
    } else {
#pragma unroll
        for (int i = 0; i < 8; ++i) tile[lane * 65 + wave * 8 + i] = y[i];
    }
}
__device__ __forceinline__ void ph_convprep(CParams& P, int l, float* lds) {
    const int tid = tid_l(), lane = tid & 63, wave = tid >> 6;
    float* tile = lds;
    bf16_t* HT = (bf16_t*)(P.ws + WS_HT);
    for (int item = blockIdx.x; item < 128 * 96; item += gridDim.x) {
        const int ct = item % 96, tt = item / 96;
        const int m0 = tt * 64;
        if (m0 >= 4096) convprep_item<true>(P, l, tile, ct, m0, lane, wave);
        else convprep_item<false>(P, l, tile, ct, m0, lane, wave);
        if (ct >= 48) {
            __syncthreads();
            const int which = (ct - 48) >> 4; const int cbase = ((ct - 48) & 15) * 64;
#pragma unroll
            for (int i = 0; i < 8; ++i) { const int ch = wave * 8 + i; HT[((size_t)which * 1024 + cbase + ch) * M + m0 + lane] = f2bf(tile[ch * 65 + lane]); }
            __syncthreads();
        }
    }
}

typedef float f32x16 __attribute__((ext_vector_type(16)));
typedef short s16x8 __attribute__((ext_vector_type(8)));
typedef short s16x4 __attribute__((ext_vector_type(4)));
typedef unsigned u32x4_t __attribute__((ext_vector_type(4)));
#define MFMA16(a, b, c) __builtin_amdgcn_mfma_f32_16x16x32_bf16((a), (b), (c), 0, 0, 0)
__device__ __forceinline__ s16x8 mk8(unsigned a, unsigned b, unsigned c, unsigned d) { u32x4_t v = {a, b, c, d}; return __builtin_bit_cast(s16x8, v); }
__device__ __forceinline__ s16x8 pack_lo(f4 x) { return mk8(pk2(x[0], x[1]), pk2(x[2], x[3]), 0u, 0u); }
__device__ __forceinline__ s16x8 pack_2(f4 lo, f4 hi) { return mk8(pk2(lo[0], lo[1]), pk2(lo[2], lo[3]), pk2(hi[0], hi[1]), pk2(hi[2], hi[3])); }
constexpr int SC_KQ = 0, SC_RQ = 2304, SC_KD = 4608, SC_BD = 6912, SC_KDCT = 9216, SC_NBDCT = 11264, SC_VT = 13312, SC_GC = 15360, SC_BUF = 15616;

__device__ __forceinline__ void chain_chunk(const unsigned char* buf, f4 (&H)[4][4], float* gO, int mrow0, int mstep, int lane) {
    const int r = lane & 15, g = lane >> 4;
    const f4 z = (f4){0.f, 0.f, 0.f, 0.f};
    const unsigned char* rb = buf + r * 144 + g * 16;
    const s16x8 fKq0 = *(const s16x8*)(rb + SC_KQ), fKq1 = *(const s16x8*)(rb + SC_KQ + 64);
    const s16x8 fRq0 = *(const s16x8*)(rb + SC_RQ), fRq1 = *(const s16x8*)(rb + SC_RQ + 64);
    const s16x8 fKd0 = *(const s16x8*)(rb + SC_KD), fKd1 = *(const s16x8*)(rb + SC_KD + 64);
    const s16x8 fBd0 = *(const s16x8*)(rb + SC_BD), fBd1 = *(const s16x8*)(rb + SC_BD + 64);
    f4 Xd = MFMA16(fKq1, fBd1, MFMA16(fKq0, fBd0, z));
    f4 XTd = MFMA16(fBd1, fKq1, MFMA16(fBd0, fKq0, z));
    f4 MkkT = MFMA16(fKd1, fKq1, MFMA16(fKd0, fKq0, z));
    f4 MrkT = MFMA16(fKd1, fRq1, MFMA16(fKd0, fRq0, z));
    f4 MrbT = MFMA16(fBd1, fRq1, MFMA16(fBd0, fRq0, z));
    f4 eye;
#pragma unroll
    for (int q = 0; q < 4; ++q) { const int ri = 4 * g + q;
        Xd[q] = ri > r ? -Xd[q] : 0.f; XTd[q] = ri < r ? -XTd[q] : 0.f; MkkT[q] = ri < r ? MkkT[q] : 0.f;
        MrkT[q] = ri <= r ? MrkT[q] : 0.f; MrbT[q] = ri <= r ? -MrbT[q] : 0.f; eye[q] = ri == r ? 1.f : 0.f; }
    const s16x8 pX = pack_lo(Xd), pXT = pack_lo(XTd);
    const f4 X2d = MFMA16(pXT, pX, z), X2Td = MFMA16(pX, pXT, z);
    const s16x8 pX2 = pack_lo(X2d), pX2T = pack_lo(X2Td);
    const f4 X4d = MFMA16(pX2T, pX2, z), X4Td = MFMA16(pX2, pX2T, z);
    const f4 X8d = MFMA16(pack_lo(X4Td), pack_lo(X4d), z);
    const f4 U1T = MFMA16(pack_lo(X2d + eye), pack_lo(XTd + eye), z);
    const f4 U2T = MFMA16(pack_lo(X4d + eye), pack_lo(U1T), z);
    const f4 TT = MFMA16(pack_lo(X8d + eye), pack_lo(U2T), z);
    const s16x8 fTT = pack_lo(TT), fMkkT = pack_lo(MkkT), fOrb = pack_2(MrkT, MrbT);
    const unsigned char* pb = buf + r * 144 + g * 8;
    const uint2 k0l = *(const uint2*)(pb + SC_KQ), k0h = *(const uint2*)(pb + SC_KQ + 32), k1l = *(const uint2*)(pb + SC_KQ + 64), k1h = *(const uint2*)(pb + SC_KQ + 96);
    const uint2 r0l = *(const uint2*)(pb + SC_RQ), r0h = *(const uint2*)(pb + SC_RQ + 32), r1l = *(const uint2*)(pb + SC_RQ + 64), r1h = *(const uint2*)(pb + SC_RQ + 96);
    const s16x8 aK0 = mk8(k0l.x, k0l.y, k0h.x, k0h.y), aK1 = mk8(k1l.x, k1l.y, k1h.x, k1h.y);
    const s16x8 aR0 = mk8(r0l.x, r0l.y, r0h.x, r0h.y), aR1 = mk8(r1l.x, r1l.y, r1h.x, r1h.y);
#pragma unroll
    for (int vt = 0; vt < 4; ++vt) {
        const s16x8 h0 = pack_2(H[0][vt], H[1][vt]), h1 = pack_2(H[2][vt], H[3][vt]);
        f4 P0 = MFMA16(aK1, h1, MFMA16(aK0, h0, z));
        f4 O = MFMA16(aR1, h1, MFMA16(aR0, h0, z));
        const uint2 vv = *(const uint2*)(buf + SC_VT + (16 * vt + r) * 32 + g * 8);
        P0 = MFMA16(fMkkT, mk8(vv.x, vv.y, 0u, 0u), P0);
        const f4 Pm = MFMA16(fTT, pack_lo(P0), z);
        const s16x8 fB = mk8(vv.x, vv.y, pk2(Pm[0], Pm[1]), pk2(Pm[2], Pm[3]));
        O = MFMA16(fOrb, fB, O);
#pragma unroll
        for (int q = 0; q < 4; ++q) gO[(ptrdiff_t)(mrow0 + mstep * (4 * g + q)) * 1024 + 16 * vt + r] = O[q];
#pragma unroll
        for (int kt = 0; kt < 4; ++kt) {
            const unsigned char* pk = buf + SC_KDCT + (16 * kt + r) * 32 + g * 8;
            const uint2 al = *(const uint2*)pk, ah = *(const uint2*)(pk + 2048);
            const f4 gc = *(const f4*)(buf + SC_GC + (16 * kt + 4 * g) * 4);
            H[kt][vt] = MFMA16(mk8(al.x, al.y, ah.x, ah.y), fB, H[kt][vt] * gc);
        }
    }
}
typedef float f32x8 __attribute__((ext_vector_type(8)));
struct RawH { f32x16 w; f32x8 r, k, v, kk, a; };
__device__ __forceinline__ void prep_load(RawH& R, const float* RW, int d, int hf, int mrow0, int mstep, int colx) {
#pragma unroll
    for (int t = 0; t < 16; ++t) R.w[t] = RW[(4 + d) * AS + (size_t)(mrow0 + mstep * t) * 1024 + colx];
#pragma unroll
    for (int j = 0; j < 8; ++j) { const size_t off = (size_t)(mrow0 + mstep * (8 * hf + j)) * 1024 + colx;
        R.r[j] = RW[off]; R.k[j] = RW[AS + off]; R.v[j] = RW[2 * AS + off]; R.kk[j] = RW[3 * AS + off]; R.a[j] = RW[(6 + d) * AS + off]; }
}
__device__ __forceinline__ void prep_proc(const RawH& R, unsigned char* buf, int hf, float ka, int lane) {
    float G = 1.f;
    if (hf) {
#pragma unroll
        for (int t = 0; t < 8; ++t) G *= R.w[t]; }
    float GC = 1.f;
#pragma unroll
    for (int t = 0; t < 16; ++t) GC *= R.w[t];
    f32x8 kdi, bdi;
#pragma unroll
    for (int j = 0; j < 8; ++j) {
        const int t = 8 * hf + j;
        *(bf16_t*)(buf + SC_KQ + t * 144 + lane * 2) = f2bf(R.kk[j] * G);
        G *= hf ? R.w[8 + j] : R.w[j];
        *(bf16_t*)(buf + SC_RQ + t * 144 + lane * 2) = f2bf(R.r[j] * G);
        const float iG = __builtin_amdgcn_rcpf(G);
        const float kd = R.k[j] * (1.f + (R.a[j] - 1.f) * ka), bb = R.kk[j] * R.a[j];
        kdi[j] = kd * iG; bdi[j] = bb * iG;
        *(bf16_t*)(buf + SC_KD + t * 144 + lane * 2) = f2bf(kdi[j]);
        *(bf16_t*)(buf + SC_BD + t * 144 + lane * 2) = f2bf(bdi[j]);
    }
    uint4 o1, o2, o3;
    o1.x = pk2(kdi[0] * GC, kdi[1] * GC); o1.y = pk2(kdi[2] * GC, kdi[3] * GC); o1.z = pk2(kdi[4] * GC, kdi[5] * GC); o1.w = pk2(kdi[6] * GC, kdi[7] * GC);
    o2.x = pk2(-bdi[0] * GC, -bdi[1] * GC); o2.y = pk2(-bdi[2] * GC, -bdi[3] * GC); o2.z = pk2(-bdi[4] * GC, -bdi[5] * GC); o2.w = pk2(-bdi[6] * GC, -bdi[7] * GC);
    o3.x = pk2(R.v[0], R.v[1]); o3.y = pk2(R.v[2], R.v[3]); o3.z = pk2(R.v[4], R.v[5]); o3.w = pk2(R.v[6], R.v[7]);
    *(uint4*)(buf + SC_KDCT + lane * 32 + hf * 16) = o1;
    *(uint4*)(buf + SC_NBDCT + lane * 32 + hf * 16) = o2;
    *(uint4*)(buf + SC_VT + lane * 32 + hf * 16) = o3;
    if (hf) *(float*)(buf + SC_GC + lane * 4) = GC;
}
__device__ __forceinline__ void scan_item(CParams& P, int l, float* ldsf, int type, int b, int h) {
    unsigned char* lds = (unsigned char*)ldsf;
    const int tid = tid_l(), lane = tid & 63, wave = __builtin_amdgcn_readfirstlane(tid >> 6);
    const int L = type ? 256 : 1024, NCH = L / 16; const int mbase = type ? b * 256 : 4096 + b * 1024;
    if (wave < 2) {
        const int d = wave; const int mstep = d ? -1 : 1; const int mfirst = mbase + (d ? L - 1 : 0);
        const unsigned char* cbuf = lds + d * 2 * SC_BUF;
        float* gO = (float*)(P.ws + WS_PROJ) + (size_t)d * AS + h * 64;
        const int r = lane & 15, g = lane >> 4;
        f4 H[4][4];
        if (type == 0) { const float* s0 = P.in[3] + ((((size_t)b * 2 + l) * 2 + d) * 16 + h) * 4096;
#pragma unroll
            for (int kt = 0; kt < 4; ++kt)
#pragma unroll
                for (int vt = 0; vt < 4; ++vt) H[kt][vt] = *(const f4*)(s0 + (16 * vt + r) * 64 + 16 * kt + 4 * g); }
        else {
#pragma unroll
            for (int kt = 0; kt < 4; ++kt)
#pragma unroll
                for (int vt = 0; vt < 4; ++vt) H[kt][vt] = (f4){0.f, 0.f, 0.f, 0.f}; }
        __syncthreads();
        for (int c = 0; c < NCH; ++c) {
            chain_chunk(cbuf + (c & 1) * SC_BUF, H, gO, mfirst + mstep * 16 * c, mstep, lane);
            __syncthreads();
        }
        if (type == 1) { float* so = P.out + OUT_STATE + ((((size_t)b * 2 + l) * 2 + d) * 16 + h) * 4096;
#pragma unroll
            for (int kt = 0; kt < 4; ++kt)
#pragma unroll
                for (int vt = 0; vt < 4; ++vt) *(f4*)(so + (16 * vt + r) * 64 + 16 * kt + 4 * g) = H[kt][vt]; }
    } else if (wave < 6) {
        const int d = (wave - 2) >> 1, hf = (wave - 2) & 1; const int mstep = d ? -1 : 1; const int mfirst = mbase + (d ? L - 1 : 0);
        unsigned char* cbuf = lds + d * 2 * SC_BUF;
        const float* RW = (const float*)(P.ws + WS_RW);
        const int colx = h * 64 + lane;
        const float ka = P.in[15][l * 1024 + colx];
        RawH RA, RB;
        prep_load(RA, RW, d, hf, mfirst, mstep, colx);
        for (int c = 0; c < NCH; c += 2) {
            prep_load(RB, RW, d, hf, mfirst + mstep * 16 * (c + 1), mstep, colx);
            prep_proc(RA, cbuf, hf, ka, lane);
            __syncthreads();
            if (c + 2 < NCH) prep_load(RA, RW, d, hf, mfirst + mstep * 16 * (c + 2), mstep, colx);
            prep_proc(RB, cbuf + SC_BUF, hf, ka, lane);
            __syncthreads();
        }
        __syncthreads();
    } else {
        for (int c = 0; c <= NCH; ++c) __syncthreads();
    }
}

template <int L>
__device__ __forceinline__ void hym_conv(const bf16_t* cps, const bf16_t* ubs, f32x16& acc) {
    constexpr int ND = (L == 1024) ? 39 : 15;
#pragma unroll 3
    for (int dd = 0; dd < ND; ++dd) {
#pragma unroll
        for (int kh = 0; kh < 2; ++kh) {
            const bf16_t* ap = cps - 32 * dd + 16 * kh; const bf16_t* bp = ubs - 32 * dd + 16 * kh;
            const s16x4 alo = *(const s16x4*)ap, ahi = *(const s16x4*)(ap + 4);
            const s16x8 av = __builtin_shufflevector(alo, ahi, 0, 1, 2, 3, 4, 5, 6, 7);
            const s16x8 bv = *(const s16x8*)bp;
            acc = __builtin_amdgcn_mfma_f32_32x32x16_bf16(av, bv, acc, 0, 0, 0);
        }
    }
}
template <int L>
__device__ __forceinline__ void hyena_item(CParams& P, int l, float* ldsf, int cp2) {
    constexpr bool LAT = (L == 1024); constexpr int NB = LAT ? 4 : 16; constexpr int GRL = 2 * L + 8; constexpr int ROWL = L + 448;
    bf16_t* sCP = (bf16_t*)ldsf;
    bf16_t* sU = sCP + 16 * GRL;
    bf16_t* sZ = sU + 2 * NB * ROWL;
    const int tid = tid_l(), lane = tid & 63, wave = tid >> 6;
    const int c0 = cp2 * 2; const int mbase = LAT ? 4096 : 0;
    bf16_t* HT = (bf16_t*)(P.ws + WS_HT);
    const bf16_t* filtb = (const bf16_t*)(P.ws + WS_FILTB) + (size_t)l * FILTB_PER + (LAT ? FILTB_CTX : 0);
    for (int idx = tid; idx < 2 * NB * 56; idx += NT) { const int row = idx / 56, q = idx % 56;
        const int off = row * ROWL + (q < 28 ? q * 8 : 224 + L + (q - 28) * 8);
        *(uint4*)(sU + off) = make_uint4(0, 0, 0, 0); *(uint4*)(sZ + off) = make_uint4(0, 0, 0, 0); }
    for (int idx = tid; idx < 2 * 512; idx += NT) { const int ch = idx >> 9, q = idx & 511;
        const uint4 v = *(const uint4*)(HT + (size_t)(c0 + ch) * M + mbase + 8 * q);
        const int b = (8 * q) / L, t = (8 * q) % L; *(uint4*)(sU + (ch * NB + b) * ROWL + 224 + t) = v; }
    for (int idx = tid; idx < 16 * GRL; idx += NT) { const int y = idx % GRL, k = idx / GRL; const int sft = k & 3, o = (k >> 2) & 1, ch = k >> 3;
        const bf16_t* src = filtb + ((size_t)o * 1024 + c0 + ch) * GRL;
        sCP[idx] = (y + sft < GRL) ? src[y + sft] : (bf16_t)0; }
    __syncthreads();
    const int ch = wave >> 2, nt = wave & 3; const int c = c0 + ch;
    const int r = lane & 31, h = lane >> 5; const int Il = r >> 2, bl = r & 3;
    const int I = LAT ? 8 * nt + Il : Il; const int b = LAT ? bl : 4 * nt + bl;
    const int dlo = LAT ? 8 * nt - 31 : -7;
    const int X0 = L - 1 - (32 * dlo + r - 8 * h); const int sft = X0 & 3;
    const int urow = (ch * NB + b) * ROWL + 224;
    const int uoff = urow + 32 * (I - dlo) + 8 * h;
    f32x16 acc;
#pragma unroll
    for (int i = 0; i < 16; ++i) acc[i] = 0.f;
    hym_conv<L>(sCP + ((ch * 2 + 0) * 4 + sft) * GRL + (X0 - sft), sU + uoff, acc);
    const float bias1 = P.in[25][(l * 2 + 0) * 1024 + c], bias2 = P.in[25][(l * 2 + 1) * 1024 + c];
    const size_t gcol = (size_t)c * M + mbase + b * L + 32 * I + 4 * h;
    float z[16];
#pragma unroll
    for (int g4 = 0; g4 < 4; ++g4) {
        const int t0 = 32 * I + 8 * g4 + 4 * h;
        const uint2 xv = *(const uint2*)(HT + (size_t)1 * 1024 * M + gcol + 8 * g4);
        const uint2 uv = *(const uint2*)(sU + urow + t0);
        const float x1[4] = {__uint_as_float(xv.x << 16), __uint_as_float(xv.x & 0xffff0000u), __uint_as_float(xv.y << 16), __uint_as_float(xv.y & 0xffff0000u)};
        const float uu[4] = {__uint_as_float(uv.x << 16), __uint_as_float(uv.x & 0xffff0000u), __uint_as_float(uv.y << 16), __uint_as_float(uv.y & 0xffff0000u)};
#pragma unroll
        for (int e = 0; e < 4; ++e) z[4 * g4 + e] = x1[e] * (acc[4 * g4 + e] + bias1 * uu[e]);
        uint2 w; w.x = pk2(z[4 * g4], z[4 * g4 + 1]); w.y = pk2(z[4 * g4 + 2], z[4 * g4 + 3]);
        *(uint2*)(sZ + urow + t0) = w;
    }
    __syncthreads();
#pragma unroll
    for (int i = 0; i < 16; ++i) acc[i] = 0.f;
    hym_conv<L>(sCP + ((ch * 2 + 1) * 4 + sft) * GRL + (X0 - sft), sZ + uoff, acc);
#pragma unroll
    for (int g4 = 0; g4 < 4; ++g4) {
        const uint2 xv = *(const uint2*)(HT + (size_t)2 * 1024 * M + gcol + 8 * g4);
        const float x2[4] = {__uint_as_float(xv.x << 16), __uint_as_float(xv.x & 0xffff0000u), __uint_as_float(xv.y << 16), __uint_as_float(xv.y & 0xffff0000u)};
        float o4[4];
#pragma unroll
        for (int e = 0; e < 4; ++e) o4[e] = x2[e] * (acc[4 * g4 + e] + bias2 * z[4 * g4 + e]);
        uint2 w; w.x = pk2(o4[0], o4[1]); w.y = pk2(o4[2], o4[3]);
        *(uint2*)(HT + gcol + 8 * g4) = w;
    }
    __syncthreads();
}

__device__ __forceinline__ void ph_scan_hyena(CParams& P, int l, float* lds) {
    const int G = gridDim.x; constexpr int total = 64 + 256 + 512 + 512;
    for (int r = 0; r * G < total; ++r) {
        const int pos = (r & 1) ? G - 1 - (int)blockIdx.x : (int)blockIdx.x; const int j = r * G + pos;
        if (j >= total) continue;
        if (j < 64) scan_item(P, l, lds, 0, j >> 4, j & 15);
        else if (j < 320) scan_item(P, l, lds, 1, (j - 64) >> 4, (j - 64) & 15);
        else if (j < 832) hyena_item<1024>(P, l, lds, j - 320);
        else hyena_item<256>(P, l, lds, j - 832);
    }
}

__device__ __forceinline__ void ph_combine(CParams& P, int l, float* lds) {
    const int lane = tid_l() & 63, wave = tid_l() >> 6;
    const int gw = blockIdx.x * 8 + wave, ngw = gridDim.x * 8;
    const float* RW = (const float*)(P.ws + WS_RW);
    const float* O = (const float*)(P.ws + WS_PROJ);
    bf16_t* mix = (bf16_t*)(P.ws + WS_MIX);
    for (int m = gw; m < M; m += ngw) {
        const size_t rowo = (size_t)m * 1024 + lane * 4;
#pragma unroll
        for (int qi = 0; qi < 4; ++qi) {
            const size_t idx = rowo + qi * 256; const int cc = qi * 256 + lane * 4;
            const f4 o0 = *(const f4*)(O + idx), o1 = *(const f4*)(O + AS + idx);
            const f4 r = *(const f4*)(RW + idx), k = *(const f4*)(RW + AS + idx), v = *(const f4*)(RW + 2 * AS + idx);
            const f4 a0 = *(const f4*)(RW + 6 * AS + idx), a1 = *(const f4*)(RW + 7 * AS + idx), g = *(const f4*)(RW + 8 * AS + idx);
            const f4 lg = *(const f4*)(P.in[17] + l * 1024 + cc), lb = *(const f4*)(P.in[18] + l * 1024 + cc);
            const f4 ka = *(const f4*)(P.in[15] + l * 1024 + cc), rk = *(const f4*)(P.in[16] + l * 1024 + cc);
            const f4 o = o0 + o1;
            const f4 kds = k * ((a0 + a1 - 2.f) * ka + 2.f);
            const f4 pb = r * kds * rk;
            float s1 = (o[0] + o[1]) + (o[2] + o[3]);
            float s2 = (o[0] * o[0] + o[1] * o[1]) + (o[2] * o[2] + o[3] * o[3]);
            float s3 = (pb[0] + pb[1]) + (pb[2] + pb[3]);
#pragma unroll
            for (int sh = 1; sh < 16; sh <<= 1) { s1 += __shfl_xor(s1, sh); s2 += __shfl_xor(s2, sh); s3 += __shfl_xor(s3, sh); }
            const float mu = s1 * (1.f / 64.f); const float var = fmaxf(s2 * (1.f / 64.f) - mu * mu, 0.f);
            const float rs = rsqrtf(var + GN_EPS);
            const f4 res = ((o - mu) * rs * lg + lb + v * s3) * g;
            uint2 w; w.x = pk2(res[0], res[1]); w.y = pk2(res[2], res[3]);
            *(uint2*)(mix + (size_t)m * 2048 + cc) = w;
        }
    }
    bf16_t* tile = (bf16_t*)lds;
    const bf16_t* HT = (const bf16_t*)(P.ws + WS_HT);
    for (int item = blockIdx.x; item < 16 * 128; item += gridDim.x) {
        const int c0 = (item & 15) * 64, m0 = (item >> 4) * 64;
#pragma unroll
        for (int i = 0; i < 8; ++i) { const int ci = wave * 8 + i; tile[ci * 66 + lane] = HT[(size_t)(c0 + ci) * M + m0 + lane]; }
        __syncthreads();
#pragma unroll
        for (int i = 0; i < 8; ++i) { const int mi = wave * 8 + i; mix[(size_t)(m0 + mi) * 2048 + 1024 + c0 + lane] = tile[lane * 66 + mi]; }
        __syncthreads();
    }
}

#define XB_TMO      128
#define XB_XCNT(j)  (256  + 64 * (j))
#define XB_XSUB(j)  (1280 + 64 * (j))
#define XB_XGEN(j)  (2304 + 64 * (j))
#define XB_TOP      3328
#define XB_TOPGEN   3392
#define XCD_BAR_WORDS 3456
#define XB_SPIN_CAP (1u << 18)
#define LAS __attribute__((address_space(3)))

__device__ __forceinline__ unsigned xb_ld(unsigned* p)              { return __hip_atomic_load(p, __ATOMIC_RELAXED, __HIP_MEMORY_SCOPE_AGENT); }
__device__ __forceinline__ unsigned xb_add(unsigned* p, unsigned v) { return __hip_atomic_fetch_add(p, v, __ATOMIC_RELAXED, __HIP_MEMORY_SCOPE_AGENT); }
__device__ __forceinline__ unsigned xb_xcc_id() { return (unsigned)__builtin_amdgcn_s_getreg((3 << 11) | 20) & 0xFu; }
#define XB_SPIN(cond, bar) do { unsigned _sp = 0; while (cond) { __builtin_amdgcn_s_sleep(1); \
    if ((++_sp & 255u) == 0u) { if (xb_ld(&(bar)[XB_TMO])) break; if (_sp > XB_SPIN_CAP) { atomicAdd(&(bar)[XB_TMO], 1u); break; } } } } while (0)

struct XcdBarrier {
    unsigned* bar; unsigned x;
    volatile LAS unsigned* st;
};

__device__ __forceinline__ XcdBarrier xcd_barrier_post(unsigned* bar, volatile LAS unsigned* st) {
    XcdBarrier b; b.bar = bar; b.x = xb_xcc_id(); b.st = st;
    if (threadIdx.x == 0) (void)xb_add(&bar[XB_XCNT(b.x)], 1u);
    return b;
}
__device__ __forceinline__ void xcd_barrier_complete(unsigned* bar, unsigned x, unsigned& nloc, unsigned& nx) {
    const unsigned G = gridDim.x * gridDim.y * gridDim.z;
    unsigned sum, cnt, mine, sp = 0u;
    for (;;) {
        sum = 0u; cnt = 0u; mine = 0u;
#pragma unroll
        for (unsigned j = 0; j < 16; ++j) { const unsigned c = xb_ld(&bar[XB_XCNT(j)]); sum += c; cnt += (c > 0u) ? 1u : 0u; mine = (j == x) ? c : mine; }
        if (sum == G) break;
        __builtin_amdgcn_s_sleep(1);
        if ((++sp & 255u) == 0u) { if (xb_ld(&bar[XB_TMO])) break; if (sp > XB_SPIN_CAP) { atomicAdd(&bar[XB_TMO], 1u); break; } }
    }
    nloc = mine > 0u ? mine : 1u; nx = cnt > 0u ? cnt : 1u;
}

__device__ __forceinline__ void xcd_barrier(const XcdBarrier& b) {
    asm volatile("s_waitcnt vmcnt(0)" ::: "memory");
    __syncthreads();
    if (threadIdx.x == 0) {
        unsigned* bar = b.bar;
        __builtin_amdgcn_s_waitcnt(0);
        unsigned nloc = b.st[0], nx = b.st[1];
        if (nloc == 0u) { xcd_barrier_complete(bar, b.x, nloc, nx); b.st[0] = nloc; b.st[1] = nx; }
        const unsigned old = xb_add(&bar[XB_XSUB(b.x)], 1u);
        const unsigned gen = old / nloc;
        if (old + 1u == (gen + 1u) * nloc) {
            __builtin_amdgcn_fence(__ATOMIC_RELEASE, "agent");
            asm volatile("s_waitcnt vmcnt(0)" ::: "memory");
            const unsigned og = xb_add(&bar[XB_TOP], 1u);
            const unsigned tg = og / nx;
            if (og + 1u == (tg + 1u) * nx) xb_add(&bar[XB_TOPGEN], 1u);
            else XB_SPIN(xb_ld(&bar[XB_TOPGEN]) == tg, bar);
            __builtin_amdgcn_fence(__ATOMIC_ACQUIRE, "agent");
            xb_add(&bar[XB_XGEN(b.x)], 1u);
            asm volatile("s_waitcnt vmcnt(0)" ::: "memory");
        } else {
            XB_SPIN(xb_ld(&bar[XB_XGEN(b.x)]) == gen, bar);
            __builtin_amdgcn_fence(__ATOMIC_ACQUIRE, "agent");
            asm volatile("s_waitcnt vmcnt(0)" ::: "memory");
        }
    }
    __syncthreads();
}


constexpr int NPH = 2 + 9 * DEPTH;
#ifndef PHM
#define PHM 1023
#endif
#ifndef DUPM
#define DUPM 0
#endif
#ifndef XSYNC
#define XSYNC 0
#endif
__global__ void __launch_bounds__(NT, 2) mega(Params Pv) {
    extern __shared__ __attribute__((aligned(16))) unsigned char lds_raw[];
    cg::grid_group grid = cg::this_grid();
    float* ldsf = (float*)lds_raw;
    PG8_LAS unsigned char* ldsg = (PG8_LAS unsigned char*)lds_raw;
    const int G = gridDim.x, bid = blockIdx.x;
    const int ph_lo = Pv.ph_lo, ph_hi = Pv.ph_hi;
    volatile LAS unsigned* xst = (volatile LAS unsigned*)(lds_raw + (LDS_BYTES - 16));
    if (threadIdx.x == 0) { xst[0] = 0u; xst[1] = 0u; }
    __syncthreads();
    XcdBarrier xbar = xcd_barrier_post((unsigned*)Pv.ws, xst);
    for (int ph = ph_lo; ph < ph_hi; ++ph) {
        const int nrep = (ph >= 2 && ((DUPM >> ((ph - 2) % 9)) & 1)) ? 2 : ((ph < 2 && ((DUPM >> (10 + ph)) & 1)) ? 2 : 1);
        for (int rep = 0; rep < nrep; ++rep) {
        CParams* kp = (CParams*)__builtin_amdgcn_kernarg_segment_ptr(); asm volatile("" : "+s"(kp));
        CParams& P = *kp;
        if (ph == 0 && (PHM & 1)) { ph_mod(P, ldsf); ph_filt_hidden(P); __syncthreads(); ph_convert(P, 0, ldsf); }
        else if (ph == 1 && (PHM & 2)) { ph_rowpass(P, 0, 0); ph_filt_final(P, ldsf); }
        else {
            const int l = (ph - 2) / 9, s = (ph - 2) % 9;
            const float* mod = (const float*)(P.ws + WS_MOD);
            if (s == 0 && (PHM & 4)) {
                pg8::Gemm g{(const bf16_t*)(P.ws + WS_H), (const bf16_t*)(P.ws + WS_WIN), M, NPAD, D}; pg8::StaticOrder S; S.init(M, NPAD, G, bid);
                pg8::EpiProj E{(float*)(P.ws + WS_PROJ), (bf16_t*)(P.ws + WS_LACT)};
                pg8::gemm_phase<pg8::EpiProj, pg8::StaticOrder, true, true>(ldsg, g, S, E);
            } else if (s == 1 && (PHM & 8)) {
                pg8::Gemm g{(const bf16_t*)(P.ws + WS_LACT), (const bf16_t*)(P.ws + WS_WL), M, NL, KL}; pg8::StaticOrder S; S.init(M, NL, G, bid);
                pg8::EpiLora E{(float*)(P.ws + WS_RW) + 4 * AS, AS, P.in[10] + l * 2048, P.in[12] + l * 2048};
                pg8::gemm_phase<pg8::EpiLora, pg8::StaticOrder, true, true>(ldsg, g, S, E);
                __syncthreads();
                ph_convprep(P, l, ldsf);
            } else if (s == 2 && (PHM & 16)) { ph_scan_hyena(P, l, ldsf); }
            else if (s == 3 && (PHM & 32)) { ph_combine(P, l, ldsf); }
            else if ((s == 4 || s == 7) && (PHM & 64)) {
                pg8::Gemm g{(const bf16_t*)(P.ws + (s == 4 ? WS_MIX : WS_PROJ)), (const bf16_t*)(P.ws + (s == 4 ? WS_WOUT : WS_W2)), M, D, s == 4 ? D : DFF}; pg8::StaticOrder S; S.init(M, D, G, bid);
                pg8::EpiRes E{P.out, mod + (size_t)l * 5 * 12288 + (s == 4 ? 2 : 5) * 2048, ALPHA};
                pg8::gemm_phase<pg8::EpiRes, pg8::StaticOrder, true, true>(ldsg, g, S, E);
            } else if (s == 5 && (PHM & 128)) { ph_rowpass(P, 1, l); }
            else if (s == 6 && (PHM & 256)) {
                pg8::Gemm g{(const bf16_t*)(P.ws + WS_H), (const bf16_t*)(P.ws + WS_W1), M, DFF, D}; pg8::StaticOrder S; S.init(M, DFF, G, bid);
                pg8::EpiRelu2 E{(bf16_t*)(P.ws + WS_PROJ), DFF};
                pg8::gemm_phase<pg8::EpiRelu2, pg8::StaticOrder, true, true>(ldsg, g, S, E);
            } else if (PHM & 512) { ph_rowpass(P, 2, l); if (l + 1 < DEPTH) ph_convert(P, l + 1, ldsf); }
        }
        if (ph + 1 < ph_hi || rep + 1 < nrep) { if (ph == 0 && rep == 0) grid.sync(); else xcd_barrier(xbar); }
        if (ph == 1) for (int xs = 0; xs < XSYNC; ++xs) xcd_barrier(xbar);
        }
    }
}

#ifndef MK_MULTI
#define MK_MULTI 0
#endif
extern "C" void kernel_launch(void* const* d_in, const int* in_sizes, int n_in, void* d_out, int out_size, void* d_ws, size_t ws_size, hipStream_t stream) {
    static int grid = 0;
    if (grid == 0) {
        int dev = 0, cus = 0, per_cu = 0;
        if (n_in != 33 || ws_size < WS_END) { fprintf(stderr, "kernel_launch: unexpected n_in %d or ws_size %zu (< %zu)\n", n_in, ws_size, (size_t)WS_END); grid = -1; return; }
        hipGetDevice(&dev);
        hipDeviceGetAttribute(&cus, hipDeviceAttributeMultiprocessorCount, dev);
        if (hipFuncSetAttribute((const void*)mega, hipFuncAttributeMaxDynamicSharedMemorySize, LDS_BYTES) != hipSuccess) { fprintf(stderr, "hipFuncSetAttribute failed\n"); grid = -1; return; }
        if (hipOccupancyMaxActiveBlocksPerMultiprocessor(&per_cu, (const void*)mega, NT, LDS_BYTES) != hipSuccess || per_cu < 1) { fprintf(stderr, "occupancy query failed (%d)\n", per_cu); grid = -1; return; }
        grid = cus;
    }
    if (grid < 0) return;
    Params p{};
    for (int i = 0; i < 33; ++i) p.in[i] = (const float*)d_in[i];
    p.out = (float*)d_out; p.ws = (unsigned char*)d_ws;
#if MK_MULTI
    for (int ph = 0; ph < NPH; ++ph) { p.ph_lo = ph; p.ph_hi = ph + 1; hipLaunchKernelGGL(mega, dim3(grid), dim3(NT), LDS_BYTES, stream, p); }
#else
    if (hipMemsetAsync(d_ws, 0, 16384, stream) != hipSuccess) { fprintf(stderr, "memset failed\n"); return; }
    p.ph_lo = 0; p.ph_hi = NPH;
    void* args[] = {&p};
    hipError_t e = hipLaunchCooperativeKernel((const void*)mega, dim3(grid), dim3(NT), args, LDS_BYTES, stream);
    if (e != hipSuccess) fprintf(stderr, "cooperative launch failed: %s (grid %d)\n", hipGetErrorString(e), grid);
#endif
}
```

```cpp
#include <hip/hip_runtime.h>
#include <hip/hip_cooperative_groups.h>
#include <cstdio>
#include <cstdint>
namespace cg = cooperative_groups;

namespace pg8 {
#define PG8_LAS __attribute__((address_space(3)))
typedef unsigned short bf16_t;
typedef short bf16x8 __attribute__((ext_vector_type(8)));
typedef float f32x4 __attribute__((ext_vector_type(4)));
typedef unsigned u32x4 __attribute__((ext_vector_type(4)));
constexpr int BM = 256, BK = 64, HALF = 128, HTB = HALF * BK * 2  , STAGE_BYTES = 8 * HTB, NXCD = 8, WGM = 8;

__host__ __device__ __forceinline__ int lds_byte(int r, int c) { const int st = (r >> 4) * 2 + (c >> 5), rr = r & 15, cc = c & 31, ob = rr * 64 + cc * 2; return st * 1024 + (ob ^ (((ob >> 9) & 1) << 5)); }
__host__ __device__ __forceinline__ void stage_rc(int b, int& R, int& C) { const int st = b / 1024, sb = b % 1024, swz = sb ^ (((sb >> 9) & 1) << 5); R = (st >> 1) * 16 + swz / 64; C = (st & 1) * 32 + (swz % 64) / 2; }
__host__ __device__ __forceinline__ int perm32(int rho) { const int n = rho >> 4, i = rho & 15; return 8 * (i >> 2) + 4 * n + (i & 3); }

struct Unit { int pm, pn; };
struct Gemm { const bf16_t* A; const bf16_t* Bt; int M, N, K; };

struct StaticOrder {
    int nM, nN, nwg, G, c;
    __host__ __device__ void init(int M, int N, int G_, int c_) { nM = M / BM; nN = N / BM; nwg = nM * nN; G = G_; c = c_; }
    __host__ __device__ bool next(int i, Unit& u) const {
        const long L = (long)i * G + c; if (L >= nwg) return false;
        int wgid = (int)L; { const int q = nwg / NXCD, r = nwg % NXCD, xcd = wgid % NXCD, off = wgid / NXCD; wgid = (xcd < r ? xcd * (q + 1) : r * (q + 1) + (xcd - r) * q) + off; }
        const int nig = WGM * nN, gid = wgid / nig, fm = gid * WGM, gsz = (nM - fm) < WGM ? (nM - fm) : WGM;
        u.pm = fm + ((wgid % nig) % gsz); u.pn = (wgid % nig) / gsz; return true;
    }
    __device__ __forceinline__ void a_ready(const Unit&) const {}
    __device__ __forceinline__ void done(const Unit&) const {}
};

typedef __bf16 bf16x2v __attribute__((ext_vector_type(2)));
typedef float f32x2v __attribute__((ext_vector_type(2)));
__device__ __forceinline__ unsigned cvt_pk_bf16(float lo, float hi) { const f32x2v v = {lo, hi}; const bf16x2v b = __builtin_convertvector(v, bf16x2v); return __builtin_bit_cast(unsigned, b); }
typedef float f32x2 __attribute__((ext_vector_type(2)));

__device__ __forceinline__ float sigm(float x) { return __builtin_amdgcn_rcpf(1.f + __expf(-x)); }
struct EpiProj {
    static constexpr bool PERM = false, AFTER_DRAIN = false;
    float* proj; bf16_t* lact;
    __device__ __forceinline__ void operator()(const f32x4 (&acc)[2][2][4][2], const Unit& u, int wr, int wc, int fr, int fq) const {
        const int row0 = u.pm * BM + wr * 64 + fr, col0 = u.pn * BM + wc * 32 + 4 * fq;
        if (u.pn < 24) {
#pragma unroll
            for (int ai = 0; ai < 2; ++ai)
#pragma unroll
                for (int m = 0; m < 4; ++m) { float* rowp = proj + (size_t)(row0 + ai * HALF + m * 16) * 6144 + col0;
#pragma unroll
                    for (int bj = 0; bj < 2; ++bj)
#pragma unroll
                        for (int n = 0; n < 2; ++n) *(f32x4*)(rowp + bj * HALF + n * 16) = acc[ai][bj][m][n]; }
        } else {
#pragma unroll
            for (int ai = 0; ai < 2; ++ai)
#pragma unroll
                for (int m = 0; m < 4; ++m) { bf16_t* rowp = lact + (size_t)(row0 + ai * HALF + m * 16) * 384;
#pragma unroll
                    for (int bj = 0; bj < 2; ++bj)
#pragma unroll
                        for (int n = 0; n < 2; ++n) {
                            const int cl = col0 - 6144 + bj * HALF + n * 16;
                            if (cl < 384) {
                                f32x4 v = acc[ai][bj][m][n];
                                if (cl < 64) { v[0] = tanhf(v[0]); v[1] = tanhf(v[1]); v[2] = tanhf(v[2]); v[3] = tanhf(v[3]); }
                                else if (cl < 128) { }
                                else if (cl < 288) { v[0] = sigm(v[0]); v[1] = sigm(v[1]); v[2] = sigm(v[2]); v[3] = sigm(v[3]); }
                                else { v = (f32x4){0.f, 0.f, 0.f, 0.f}; }
                                uint2 w; w.x = cvt_pk_bf16(v[0], v[1]); w.y = cvt_pk_bf16(v[2], v[3]);
                                *(uint2*)(rowp + cl) = w;
                            }
                        } }
        }
    }
};
struct EpiLora {
    static constexpr bool PERM = false, AFTER_DRAIN = false;
    float* arr0; size_t arr_stride;
    const float* w0; const float* a0;
    template <int MODE>
    __device__ __forceinline__ void body(const f32x4 (&acc)[2][2][4][2], float* base, const float* bptr, int row0, int col0, float bsc, bool isg) const {
#pragma unroll
        for (int ai = 0; ai < 2; ++ai)
#pragma unroll
            for (int m = 0; m < 4; ++m) { float* rowp = base + (size_t)(row0 + ai * HALF + m * 16) * 1024 + col0;
#pragma unroll
                for (int bj = 0; bj < 2; ++bj)
#pragma unroll
                    for (int n = 0; n < 2; ++n) {
                        f32x4 v = acc[ai][bj][m][n];
                        v = v + *(const f32x4*)(bptr + col0 + bj * HALF + n * 16) * bsc;
#pragma unroll
                        for (int e = 0; e < 4; ++e) { const float sg = sigm(v[e]); v[e] = MODE == 0 ? __expf(-0.6065306597126334f * sg) : (isg ? v[e] : sg); }
                        *(f32x4*)(rowp + bj * HALF + n * 16) = v;
                    } }
    }
    __device__ __forceinline__ void operator()(const f32x4 (&acc)[2][2][4][2], const Unit& u, int wr, int wc, int fr, int fq) const {
        const int which = u.pn >> 2;
        const int row0 = u.pm * BM + wr * 64 + fr, col0 = (u.pn & 3) * BM + wc * 32 + 4 * fq;
        float* base = arr0 + (size_t)which * arr_stride;
        if (which < 2) body<0>(acc, base, w0 + which * 1024, row0, col0, 1.f, false);
        else body<1>(acc, base, a0 + ((which - 2) & 1) * 1024, row0, col0, which < 4 ? 1.f : 0.f, which >= 4);
    }
};
struct EpiRes {
    static constexpr bool PERM = false, AFTER_DRAIN = false;
    float* X; const float* gate;
    float alpha;
    __device__ __forceinline__ void operator()(const f32x4 (&acc)[2][2][4][2], const Unit& u, int wr, int wc, int fr, int fq) const {
        const int row0 = u.pm * BM + wr * 64 + fr, col0 = u.pn * BM + wc * 32 + 4 * fq;
        const int bidx = u.pm < 16 ? 0 : 1 + ((u.pm - 16) >> 2);
        const float* gp = gate + (size_t)bidx * 12288 + col0;
        f32x4 gv[2][2];
#pragma unroll
        for (int bj = 0; bj < 2; ++bj)
#pragma unroll
            for (int n = 0; n < 2; ++n) gv[bj][n] = *(const f32x4*)(gp + bj * HALF + n * 16);
#pragma unroll
        for (int ai = 0; ai < 2; ++ai)
#pragma unroll
            for (int m = 0; m < 4; ++m) { float* rowp = X + (size_t)(row0 + ai * HALF + m * 16) * 2048 + col0;
#pragma unroll
                for (int bj = 0; bj < 2; ++bj)
#pragma unroll
                    for (int n = 0; n < 2; ++n) {
                        f32x4* p = (f32x4*)(rowp + bj * HALF + n * 16);
                        const f32x4 xv = *p;
                        *p = xv * alpha + gv[bj][n] * acc[ai][bj][m][n];
                    } }
    }
};
struct EpiRelu2 {
    static constexpr bool PERM = true, AFTER_DRAIN = false;
    bf16_t* O; int ldc;
    __device__ __forceinline__ void operator()(const f32x4 (&acc)[2][2][4][2], const Unit& u, int wr, int wc, int fr, int fq) const {
        const int row0 = u.pm * BM + wr * 64 + fr, col0 = u.pn * BM + wc * 32 + 8 * fq;
#pragma unroll
        for (int ai = 0; ai < 2; ++ai)
#pragma unroll
            for (int m = 0; m < 4; ++m) { bf16_t* rowp = O + (size_t)(row0 + ai * HALF + m * 16) * ldc + col0;
#pragma unroll
                for (int bj = 0; bj < 2; ++bj) { f32x4 v0 = acc[ai][bj][m][0], v1 = acc[ai][bj][m][1];
#pragma unroll
                    for (int e = 0; e < 4; ++e) { const float a = fmaxf(v0[e], 0.f), b = fmaxf(v1[e], 0.f); v0[e] = a * a; v1[e] = b * b; }
                    u32x4 w; w.x = cvt_pk_bf16(v0[0], v0[1]); w.y = cvt_pk_bf16(v0[2], v0[3]); w.z = cvt_pk_bf16(v1[0], v1[1]); w.w = cvt_pk_bf16(v1[2], v1[3]);
                    *(u32x4*)(rowp + bj * HALF) = w; } }
    }
};

template <class Epi, class Sched, bool ALIGN_EPI = false, bool SP2 = false>
__device__ __forceinline__ void gemm_phase(PG8_LAS unsigned char* lds, const Gemm g, const Sched& S, const Epi& E) {
    int tid = threadIdx.x; asm volatile("" : "+v"(tid)); const int wid = __builtin_amdgcn_readfirstlane(tid >> 6), lane = tid & 63, wr = wid >> 2, wc = wid & 3, fr = lane & 15, fq = lane >> 4;
    const int K = g.K, nt = K / BK;
    unsigned voffA[2], voffB[2];
#pragma unroll
    for (int i = 0; i < 2; ++i) { int R, C; stage_rc(tid * 16 + i * 8192, R, C); const int Rb = Epi::PERM ? ((R & ~31) + perm32(R & 31)) : R;
        voffA[i] = (unsigned)(R * K + C) * 2u; voffB[i] = (unsigned)(Rb * K + C) * 2u; }
    const size_t kstep = (size_t)(BK * 2);
    const size_t hstep = (size_t)HALF * K * 2;
    const size_t tstep = 2 * hstep;
    const unsigned ldsw = (unsigned)wid * 1024u;
    const int aoff = lds_byte(wr * 64 + fr, fq * 8), boff = lds_byte(wc * 32 + fr, fq * 8);
#define PG8_SA(b, h) (((b) * 2 + (h)) * HTB)
#define PG8_SB(b, h) ((4 + (b) * 2 + (h)) * HTB)
#define PG8_STAGE(bufoff, gbase, voff) do { _Pragma("unroll") for (int _i = 0; _i < 2; ++_i) \
        __builtin_amdgcn_global_load_lds((const unsigned*)((const char*)(gbase) + (voff)[_i]), (PG8_LAS unsigned*)(lds + (bufoff) + ldsw + _i * 8192), 16, 0, 0); } while (0)
#define PG8_LDA(dst, b, h) do { _Pragma("unroll") for (int m = 0; m < 4; ++m) _Pragma("unroll") for (int k = 0; k < 2; ++k) dst[m][k] = *(const PG8_LAS bf16x8*)(lds + PG8_SA(b, h) + aoff + m * 2048 + k * 1024); } while (0)
#define PG8_LDB(dst, b, h) do { _Pragma("unroll") for (int n = 0; n < 2; ++n) _Pragma("unroll") for (int k = 0; k < 2; ++k) dst[n][k] = *(const PG8_LAS bf16x8*)(lds + PG8_SB(b, h) + boff + n * 2048 + k * 1024); } while (0)
#define PG8_MMA(ai, bj, At, Bt) do { __builtin_amdgcn_s_setprio(1); _Pragma("unroll") for (int m = 0; m < 4; ++m) _Pragma("unroll") for (int n = 0; n < 2; ++n) _Pragma("unroll") for (int k = 0; k < 2; ++k) \
        acc[ai][bj][m][n] = __builtin_amdgcn_mfma_f32_16x16x32_bf16(Bt[n][k], At[m][k], acc[ai][bj][m][n], 0, 0, 0); __builtin_amdgcn_s_setprio(0); } while (0)
#define PG8_WAIT_V(n) asm volatile("s_waitcnt vmcnt(" #n ")" ::: "memory")
#define PG8_WAIT_L(n) asm volatile("s_waitcnt lgkmcnt(" #n ")" ::: "memory")
#define PG8_BAR __builtin_amdgcn_s_barrier()
#define PG8_SCHED __builtin_amdgcn_sched_barrier(0)
    Unit cur, nxt; int ui = 0;
    if (!S.next(0, cur)) return;
    f32x4 acc[2][2][4][2];
#pragma unroll
    for (int a = 0; a < 2; ++a)
#pragma unroll
        for (int b = 0; b < 2; ++b)
#pragma unroll
            for (int m = 0; m < 4; ++m)
#pragma unroll
                for (int n = 0; n < 2; ++n) acc[a][b][m][n] = (f32x4){0.f, 0.f, 0.f, 0.f};
    bf16x8 At[4][2], B0[2][2], B1[2][2];
    const char* cA = (const char*)g.A + (size_t)cur.pm * tstep; const char* cB = (const char*)g.Bt + (size_t)cur.pn * tstep;
    S.a_ready(cur);
    if constexpr (SP2) {
        PG8_STAGE(PG8_SB(0, 0), cB, voffB); PG8_STAGE(PG8_SB(0, 1), cB + hstep, voffB); PG8_STAGE(PG8_SA(0, 0), cA, voffA); PG8_STAGE(PG8_SA(0, 1), cA + hstep, voffA);
        if (wr == 1) PG8_BAR;
        PG8_WAIT_V(2); PG8_BAR;
        PG8_STAGE(PG8_SB(1, 0), cB + kstep, voffB); PG8_STAGE(PG8_SA(1, 0), cA + kstep, voffA); PG8_STAGE(PG8_SB(1, 1), cB + hstep + kstep, voffB);
        PG8_WAIT_V(6); PG8_BAR;
    } else {
        PG8_STAGE(PG8_SB(0, 0), cB, voffB); PG8_STAGE(PG8_SA(0, 0), cA, voffA); PG8_STAGE(PG8_SB(0, 1), cB + hstep, voffB); PG8_STAGE(PG8_SA(0, 1), cA + hstep, voffA);
        if (wr == 1) PG8_BAR;
        PG8_WAIT_V(4); PG8_BAR;
        PG8_STAGE(PG8_SB(1, 0), cB + kstep, voffB); PG8_STAGE(PG8_SA(1, 0), cA + kstep, voffA); PG8_STAGE(PG8_SB(1, 1), cB + hstep + kstep, voffB);
        PG8_WAIT_V(6); PG8_BAR;
    }
    for (;;) {
        const bool has_next = S.next(ui + 1, nxt);
        const char* nA = has_next ? (const char*)g.A + (size_t)nxt.pm * tstep : cA; const char* nB = has_next ? (const char*)g.Bt + (size_t)nxt.pn * tstep : cB;
        for (int t = 0; t < nt; t += 2) {
            const bool last = (t == nt - 2);
            const char* a1 = cA + (size_t)(t + 1) * kstep;
            const char* a2 = last ? nA : cA + (size_t)(t + 2) * kstep; const char* b2 = last ? nB : cB + (size_t)(t + 2) * kstep;
            const char* a3 = a2 + kstep; const char* b3 = b2 + kstep;
            if (last && has_next) S.a_ready(nxt);
            if constexpr (SP2) {
            PG8_LDB(B0, 0, 0); PG8_LDB(B1, 0, 1); PG8_SCHED; PG8_LDA(At, 0, 0); PG8_STAGE(PG8_SA(1, 1), a1 + hstep, voffA);
            PG8_WAIT_V(8); PG8_WAIT_L(0); PG8_BAR; PG8_MMA(0, 0, At, B0); PG8_MMA(0, 1, At, B1); PG8_BAR; PG8_SCHED;
            PG8_LDA(At, 0, 1); PG8_STAGE(PG8_SB(0, 0), b2, voffB); PG8_STAGE(PG8_SB(0, 1), b2 + hstep, voffB); PG8_STAGE(PG8_SA(0, 0), a2, voffA);
            PG8_WAIT_V(8); PG8_WAIT_L(0); PG8_BAR; PG8_MMA(1, 0, At, B0); PG8_MMA(1, 1, At, B1); PG8_BAR; PG8_SCHED;
            PG8_LDB(B0, 1, 0); PG8_LDB(B1, 1, 1); PG8_SCHED; PG8_LDA(At, 1, 0); PG8_STAGE(PG8_SA(0, 1), a2 + hstep, voffA);
            PG8_WAIT_V(8); PG8_WAIT_L(0); PG8_BAR; PG8_MMA(0, 0, At, B0); PG8_MMA(0, 1, At, B1); PG8_BAR; PG8_SCHED;
            PG8_LDA(At, 1, 1); PG8_STAGE(PG8_SB(1, 0), b3, voffB); PG8_STAGE(PG8_SB(1, 1), b3 + hstep, voffB); PG8_STAGE(PG8_SA(1, 0), a3, voffA);
            PG8_WAIT_V(8); PG8_WAIT_L(0); PG8_BAR; PG8_MMA(1, 0, At, B0); PG8_MMA(1, 1, At, B1); PG8_BAR; PG8_SCHED;
            } else {
            PG8_LDB(B0, 0, 0); PG8_SCHED; PG8_LDA(At, 0, 0); PG8_STAGE(PG8_SA(1, 1), a1 + hstep, voffA);
            PG8_WAIT_L(8); PG8_BAR; PG8_WAIT_L(0); PG8_MMA(0, 0, At, B0); PG8_BAR; PG8_SCHED;
            PG8_LDB(B1, 0, 1); PG8_STAGE(PG8_SB(0, 0), b2, voffB);
            PG8_BAR; PG8_WAIT_L(0); PG8_MMA(0, 1, At, B1); PG8_BAR;
            PG8_LDA(At, 0, 1); PG8_STAGE(PG8_SA(0, 0), a2, voffA);
            PG8_BAR; PG8_WAIT_L(0); PG8_MMA(1, 0, At, B0); PG8_BAR; PG8_SCHED;
            PG8_STAGE(PG8_SB(0, 1), b2 + hstep, voffB);
            PG8_WAIT_V(6); PG8_BAR; PG8_MMA(1, 1, At, B1); PG8_BAR;
            PG8_LDB(B0, 1, 0); PG8_SCHED; PG8_LDA(At, 1, 0); PG8_STAGE(PG8_SA(0, 1), a2 + hstep, voffA);
            PG8_WAIT_L(8); PG8_BAR; PG8_WAIT_L(0); PG8_MMA(0, 0, At, B0); PG8_BAR; PG8_SCHED;
            PG8_LDB(B1, 1, 1); PG8_STAGE(PG8_SB(1, 0), b3, voffB);
            PG8_BAR; PG8_WAIT_L(0); PG8_MMA(0, 1, At, B1); PG8_BAR;
            PG8_LDA(At, 1, 1); PG8_STAGE(PG8_SA(1, 0), a3, voffA);
            PG8_BAR; PG8_WAIT_L(0); PG8_MMA(1, 0, At, B0); PG8_BAR; PG8_SCHED;
            PG8_STAGE(PG8_SB(1, 1), b3 + hstep, voffB);
            PG8_WAIT_V(6); PG8_BAR; PG8_MMA(1, 1, At, B1); PG8_BAR;
            }
        }
        if constexpr (ALIGN_EPI) { if (wr == 0) PG8_BAR; }
        if constexpr (!Epi::AFTER_DRAIN) { int t2 = threadIdx.x; asm volatile("" : "+v"(t2)); const int fr2 = t2 & 15, fq2 = (t2 & 63) >> 4; E(acc, cur, wr, wc, fr2, fq2); S.done(cur); }
        if (!has_next) break;
#pragma unroll
        for (int a = 0; a < 2; ++a)
#pragma unroll
            for (int b = 0; b < 2; ++b)
#pragma unroll
                for (int m = 0; m < 4; ++m)
#pragma unroll
                    for (int n = 0; n < 2; ++n) acc[a][b][m][n] = (f32x4){0.f, 0.f, 0.f, 0.f};
        cur = nxt; cA = nA; cB = nB; ++ui;
        if constexpr (ALIGN_EPI) { if (wr == 1) PG8_BAR; }
    }
    PG8_WAIT_V(0);
    if constexpr (!ALIGN_EPI) { if (wr == 0) PG8_BAR; }
    PG8_BAR;
    if constexpr (Epi::AFTER_DRAIN) { E.fused(acc, cur, wr, wc, fr, fq, lds, wid, lane); S.done(cur); }
#undef PG8_SA
#undef PG8_SB
#undef PG8_STAGE
#undef PG8_LDA
#undef PG8_LDB
#undef PG8_MMA
#undef PG8_WAIT_V
#undef PG8_WAIT_L
#undef PG8_BAR
#undef PG8_SCHED
}
}

using f4 = pg8::f32x4;
typedef unsigned short bf16_t;
constexpr int NT = 512;
constexpr int M = 8192, D = 2048, DR = 1024, NPAD = 6656, DFF = 8192, KL = 384, NL = 5120;
constexpr int DEPTH = 2;
constexpr float ALPHA = 1.4142135623730951f;
constexpr float LN_EPS = 1e-5f, GN_EPS = 64e-5f;
constexpr int LDS_BYTES = 147456;

constexpr size_t al256(size_t x) { return (x + 255) & ~(size_t)255; }
constexpr size_t FILT_CTX_PER = (size_t)2 * 1024 * 528, FILT_LAT_PER = (size_t)2 * 1024 * 2064;
constexpr size_t WS_MOD = 16384;
constexpr size_t WS_FH2 = al256(WS_MOD + (size_t)2 * 5 * 12288 * 4);
constexpr size_t WS_FILT = al256(WS_FH2 + (size_t)2 * 1280 * 64 * 4);
constexpr size_t WS_WIN = al256(WS_FILT + 2 * (FILT_CTX_PER + FILT_LAT_PER) * 4);
constexpr size_t WS_WOUT = WS_WIN + (size_t)NPAD * D * 2;
constexpr size_t WS_W1 = WS_WOUT + (size_t)D * D * 2;
constexpr size_t WS_W2 = WS_W1 + (size_t)DFF * D * 2;
constexpr size_t WS_WL = WS_W2 + (size_t)D * DFF * 2;
constexpr size_t WS_H = WS_WL + (size_t)NL * KL * 2;
constexpr size_t WS_MIX = WS_H + (size_t)M * D * 2;
constexpr size_t WS_LACT = WS_MIX + (size_t)M * D * 2;
constexpr size_t WS_PROJ = WS_LACT + (size_t)M * KL * 2;
constexpr size_t WS_RW = WS_PROJ + (size_t)M * 6144 * 4;
constexpr size_t WS_HT = WS_RW + (size_t)9 * M * 1024 * 4;
constexpr size_t WS_FILTB = WS_HT + (size_t)3 * 1024 * M * 2;
constexpr size_t FILTB_CTX = (size_t)2 * 1024 * 520, FILTB_LAT = (size_t)2 * 1024 * 2056, FILTB_PER = FILTB_CTX + FILTB_LAT;
constexpr size_t WS_END = WS_FILTB + 2 * FILTB_PER * 2;
static_assert(WS_END <= (size_t)805306368, "workspace map too large");
constexpr size_t AS = (size_t)M * 1024;
constexpr size_t OUT_STATE = (size_t)16777216;

__device__ __forceinline__ int tid_l() { int t = threadIdx.x; asm volatile("" : "+v"(t)); return t; }
struct Params { const float* in[33]; float* out; unsigned char* ws; int ph_lo, ph_hi; };
typedef const __attribute__((address_space(4))) Params CParams;

__device__ __forceinline__ float wave_sum(float v) {
#pragma unroll
    for (int o = 1; o < 64; o <<= 1) v += __shfl_xor(v, o);
    return v;
}
typedef __bf16 bf16x2_t __attribute__((ext_vector_type(2)));
typedef float f32x2_t __attribute__((ext_vector_type(2)));
__device__ __forceinline__ unsigned pk2(float lo, float hi) { const f32x2_t v = {lo, hi}; const bf16x2_t b = __builtin_convertvector(v, bf16x2_t); return __builtin_bit_cast(unsigned, b); }
__device__ __forceinline__ bf16_t f2bf(float f) { unsigned u = __float_as_uint(f); u += 0x7FFFu + ((u >> 16) & 1u); return (bf16_t)(u >> 16); }
__device__ __forceinline__ float bf2f(unsigned short b) { return __uint_as_float(((unsigned)b) << 16); }
__device__ __forceinline__ float sigmf(float x) { return __builtin_amdgcn_rcpf(1.f + __expf(-x)); }

__device__ __forceinline__ void ph_mod(CParams& P, float* lds) {
    const int tid = tid_l();
    float* scond = lds;
    float* red = lds + 5 * 2048;
    const float* c = P.in[2]; const float* cctx = P.in[4];
    for (int i = tid; i < 5 * 2048; i += NT) { const int b = i >> 11, k = i & 2047; const float x = b == 0 ? cctx[k] : c[(b - 1) * 2048 + k]; scond[i] = x / (1.f + __expf(-x)); }
    __syncthreads();
    const float* w_ada = P.in[5]; const float* b_ada = P.in[6];
    float* mod = (float*)(P.ws + WS_MOD);
    const int kg = tid >> 5, c4 = tid & 31;
    for (int item = blockIdx.x; item < 192; item += gridDim.x) {
        const int l = item / 96, c0 = (item % 96) * 128;
        f4 acc[5];
#pragma unroll
        for (int b = 0; b < 5; ++b) acc[b] = (f4){0.f, 0.f, 0.f, 0.f};
        const float* wp = w_ada + ((size_t)l * 2048 + kg * 128) * 12288 + c0 + c4 * 4;
        const float* sc = scond + kg * 128;
#pragma unroll 8
        for (int k = 0; k < 128; ++k) {
            const f4 w = *(const f4*)(wp + (size_t)k * 12288);
#pragma unroll
            for (int b = 0; b < 5; ++b) acc[b] += w * sc[b * 2048 + k];
        }
#pragma unroll
        for (int b = 0; b < 5; ++b) *(f4*)(red + (kg * 5 + b) * 128 + c4 * 4) = acc[b];
        __syncthreads();
        for (int idx = tid; idx < 640; idx += NT) {
            const int b = idx >> 7, cc = idx & 127; float s = 0.f;
#pragma unroll
            for (int g = 0; g < 16; ++g) s += red[(g * 5 + b) * 128 + cc];
            mod[(size_t)(l * 5 + b) * 12288 + c0 + cc] = s + b_ada[(size_t)l * 12288 + c0 + cc];
        }
        __syncthreads();
    }
}

__device__ __forceinline__ void ph_filt_hidden(CParams& P) {
    const int lane = tid_l() & 63, wave = tid_l() >> 6;
    const int gw = blockIdx.x * 8 + wave, ngw = gridDim.x * 8;
    float* fh2 = (float*)(P.ws + WS_FH2);
    for (int it = gw; it < 2 * 1280; it += ngw) {
        const int l = it / 1280, q = it % 1280;
        const int seq = q < 256 ? 256 : 1024, p = q < 256 ? q : q - 256;
        const float t = (float)p / (float)(seq - 1);
        const float wang = (float)(6.283185307179586 / (double)seq) * (float)p;
        float z = 0.f;
        if (lane == 0) z = t;
        else if (lane <= 32) {
            const int fi = (lane - 1) & 15; const float st = (float)fi / 15.f; const float f = 1e-4f * (1.f - st) + 15.f * st;
            z = lane <= 16 ? cosf(f * wang) : -sinf(f * wang);
        }
        const float* w1 = P.in[19] + (size_t)l * 33 * 64; const float* b1 = P.in[20] + l * 64;
        const float* w2 = P.in[21] + (size_t)l * 64 * 64; const float* b2 = P.in[22] + l * 64;
        const float* fr = P.in[24] + l * 128;
        float a = b1[lane];
        for (int i = 0; i < 33; ++i) a += __shfl(z, i) * w1[i * 64 + lane];
        const float h1 = sinf(fr[lane] * a);
        float a2 = b2[lane];
        for (int i = 0; i < 64; ++i) a2 += __shfl(h1, i) * w2[i * 64 + lane];
        const float h2 = sinf(fr[64 + lane] * a2);
        fh2[((size_t)l * 1280 + q) * 64 + lane] = h2;
    }
}

__device__ __forceinline__ void transpose_item(const float* W, int K, int N, bf16_t* WT, float* scr, int item, int lane) {
    const int nblk = N / 32, kb = item / nblk, nb = item % nblk, k0 = 64 * kb, n0 = 32 * nb;
    float tv[32];
#pragma unroll
    for (int i = 0; i < 32; ++i) { const int kk = 2 * i + (lane >> 5); tv[i] = W[(size_t)(k0 + kk) * N + n0 + (lane & 31)]; }
#pragma unroll
    for (int i = 0; i < 32; ++i) { const int kk = 2 * i + (lane >> 5); scr[kk * 33 + (lane & 31)] = tv[i]; }
    asm volatile("s_waitcnt lgkmcnt(0)" ::: "memory");
    const int c = lane & 7;
#pragma unroll
    for (int j = 0; j < 4; ++j) { const int n = (lane >> 3) + 8 * j; const float* s = scr + (8 * c) * 33 + n;
        uint4 o; o.x = pk2(s[0 * 33], s[1 * 33]); o.y = pk2(s[2 * 33], s[3 * 33]); o.z = pk2(s[4 * 33], s[5 * 33]); o.w = pk2(s[6 * 33], s[7 * 33]);
        *(uint4*)(WT + (size_t)(n0 + n) * K + k0 + 8 * c) = o; }
    asm volatile("s_waitcnt lgkmcnt(0)" ::: "memory");
}
__device__ __forceinline__ void ph_convert(CParams& P, int l, float* lds) {
    const int lane = tid_l() & 63, wave = tid_l() >> 6;
    const int gw = blockIdx.x * 8 + wave, ngw = gridDim.x * 8;
    float* scr = lds + wave * (64 * 33);
    constexpr int I_IN = 32 * 201, I_OUT = 32 * 64, I_1 = 32 * 256, I_2 = 128 * 64;
    const float* w_in = P.in[7] + (size_t)l * 2048 * 6432; const float* w_out = P.in[26] + (size_t)l * 2048 * 2048;
    const float* w1 = P.in[31] + (size_t)l * 2048 * 8192; const float* w2 = P.in[32] + (size_t)l * 8192 * 2048;
    bf16_t* WIN = (bf16_t*)(P.ws + WS_WIN); bf16_t* WOUT = (bf16_t*)(P.ws + WS_WOUT); bf16_t* W1 = (bf16_t*)(P.ws + WS_W1); bf16_t* W2 = (bf16_t*)(P.ws + WS_W2);
    for (int it = gw; it < I_IN + I_OUT + I_1 + I_2; it += ngw) {
        int r = it;
        if (r < I_IN) { transpose_item(w_in, 2048, 6432, WIN, scr, r, lane); continue; } r -= I_IN;
        if (r < I_OUT) { transpose_item(w_out, 2048, 2048, WOUT, scr, r, lane); continue; } r -= I_OUT;
        if (r < I_1) { transpose_item(w1, 2048, 8192, W1, scr, r, lane); continue; } r -= I_1;
        transpose_item(w2, 8192, 2048, W2, scr, r, lane);
    }
    { uint4* z = (uint4*)(WIN + (size_t)6432 * 2048); const int n16 = 224 * 2048 * 2 / 16;
      unsigned zz = 0u; asm volatile("" : "+v"(zz));
      for (int i = blockIdx.x * NT + tid_l(); i < n16; i += gridDim.x * NT) z[i] = make_uint4(zz, zz, zz, zz); }
    { bf16_t* WL = (bf16_t*)(P.ws + WS_WL);
      const float* wup = P.in[9] + (size_t)l * 2 * 64 * 1024; const float* aup = P.in[11] + (size_t)l * 2 * 64 * 1024; const float* gup = P.in[13] + (size_t)l * 160 * 1024;
      for (int i = blockIdx.x * NT + tid_l(); i < NL * KL; i += gridDim.x * NT) {
          const int n = i / KL, k = i % KL; const int which = n >> 10, c = n & 1023; float v = 0.f;
          if (which < 2) { if (k < 64) v = wup[((size_t)which * 64 + k) * 1024 + c]; }
          else if (which < 4) { if (k >= 64 && k < 128) v = aup[((size_t)(which - 2) * 64 + (k - 64)) * 1024 + c]; }
          else { if (k >= 128 && k < 288) v = gup[(size_t)(k - 128) * 1024 + c]; }
          WL[i] = f2bf(v);
      } }
}

__device__ __forceinline__ void row_pass4(const float* src, float* dstX, const float* ag, const float* ab, const float* msh, const float* msc, bf16_t* hrow, int lane) {
    f4 v[4][8]; float s[4];
#pragma unroll
    for (int r = 0; r < 4; ++r) {
        s[r] = 0.f;
#pragma unroll
        for (int j = 0; j < 8; ++j) v[r][j] = *(const f4*)(src + (size_t)r * 2048 + j * 256 + lane * 4);
    }
#pragma unroll
    for (int r = 0; r < 4; ++r)
#pragma unroll
        for (int j = 0; j < 8; ++j) s[r] += (v[r][j][0] + v[r][j][1]) + (v[r][j][2] + v[r][j][3]);
    if (ag) {
        float s2[4], rstd[4];
#pragma unroll
        for (int r = 0; r < 4; ++r) { const float mean = wave_sum(s[r]) * (1.f / 2048.f); s2[r] = 0.f;
#pragma unroll
            for (int j = 0; j < 8; ++j) { v[r][j] = v[r][j] - mean; s2[r] += (v[r][j][0] * v[r][j][0] + v[r][j][1] * v[r][j][1]) + (v[r][j][2] * v[r][j][2] + v[r][j][3] * v[r][j][3]); } }
#pragma unroll
        for (int r = 0; r < 4; ++r) { rstd[r] = rsqrtf(wave_sum(s2[r]) * (1.f / 2048.f) + LN_EPS); s[r] = 0.f; }
#pragma unroll
        for (int j = 0; j < 8; ++j) { const f4 g = *(const f4*)(ag + j * 256 + lane * 4), b = *(const f4*)(ab + j * 256 + lane * 4);
#pragma unroll
            for (int r = 0; r < 4; ++r) { v[r][j] = v[r][j] * rstd[r] * g + b; s[r] += (v[r][j][0] + v[r][j][1]) + (v[r][j][2] + v[r][j][3]); } }
    }
#pragma unroll
    for (int r = 0; r < 4; ++r)
#pragma unroll
        for (int j = 0; j < 8; ++j) *(f4*)(dstX + (size_t)r * 2048 + j * 256 + lane * 4) = v[r][j];
    if (msh) {
        float s2[4], rstd[4];
#pragma unroll
        for (int r = 0; r < 4; ++r) { const float mean = wave_sum(s[r]) * (1.f / 2048.f); s2[r] = 0.f;
#pragma unroll
            for (int j = 0; j < 8; ++j) { v[r][j] = v[r][j] - mean; s2[r] += (v[r][j][0] * v[r][j][0] + v[r][j][1] * v[r][j][1]) + (v[r][j][2] * v[r][j][2] + v[r][j][3] * v[r][j][3]); } }
#pragma unroll
        for (int r = 0; r < 4; ++r) rstd[r] = rsqrtf(wave_sum(s2[r]) * (1.f / 2048.f) + LN_EPS);
#pragma unroll
        for (int j = 0; j < 8; ++j) { const f4 sh = *(const f4*)(msh + j * 256 + lane * 4), sc = *(const f4*)(msc + j * 256 + lane * 4) + 1.f;
#pragma unroll
            for (int r = 0; r < 4; ++r) { const f4 h = v[r][j] * rstd[r] * sc + sh;
                uint2 w; w.x = pk2(h[0], h[1]); w.y = pk2(h[2], h[3]);
                *(uint2*)(hrow + (size_t)r * 2048 + j * 256 + lane * 4) = w; } }
    }
}
__device__ __forceinline__ void ph_rowpass(CParams& P, int mode, int l) {
    const int lane = tid_l() & 63, wave = tid_l() >> 6;
    const int gw = blockIdx.x * 8 + wave, ngw = gridDim.x * 8;
    const float* mod = (const float*)(P.ws + WS_MOD);
    bf16_t* H = (bf16_t*)(P.ws + WS_H);
    for (int m = gw * 4; m < M; m += ngw * 4) {
        const int bidx = m < 4096 ? 0 : 1 + ((m - 4096) >> 10);
        const float* src; const float* ag = nullptr; const float* ab = nullptr; const float* msh = nullptr; const float* msc = nullptr;
        float* dst = P.out + (size_t)m * 2048;
        if (mode == 0) { src = m < 4096 ? P.in[0] + (size_t)m * 2048 : P.in[1] + (size_t)(m - 4096) * 2048;
            msh = mod + (size_t)(0 * 5 + bidx) * 12288; msc = msh + 2048; }
        else if (mode == 1) { src = dst; ag = P.in[27] + l * 2048; ab = P.in[28] + l * 2048;
            msh = mod + (size_t)(l * 5 + bidx) * 12288 + 3 * 2048; msc = msh + 2048; }
        else { src = dst; ag = P.in[29] + l * 2048; ab = P.in[30] + l * 2048;
            if (l + 1 < DEPTH) { msh = mod + (size_t)((l + 1) * 5 + bidx) * 12288; msc = msh + 2048; } }
        row_pass4(src, dst, ag, ab, msh, msc, H + (size_t)m * 2048, lane);
    }
}

__device__ __forceinline__ void ph_filt_final(CParams& P, float* lds) {
    const int tid = tid_l(); const int cl = tid & 15, ps = tid >> 4;
    for (int it = blockIdx.x; it < 512; it += gridDim.x) {
        const int ss = it < 256 ? 1 : 0; const int item = it & 255;
        const int cgp = item & 63, o = (item >> 6) & 1, l = item >> 7;
        const int L = ss ? 1024 : 256, GRL = 2 * L + 8, RS = 2 * L + 1;
        float* buf = lds; float* red = lds + 16 * 2049; float* invs = red + 512;
        const int c = cgp * 16 + cl;
        const float* h2 = (const float*)(P.ws + WS_FH2) + ((size_t)l * 1280 + (ss ? 256 : 0)) * 64;
        const float* w3 = P.in[23] + (size_t)l * 64 * 4096;
        float wf[64], wb[64];
#pragma unroll
        for (int j = 0; j < 64; ++j) { wf[j] = w3[(size_t)j * 4096 + (o * 2 + 0) * 1024 + c]; wb[j] = w3[(size_t)j * 4096 + (o * 2 + 1) * 1024 + c]; }
        const float st = (float)c / 1023.f;
        const float delta = fabsf(-3.0701134573253943f * (1.f - st) + -15.350567286626972f * st);
        float asum = 0.f;
        for (int p = ps; p < L; p += 32) {
            const float* hp = h2 + (size_t)p * 64;
            float af = 0.f, ab = 0.f;
#pragma unroll
            for (int j4 = 0; j4 < 16; ++j4) { const f4 hv = *(const f4*)(hp + j4 * 4);
#pragma unroll
                for (int e = 0; e < 4; ++e) { af += hv[e] * wf[j4 * 4 + e]; ab += hv[e] * wb[j4 * 4 + e]; } }
            const float t = (float)p / (float)(L - 1);
            const float dec = expf(-t * delta);
            af *= dec; ab *= dec;
            asum += fabsf(af) + fabsf(ab);
            buf[cl * RS + (L - 1 - p)] = af;
            if (p > 0) buf[cl * RS + (L - 1 + p)] = ab;
        }
        red[ps * 16 + cl] = asum;
        __syncthreads();
        if (tid < 16) { float tot = 0.f;
#pragma unroll
            for (int g = 0; g < 32; ++g) tot += red[g * 16 + tid];
            invs[tid] = 1.f / tot; }
        __syncthreads();
        bf16_t* gr = (bf16_t*)(P.ws + WS_FILTB) + (size_t)l * FILTB_PER + (ss ? FILTB_CTX : 0) + ((size_t)o * 1024 + cgp * 16) * GRL;
        const int half = GRL / 2;
        for (int idx = tid; idx < 16 * half; idx += NT) {
            const int cc = idx / half, x = (idx % half) * 2;
            const float iv = invs[cc];
            const float v0 = x < 2 * L - 1 ? buf[cc * RS + x] * iv : 0.f, v1 = x + 1 < 2 * L - 1 ? buf[cc * RS + x + 1] * iv : 0.f;
            *(unsigned*)(gr + (size_t)cc * GRL + x) = pk2(v0, v1);
        }
        __syncthreads();
    }
}

template <bool LAT>
__device__ __forceinline__ void convprep_item(CParams& P, int l, float* tile, int ct, int m0, int lane, int wave) {
    constexpr int NR = LAT ? 3 : 1;
    const float* proj = (const float*)(P.ws + WS_PROJ);
    float* RW = (float*)(P.ws + WS_RW);
    const float* cw = P.in[8] + (size_t)l * 9 * 6144;
    const int c = ct * 64 + lane;
    float wgt[9];
#pragma unroll
    for (int q = 0; q < 9; ++q) wgt[q] = cw[q * 6144 + c];
    const int row = LAT ? (((m0 - 4096) & 1023) >> 6) : 0;
    const int p0 = LAT ? wave * 8 : (m0 & 255) + wave * 8;
    constexpr int PMAX = LAT ? 63 : 255;
    const float* pc = proj + (size_t)(m0 + wave * 8) * 6144 + c;
    float u[NR][10];
#pragma unroll
    for (int ry = 0; ry < NR; ++ry) {
        const int dy = LAT ? ry - 1 : 0;
        const bool rok = LAT ? (row + dy >= 0 && row + dy <= 15) : true;
#pragma unroll
        for (int xx = 0; xx < 10; ++xx) {
            const int pp = p0 + xx - 1;
            const bool ok = rok && pp >= 0 && pp <= PMAX;
            u[ry][xx] = ok ? pc[(ptrdiff_t)(dy * 64 + xx - 1) * 6144] : 0.f;
        }
    }
    float y[8];
#pragma unroll
    for (int i = 0; i < 8; ++i) {
        float a = 0.f;
#pragma unroll
        for (int ry = 0; ry < NR; ++ry)
#pragma unroll
            for (int dx = 0; dx < 3; ++dx) a += u[ry][i + dx] * wgt[(LAT ? ry : 1) * 3 + dx];
        y[i] = a;
    }
    if (ct < 48) {
        const int arr = ct >> 4; const int cc = (ct & 15) * 64 + lane;
        float* dst = RW + (size_t)arr * AS + (size_t)(m0 + wave * 8) * 1024 + cc;
#pragma unroll
        for (int i = 0; i < 8; ++i) dst[(size_t)i * 1024] = y[i];
        if (arr == 1) {
            const float kkw = P.in[14][l * 1024 + cc];
            float* dk = RW + (size_t)3 * AS + (size_t)(m0 + wave * 8) * 1024 + cc;
#pragma unroll
            for (int i = 0; i < 8; ++i) { const float kr = y[i] * kkw; const float ssq = wave_sum(kr * kr); dk[(size_t)i * 1024] = kr * rsqrtf(ssq + 1e-12f); }
        }
    } else {
#pragma unroll
        for (int i = 0; i < 8; ++i) tile[lane * 65 + wave * 8 + i] = y[i];
    }
}
__device__ __forceinline__ void ph_convprep(CParams& P, int l, float* lds) {
    const int tid = tid_l(), lane = tid & 63, wave = tid >> 6;
    float* tile = lds;
    bf16_t* HT = (bf16_t*)(P.ws + WS_HT);
    for (int item = blockIdx.x; item < 128 * 96; item += gridDim.x) {
        const int ct = item % 96, tt = item / 96;
        const int m0 = tt * 64;
        if (m0 >= 4096) convprep_item<true>(P, l, tile, ct, m0, lane, wave);
        else convprep_item<false>(P, l, tile, ct, m0, lane, wave);
        if (ct >= 48) {
            __syncthreads();
            const int which = (ct - 48) >> 4; const int cbase = ((ct - 48) & 15) * 64;
#pragma unroll
            for (int i = 0; i < 8; ++i) { const int ch = wave * 8 + i; HT[((size_t)which * 1024 + cbase + ch) * M + m0 + lane] = f2bf(tile[ch * 65 + lane]); }
            __syncthreads();
        }
    }
}

typedef float f32x16 __attribute__((ext_vector_type(16)));
typedef short s16x8 __attribute__((ext_vector_type(8)));
typedef short s16x4 __attribute__((ext_vector_type(4)));
typedef unsigned u32x4_t __attribute__((ext_vector_type(4)));
#define MFMA16(a, b, c) __builtin_amdgcn_mfma_f32_16x16x32_bf16((a), (b), (c), 0, 0, 0)
__device__ __forceinline__ s16x8 mk8(unsigned a, unsigned b, unsigned c, unsigned d) { u32x4_t v = {a, b, c, d}; return __builtin_bit_cast(s16x8, v); }
__device__ __forceinline__ s16x8 pack_lo(f4 x) { return mk8(pk2(x[0], x[1]), pk2(x[2], x[3]), 0u, 0u); }
__device__ __forceinline__ s16x8 pack_2(f4 lo, f4 hi) { return mk8(pk2(lo[0], lo[1]), pk2(lo[2], lo[3]), pk2(hi[0], hi[1]), pk2(hi[2], hi[3])); }
constexpr int SC_KQ = 0, SC_RQ = 2304, SC_KD = 4608, SC_BD = 6912, SC_KDCT = 9216, SC_NBDCT = 11264, SC_VT = 13312, SC_GC = 15360, SC_BUF = 15616;

__device__ __forceinline__ void chain_chunk(const unsigned char* buf, f4 (&H)[4][4], float* gO, int mrow0, int mstep, int lane) {
    const int r = lane & 15, g = lane >> 4;
    const f4 z = (f4){0.f, 0.f, 0.f, 0.f};
    const unsigned char* rb = buf + r * 144 + g * 16;
    const s16x8 fKq0 = *(const s16x8*)(rb + SC_KQ), fKq1 = *(const s16x8*)(rb + SC_KQ + 64);
    const s16x8 fRq0 = *(const s16x8*)(rb + SC_RQ), fRq1 = *(const s16x8*)(rb + SC_RQ + 64);
    const s16x8 fKd0 = *(const s16x8*)(rb + SC_KD), fKd1 = *(const s16x8*)(rb + SC_KD + 64);
    const s16x8 fBd0 = *(const s16x8*)(rb + SC_BD), fBd1 = *(const s16x8*)(rb + SC_BD + 64);
    f4 Xd = MFMA16(fKq1, fBd1, MFMA16(fKq0, fBd0, z));
    f4 XTd = MFMA16(fBd1, fKq1, MFMA16(fBd0, fKq0, z));
    f4 MkkT = MFMA16(fKd1, fKq1, MFMA16(fKd0, fKq0, z));
    f4 MrkT = MFMA16(fKd1, fRq1, MFMA16(fKd0, fRq0, z));
    f4 MrbT = MFMA16(fBd1, fRq1, MFMA16(fBd0, fRq0, z));
    f4 eye;
#pragma unroll
    for (int q = 0; q < 4; ++q) { const int ri = 4 * g + q;
        Xd[q] = ri > r ? -Xd[q] : 0.f; XTd[q] = ri < r ? -XTd[q] : 0.f; MkkT[q] = ri < r ? MkkT[q] : 0.f;
        MrkT[q] = ri <= r ? MrkT[q] : 0.f; MrbT[q] = ri <= r ? -MrbT[q] : 0.f; eye[q] = ri == r ? 1.f : 0.f; }
    const s16x8 pX = pack_lo(Xd), pXT = pack_lo(XTd);
    const f4 X2d = MFMA16(pXT, pX, z), X2Td = MFMA16(pX, pXT, z);
    const s16x8 pX2 = pack_lo(X2d), pX2T = pack_lo(X2Td);
    const f4 X4d = MFMA16(pX2T, pX2, z), X4Td = MFMA16(pX2, pX2T, z);
    const f4 X8d = MFMA16(pack_lo(X4Td), pack_lo(X4d), z);
    const f4 U1T = MFMA16(pack_lo(X2d + eye), pack_lo(XTd + eye), z);
    const f4 U2T = MFMA16(pack_lo(X4d + eye), pack_lo(U1T), z);
    const f4 TT = MFMA16(pack_lo(X8d + eye), pack_lo(U2T), z);
    const s16x8 fTT = pack_lo(TT), fMkkT = pack_lo(MkkT), fOrb = pack_2(MrkT, MrbT);
    const unsigned char* pb = buf + r * 144 + g * 8;
    const uint2 k0l = *(const uint2*)(pb + SC_KQ), k0h = *(const uint2*)(pb + SC_KQ + 32), k1l = *(const uint2*)(pb + SC_KQ + 64), k1h = *(const uint2*)(pb + SC_KQ + 96);
    const uint2 r0l = *(const uint2*)(pb + SC_RQ), r0h = *(const uint2*)(pb + SC_RQ + 32), r1l = *(const uint2*)(pb + SC_RQ + 64), r1h = *(const uint2*)(pb + SC_RQ + 96);
    const s16x8 aK0 = mk8(k0l.x, k0l.y, k0h.x, k0h.y), aK1 = mk8(k1l.x, k1l.y, k1h.x, k1h.y);
    const s16x8 aR0 = mk8(r0l.x, r0l.y, r0h.x, r0h.y), aR1 = mk8(r1l.x, r1l.y, r1h.x, r1h.y);
#pragma unroll
    for (int vt = 0; vt < 4; ++vt) {
        const s16x8 h0 = pack_2(H[0][vt], H[1][vt]), h1 = pack_2(H[2][vt], H[3][vt]);
        f4 P0 = MFMA16(aK1, h1, MFMA16(aK0, h0, z));
        f4 O = MFMA16(aR1, h1, MFMA16(aR0, h0, z));
        const uint2 vv = *(const uint2*)(buf + SC_VT + (16 * vt + r) * 32 + g * 8);
        P0 = MFMA16(fMkkT, mk8(vv.x, vv.y, 0u, 0u), P0);
        const f4 Pm = MFMA16(fTT, pack_lo(P0), z);
        const s16x8 fB = mk8(vv.x, vv.y, pk2(Pm[0], Pm[1]), pk2(Pm[2], Pm[3]));
        O = MFMA16(fOrb, fB, O);
#pragma unroll
        for (int q = 0; q < 4; ++q) gO[(ptrdiff_t)(mrow0 + mstep * (4 * g + q)) * 1024 + 16 * vt + r] = O[q];
#pragma unroll
        for (int kt = 0; kt < 4; ++kt) {
            const unsigned char* pk = buf + SC_KDCT + (16 * kt + r) * 32 + g * 8;
            const uint2 al = *(const uint2*)pk, ah = *(const uint2*)(pk + 2048);
            const f4 gc = *(const f4*)(buf + SC_GC + (16 * kt + 4 * g) * 4);
            H[kt][vt] = MFMA16(mk8(al.x, al.y, ah.x, ah.y), fB, H[kt][vt] * gc);
        }
    }
}
typedef float f32x8 __attribute__((ext_vector_type(8)));
struct RawH { f32x16 w; f32x8 r, k, v, kk, a; };
__device__ __forceinline__ void prep_load(RawH& R, const float* RW, int d, int hf, int mrow0, int mstep, unsigned colx) {
    const float* wb = RW + (size_t)(4 + d) * AS;
#pragma unroll
    for (int t = 0; t < 16; ++t) { const float* rp = wb + (size_t)(unsigned)(mrow0 + mstep * t) * 1024; R.w[t] = rp[colx]; }
    const float* ab = RW + (size_t)(6 + d) * AS;
#pragma unroll
    for (int j = 0; j < 8; ++j) { const size_t ro = (size_t)(unsigned)(mrow0 + mstep * (8 * hf + j)) * 1024;
        const float* p0 = RW + ro; const float* p1 = RW + AS + ro; const float* p2 = RW + 2 * AS + ro; const float* p3 = RW + 3 * AS + ro; const float* p4 = ab + ro;
        R.r[j] = p0[colx]; R.k[j] = p1[colx]; R.v[j] = p2[colx]; R.kk[j] = p3[colx]; R.a[j] = p4[colx]; }
}
__device__ __forceinline__ void prep_proc(const RawH& R, unsigned char* buf, int hf, float ka, int lane) {
    float G = 1.f;
    if (hf) {
#pragma unroll
        for (int t = 0; t < 8; ++t) G *= R.w[t]; }
    float GC = 1.f;
#pragma unroll
    for (int t = 0; t < 16; ++t) GC *= R.w[t];
    f32x8 kdi, bdi;
#pragma unroll
    for (int j = 0; j < 8; ++j) {
        const int t = 8 * hf + j;
        *(bf16_t*)(buf + SC_KQ + t * 144 + lane * 2) = (bf16_t)pk2(R.kk[j] * G, 0.f);
        G *= hf ? R.w[8 + j] : R.w[j];
        *(bf16_t*)(buf + SC_RQ + t * 144 + lane * 2) = (bf16_t)pk2(R.r[j] * G, 0.f);
        const float iG = __builtin_amdgcn_rcpf(G);
        const float kd = R.k[j] * (1.f + (R.a[j] - 1.f) * ka), bb = R.kk[j] * R.a[j];
        kdi[j] = kd * iG; bdi[j] = bb * iG;
        *(bf16_t*)(buf + SC_KD + t * 144 + lane * 2) = (bf16_t)pk2(kdi[j], 0.f);
        *(bf16_t*)(buf + SC_BD + t * 144 + lane * 2) = (bf16_t)pk2(bdi[j], 0.f);
    }
    uint4 o1, o2, o3;
    o1.x = pk2(kdi[0] * GC, kdi[1] * GC); o1.y = pk2(kdi[2] * GC, kdi[3] * GC); o1.z = pk2(kdi[4] * GC, kdi[5] * GC); o1.w = pk2(kdi[6] * GC, kdi[7] * GC);
    o2.x = pk2(-bdi[0] * GC, -bdi[1] * GC); o2.y = pk2(-bdi[2] * GC, -bdi[3] * GC); o2.z = pk2(-bdi[4] * GC, -bdi[5] * GC); o2.w = pk2(-bdi[6] * GC, -bdi[7] * GC);
    o3.x = pk2(R.v[0], R.v[1]); o3.y = pk2(R.v[2], R.v[3]); o3.z = pk2(R.v[4], R.v[5]); o3.w = pk2(R.v[6], R.v[7]);
    *(uint4*)(buf + SC_KDCT + lane * 32 + hf * 16) = o1;
    *(uint4*)(buf + SC_NBDCT + lane * 32 + hf * 16) = o2;
    *(uint4*)(buf + SC_VT + lane * 32 + hf * 16) = o3;
    if (hf) *(float*)(buf + SC_GC + lane * 4) = GC;
}
__device__ __forceinline__ void lds_barrier() { asm volatile("s_waitcnt lgkmcnt(0)" ::: "memory"); __builtin_amdgcn_s_barrier(); asm volatile("" ::: "memory"); }
__device__ __forceinline__ void scan_item(CParams& P, int l, float* ldsf, int type, int b, int h) {
    unsigned char* lds = (unsigned char*)ldsf;
    const int tid = tid_l(), lane = tid & 63, wave = __builtin_amdgcn_readfirstlane(tid >> 6);
    const int L = type ? 256 : 1024, NCH = L / 16; const int mbase = type ? b * 256 : 4096 + b * 1024;
    if (wave < 2) {
        const int d = wave; const int mstep = d ? -1 : 1; const int mfirst = mbase + (d ? L - 1 : 0);
        const unsigned char* cbuf = lds + d * 2 * SC_BUF;
        float* gO = (float*)(P.ws + WS_PROJ) + (size_t)d * AS + h * 64;
        const int r = lane & 15, g = lane >> 4;
        f4 H[4][4];
        if (type == 0) { const float* s0 = P.in[3] + ((((size_t)b * 2 + l) * 2 + d) * 16 + h) * 4096;
#pragma unroll
            for (int kt = 0; kt < 4; ++kt)
#pragma unroll
                for (int vt = 0; vt < 4; ++vt) H[kt][vt] = *(const f4*)(s0 + (16 * vt + r) * 64 + 16 * kt + 4 * g); }
        else {
#pragma unroll
            for (int kt = 0; kt < 4; ++kt)
#pragma unroll
                for (int vt = 0; vt < 4; ++vt) H[kt][vt] = (f4){0.f, 0.f, 0.f, 0.f}; }
        lds_barrier();
        for (int c = 0; c < NCH; ++c) {
            chain_chunk(cbuf + (c & 1) * SC_BUF, H, gO, mfirst + mstep * 16 * c, mstep, lane);
            lds_barrier();
        }
        if (type == 1) { float* so = P.out + OUT_STATE + ((((size_t)b * 2 + l) * 2 + d) * 16 + h) * 4096;
#pragma unroll
            for (int kt = 0; kt < 4; ++kt)
#pragma unroll
                for (int vt = 0; vt < 4; ++vt) *(f4*)(so + (16 * vt + r) * 64 + 16 * kt + 4 * g) = H[kt][vt]; }
    } else if (wave != 4 && wave != 5) {
        const int d = wave & 1, hf = wave >> 2; const int mstep = d ? -1 : 1; const int mfirst = mbase + (d ? L - 1 : 0);
        unsigned char* cbuf = lds + d * 2 * SC_BUF;
        const float* RW = (const float*)(P.ws + WS_RW);
        const unsigned colx = (unsigned)(h * 64 + lane);
        const float ka = P.in[15][l * 1024 + colx];
        RawH RA, RB;
        prep_load(RA, RW, d, hf, mfirst, mstep, colx);
        for (int c = 0; c < NCH; c += 2) {
            prep_load(RB, RW, d, hf, mfirst + mstep * 16 * (c + 1), mstep, colx);
            prep_proc(RA, cbuf, hf, ka, lane);
            lds_barrier();
            if (c + 2 < NCH) prep_load(RA, RW, d, hf, mfirst + mstep * 16 * (c + 2), mstep, colx);
            prep_proc(RB, cbuf + SC_BUF, hf, ka, lane);
            lds_barrier();
        }
        lds_barrier();
    } else {
        for (int c = 0; c <= NCH; ++c) lds_barrier();
    }
}

template <int L>
__device__ __forceinline__ void hym_conv(const bf16_t* cps, const bf16_t* ubs, f32x16& acc) {
    constexpr int ND = (L == 1024) ? 39 : 15;
#pragma unroll 3
    for (int dd = 0; dd < ND; ++dd) {
#pragma unroll
        for (int kh = 0; kh < 2; ++kh) {
            const bf16_t* ap = cps - 32 * dd + 16 * kh; const bf16_t* bp = ubs - 32 * dd + 16 * kh;
            const s16x4 alo = *(const s16x4*)ap, ahi = *(const s16x4*)(ap + 4);
            const s16x8 av = __builtin_shufflevector(alo, ahi, 0, 1, 2, 3, 4, 5, 6, 7);
            const s16x8 bv = *(const s16x8*)bp;
            acc = __builtin_amdgcn_mfma_f32_32x32x16_bf16(av, bv, acc, 0, 0, 0);
        }
    }
}
template <int L>
__device__ __forceinline__ void hyena_item(CParams& P, int l, float* ldsf, int cp2) {
    constexpr bool LAT = (L == 1024); constexpr int NB = LAT ? 4 : 16; constexpr int GRL = 2 * L + 8; constexpr int ROWL = L + 448;
    bf16_t* sCP = (bf16_t*)ldsf;
    bf16_t* sU = sCP + 16 * GRL;
    bf16_t* sZ = sU + 2 * NB * ROWL;
    const int tid = tid_l(), lane = tid & 63, wave = tid >> 6;
    const int c0 = cp2 * 2; const int mbase = LAT ? 4096 : 0;
    bf16_t* HT = (bf16_t*)(P.ws + WS_HT);
    const bf16_t* filtb = (const bf16_t*)(P.ws + WS_FILTB) + (size_t)l * FILTB_PER + (LAT ? FILTB_CTX : 0);
    unsigned zz = 0u; asm volatile("" : "+v"(zz));
    for (int idx = tid; idx < 2 * NB * 56; idx += NT) { const int row = idx / 56, q = idx % 56;
        const int off = row * ROWL + (q < 28 ? q * 8 : 224 + L + (q - 28) * 8);
        *(uint4*)(sU + off) = make_uint4(zz, zz, zz, zz); *(uint4*)(sZ + off) = make_uint4(zz, zz, zz, zz); }
    for (int idx = tid; idx < 2 * 512; idx += NT) { const int ch = idx >> 9, q = idx & 511;
        const uint4 v = *(const uint4*)(HT + (size_t)(c0 + ch) * M + mbase + 8 * q);
        const int b = (8 * q) / L, t = (8 * q) % L; *(uint4*)(sU + (ch * NB + b) * ROWL + 224 + t) = v; }
    for (int idx = tid; idx < 16 * GRL; idx += NT) { const int y = idx % GRL, k = idx / GRL; const int sft = k & 3, o = (k >> 2) & 1, ch = k >> 3;
        const bf16_t* src = filtb + ((size_t)o * 1024 + c0 + ch) * GRL;
        sCP[idx] = (y + sft < GRL) ? src[y + sft] : (bf16_t)0; }
    __syncthreads();
    const int ch = wave >> 2, nt = wave & 3; const int c = c0 + ch;
    const int r = lane & 31, h = lane >> 5; const int Il = r >> 2, bl = r & 3;
    const int I = LAT ? 8 * nt + Il : Il; const int b = LAT ? bl : 4 * nt + bl;
    const int dlo = LAT ? 8 * nt - 31 : -7;
    const int X0 = L - 1 - (32 * dlo + r - 8 * h); const int sft = X0 & 3;
    const int urow = (ch * NB + b) * ROWL + 224;
    const int uoff = urow + 32 * (I - dlo) + 8 * h;
    f32x16 acc;
#pragma unroll
    for (int i = 0; i < 16; ++i) acc[i] = 0.f;
    hym_conv<L>(sCP + ((ch * 2 + 0) * 4 + sft) * GRL + (X0 - sft), sU + uoff, acc);
    const float bias1 = P.in[25][(l * 2 + 0) * 1024 + c], bias2 = P.in[25][(l * 2 + 1) * 1024 + c];
    const size_t gcol = (size_t)c * M + mbase + b * L + 32 * I + 4 * h;
    float z[16];
#pragma unroll
    for (int g4 = 0; g4 < 4; ++g4) {
        const int t0 = 32 * I + 8 * g4 + 4 * h;
        const uint2 xv = *(const uint2*)(HT + (size_t)1 * 1024 * M + gcol + 8 * g4);
        const uint2 uv = *(const uint2*)(sU + urow + t0);
        const float x1[4] = {__uint_as_float(xv.x << 16), __uint_as_float(xv.x & 0xffff0000u), __uint_as_float(xv.y << 16), __uint_as_float(xv.y & 0xffff0000u)};
        const float uu[4] = {__uint_as_float(uv.x << 16), __uint_as_float(uv.x & 0xffff0000u), __uint_as_float(uv.y << 16), __uint_as_float(uv.y & 0xffff0000u)};
#pragma unroll
        for (int e = 0; e < 4; ++e) z[4 * g4 + e] = x1[e] * (acc[4 * g4 + e] + bias1 * uu[e]);
        uint2 w; w.x = pk2(z[4 * g4], z[4 * g4 + 1]); w.y = pk2(z[4 * g4 + 2], z[4 * g4 + 3]);
        *(uint2*)(sZ + urow + t0) = w;
    }
    __syncthreads();
#pragma unroll
    for (int i = 0; i < 16; ++i) acc[i] = 0.f;
    hym_conv<L>(sCP + ((ch * 2 + 1) * 4 + sft) * GRL + (X0 - sft), sZ + uoff, acc);
#pragma unroll
    for (int g4 = 0; g4 < 4; ++g4) {
        const uint2 xv = *(const uint2*)(HT + (size_t)2 * 1024 * M + gcol + 8 * g4);
        const float x2[4] = {__uint_as_float(xv.x << 16), __uint_as_float(xv.x & 0xffff0000u), __uint_as_float(xv.y << 16), __uint_as_float(xv.y & 0xffff0000u)};
        float o4[4];
#pragma unroll
        for (int e = 0; e < 4; ++e) o4[e] = x2[e] * (acc[4 * g4 + e] + bias2 * z[4 * g4 + e]);
        uint2 w; w.x = pk2(o4[0], o4[1]); w.y = pk2(o4[2], o4[3]);
        *(uint2*)(HT + gcol + 8 * g4) = w;
    }
    __syncthreads();
}

__device__ __forceinline__ void ph_scan_hyena(CParams& P, int l, float* lds) {
    const int G = gridDim.x; constexpr int total = 64 + 256 + 512 + 512;
    for (int r = 0; r * G < total; ++r) {
        const int pos = (r & 1) ? G - 1 - (int)blockIdx.x : (int)blockIdx.x; const int j = r * G + pos;
        if (j >= total) continue;
        if (j < 64) scan_item(P, l, lds, 0, j >> 4, j & 15);
        else if (j < 320) scan_item(P, l, lds, 1, (j - 64) >> 4, (j - 64) & 15);
        else if (j < 832) hyena_item<1024>(P, l, lds, j - 320);
        else hyena_item<256>(P, l, lds, j - 832);
    }
}

__device__ __forceinline__ void ph_combine(CParams& P, int l, float* lds) {
    const int lane = tid_l() & 63, wave = tid_l() >> 6;
    const int gw = blockIdx.x * 8 + wave, ngw = gridDim.x * 8;
    const float* RW = (const float*)(P.ws + WS_RW);
    const float* O = (const float*)(P.ws + WS_PROJ);
    bf16_t* mix = (bf16_t*)(P.ws + WS_MIX);
    for (int m = gw; m < M; m += ngw) {
        const size_t rowo = (size_t)m * 1024 + lane * 4;
#pragma unroll
        for (int qi = 0; qi < 4; ++qi) {
            const size_t idx = rowo + qi * 256; const int cc = qi * 256 + lane * 4;
            const f4 o0 = *(const f4*)(O + idx), o1 = *(const f4*)(O + AS + idx);
            const f4 r = *(const f4*)(RW + idx), k = *(const f4*)(RW + AS + idx), v = *(const f4*)(RW + 2 * AS + idx);
            const f4 a0 = *(const f4*)(RW + 6 * AS + idx), a1 = *(const f4*)(RW + 7 * AS + idx), g = *(const f4*)(RW + 8 * AS + idx);
            const f4 lg = *(const f4*)(P.in[17] + l * 1024 + cc), lb = *(const f4*)(P.in[18] + l * 1024 + cc);
            const f4 ka = *(const f4*)(P.in[15] + l * 1024 + cc), rk = *(const f4*)(P.in[16] + l * 1024 + cc);
            const f4 o = o0 + o1;
            const f4 kds = k * ((a0 + a1 - 2.f) * ka + 2.f);
            const f4 pb = r * kds * rk;
            float s1 = (o[0] + o[1]) + (o[2] + o[3]);
            float s2 = (o[0] * o[0] + o[1] * o[1]) + (o[2] * o[2] + o[3] * o[3]);
            float s3 = (pb[0] + pb[1]) + (pb[2] + pb[3]);
#pragma unroll
            for (int sh = 1; sh < 16; sh <<= 1) { s1 += __shfl_xor(s1, sh); s2 += __shfl_xor(s2, sh); s3 += __shfl_xor(s3, sh); }
            const float mu = s1 * (1.f / 64.f); const float var = fmaxf(s2 * (1.f / 64.f) - mu * mu, 0.f);
            const float rs = rsqrtf(var + GN_EPS);
            const f4 res = ((o - mu) * rs * lg + lb + v * s3) * g;
            uint2 w; w.x = pk2(res[0], res[1]); w.y = pk2(res[2], res[3]);
            *(uint2*)(mix + (size_t)m * 2048 + cc) = w;
        }
    }
    bf16_t* tile = (bf16_t*)lds;
    const bf16_t* HT = (const bf16_t*)(P.ws + WS_HT);
    for (int item = blockIdx.x; item < 16 * 128; item += gridDim.x) {
        const int c0 = (item & 15) * 64, m0 = (item >> 4) * 64;
#pragma unroll
        for (int i = 0; i < 8; ++i) { const int ci = wave * 8 + i; tile[ci * 66 + lane] = HT[(size_t)(c0 + ci) * M + m0 + lane]; }
        __syncthreads();
#pragma unroll
        for (int i = 0; i < 8; ++i) { const int mi = wave * 8 + i; mix[(size_t)(m0 + mi) * 2048 + 1024 + c0 + lane] = tile[lane * 66 + mi]; }
        __syncthreads();
    }
}

#define XB_TMO      128
#define XB_XCNT(j)  (256  + 64 * (j))
#define XB_XSUB(j)  (1280 + 64 * (j))
#define XB_XGEN(j)  (2304 + 64 * (j))
#define XB_TOP      3328
#define XB_TOPGEN   3392
#define XCD_BAR_WORDS 3456
#define XB_SPIN_CAP (1u << 18)
#define LAS __attribute__((address_space(3)))

__device__ __forceinline__ unsigned xb_ld(unsigned* p)              { return __hip_atomic_load(p, __ATOMIC_RELAXED, __HIP_MEMORY_SCOPE_AGENT); }
__device__ __forceinline__ unsigned xb_add(unsigned* p, unsigned v) { return __hip_atomic_fetch_add(p, v, __ATOMIC_RELAXED, __HIP_MEMORY_SCOPE_AGENT); }
__device__ __forceinline__ unsigned xb_xcc_id() { return (unsigned)__builtin_amdgcn_s_getreg((3 << 11) | 20) & 0xFu; }
#define XB_SPIN(cond, bar) do { unsigned _sp = 0; while (cond) { __builtin_amdgcn_s_sleep(1); \
    if ((++_sp & 255u) == 0u) { if (xb_ld(&(bar)[XB_TMO])) break; if (_sp > XB_SPIN_CAP) { atomicAdd(&(bar)[XB_TMO], 1u); break; } } } } while (0)

struct XcdBarrier {
    unsigned* bar; unsigned x;
    volatile LAS unsigned* st;
};

__device__ __forceinline__ XcdBarrier xcd_barrier_post(unsigned* bar, volatile LAS unsigned* st) {
    XcdBarrier b; b.bar = bar; b.x = xb_xcc_id(); b.st = st;
    if (threadIdx.x == 0) (void)xb_add(&bar[XB_XCNT(b.x)], 1u);
    return b;
}
__device__ __forceinline__ void xcd_barrier_complete(unsigned* bar, unsigned x, unsigned& nloc, unsigned& nx) {
    const unsigned G = gridDim.x * gridDim.y * gridDim.z;
    unsigned sum, cnt, mine, sp = 0u;
    for (;;) {
        sum = 0u; cnt = 0u; mine = 0u;
#pragma unroll
        for (unsigned j = 0; j < 16; ++j) { const unsigned c = xb_ld(&bar[XB_XCNT(j)]); sum += c; cnt += (c > 0u) ? 1u : 0u; mine = (j == x) ? c : mine; }
        if (sum == G) break;
        __builtin_amdgcn_s_sleep(1);
        if ((++sp & 255u) == 0u) { if (xb_ld(&bar[XB_TMO])) break; if (sp > XB_SPIN_CAP) { atomicAdd(&bar[XB_TMO], 1u); break; } }
    }
    nloc = mine > 0u ? mine : 1u; nx = cnt > 0u ? cnt : 1u;
}

__device__ __forceinline__ void xcd_barrier(const XcdBarrier& b) {
    asm volatile("s_waitcnt vmcnt(0)" ::: "memory");
    __syncthreads();
    if (threadIdx.x == 0) {
        unsigned* bar = b.bar;
        __builtin_amdgcn_s_waitcnt(0);
        unsigned nloc = b.st[0], nx = b.st[1];
        if (nloc == 0u) { xcd_barrier_complete(bar, b.x, nloc, nx); b.st[0] = nloc; b.st[1] = nx; }
        const unsigned old = xb_add(&bar[XB_XSUB(b.x)], 1u);
        const unsigned gen = old / nloc;
        if (old + 1u == (gen + 1u) * nloc) {
            __builtin_amdgcn_fence(__ATOMIC_RELEASE, "agent");
            asm volatile("s_waitcnt vmcnt(0)" ::: "memory");
            const unsigned og = xb_add(&bar[XB_TOP], 1u);
            const unsigned tg = og / nx;
            if (og + 1u == (tg + 1u) * nx) xb_add(&bar[XB_TOPGEN], 1u);
            else XB_SPIN(xb_ld(&bar[XB_TOPGEN]) == tg, bar);
            __builtin_amdgcn_fence(__ATOMIC_ACQUIRE, "agent");
            xb_add(&bar[XB_XGEN(b.x)], 1u);
            asm volatile("s_waitcnt vmcnt(0)" ::: "memory");
        } else {
            XB_SPIN(xb_ld(&bar[XB_XGEN(b.x)]) == gen, bar);
            __builtin_amdgcn_fence(__ATOMIC_ACQUIRE, "agent");
            asm volatile("s_waitcnt vmcnt(0)" ::: "memory");
        }
    }
    __syncthreads();
}


constexpr int NPH = 2 + 9 * DEPTH;
#ifndef PHM
#define PHM 1023
#endif
#ifndef DUPM
#define DUPM 0
#endif
#ifndef XSYNC
#define XSYNC 0
#endif
__device__ __forceinline__ XcdBarrier make_bar(unsigned char* lds_raw) {
    CParams* kp = (CParams*)__builtin_amdgcn_kernarg_segment_ptr(); asm volatile("" : "+s"(kp));
    XcdBarrier b; b.bar = (unsigned*)kp->ws; b.x = xb_xcc_id(); b.st = (volatile LAS unsigned*)(lds_raw + (LDS_BYTES - 16)); return b;
}
__global__ void __launch_bounds__(NT, 2) mega(Params Pv) {
    extern __shared__ __attribute__((aligned(16))) unsigned char lds_raw[];
    { volatile LAS unsigned* xst = (volatile LAS unsigned*)(lds_raw + (LDS_BYTES - 16));
      if (threadIdx.x == 0) { xst[0] = 0u; xst[1] = 0u; }
      __syncthreads();
      (void)xcd_barrier_post((unsigned*)Pv.ws, xst); }
#pragma unroll 1
    for (int ph = 0; ph < NPH; ++ph) {
#if DUPM
        const int nrep = (ph >= 2 && ((DUPM >> ((ph - 2) % 9)) & 1)) ? 2 : ((ph < 2 && ((DUPM >> (10 + ph)) & 1)) ? 2 : 1);
        for (int rep = 0; rep < nrep; ++rep) {
#else
        {
#endif
        CParams* kp = (CParams*)__builtin_amdgcn_kernarg_segment_ptr(); asm volatile("" : "+s"(kp));
        CParams& P = *kp;
        float* ldsf = (float*)lds_raw;
        PG8_LAS unsigned char* ldsg = (PG8_LAS unsigned char*)lds_raw;
        const int G = gridDim.x, bid = blockIdx.x;
        if (ph == 0 && (PHM & 1)) { ph_mod(P, ldsf); ph_filt_hidden(P); __syncthreads(); ph_convert(P, 0, ldsf); }
        else if (ph == 1 && (PHM & 2)) { ph_rowpass(P, 0, 0); ph_filt_final(P, ldsf); }
        else {
            const int l = (ph - 2) / 9, s = (ph - 2) % 9;
            const float* mod = (const float*)(P.ws + WS_MOD);
            if (s == 0 && (PHM & 4)) {
                pg8::Gemm g{(const bf16_t*)(P.ws + WS_H), (const bf16_t*)(P.ws + WS_WIN), M, NPAD, D}; pg8::StaticOrder S; S.init(M, NPAD, G, bid);
                pg8::EpiProj E{(float*)(P.ws + WS_PROJ), (bf16_t*)(P.ws + WS_LACT)};
                pg8::gemm_phase<pg8::EpiProj, pg8::StaticOrder, true, true>(ldsg, g, S, E);
            } else if (s == 1 && (PHM & 8)) {
                pg8::Gemm g{(const bf16_t*)(P.ws + WS_LACT), (const bf16_t*)(P.ws + WS_WL), M, NL, KL}; pg8::StaticOrder S; S.init(M, NL, G, bid);
                pg8::EpiLora E{(float*)(P.ws + WS_RW) + 4 * AS, AS, P.in[10] + l * 2048, P.in[12] + l * 2048};
                pg8::gemm_phase<pg8::EpiLora, pg8::StaticOrder, true, true>(ldsg, g, S, E);
                __syncthreads();
                ph_convprep(P, l, ldsf);
            } else if (s == 2 && (PHM & 16)) { ph_scan_hyena(P, l, ldsf); }
            else if (s == 3 && (PHM & 32)) { ph_combine(P, l, ldsf); }
            else if ((s == 4 || s == 7) && (PHM & 64)) {
                pg8::Gemm g{(const bf16_t*)(P.ws + (s == 4 ? WS_MIX : WS_PROJ)), (const bf16_t*)(P.ws + (s == 4 ? WS_WOUT : WS_W2)), M, D, s == 4 ? D : DFF}; pg8::StaticOrder S; S.init(M, D, G, bid);
                pg8::EpiRes E{P.out, mod + (size_t)l * 5 * 12288 + (s == 4 ? 2 : 5) * 2048, ALPHA};
                pg8::gemm_phase<pg8::EpiRes, pg8::StaticOrder, true, true>(ldsg, g, S, E);
            } else if (s == 5 && (PHM & 128)) { ph_rowpass(P, 1, l); }
            else if (s == 6 && (PHM & 256)) {
                pg8::Gemm g{(const bf16_t*)(P.ws + WS_H), (const bf16_t*)(P.ws + WS_W1), M, DFF, D}; pg8::StaticOrder S; S.init(M, DFF, G, bid);
                pg8::EpiRelu2 E{(bf16_t*)(P.ws + WS_PROJ), DFF};
                pg8::gemm_phase<pg8::EpiRelu2, pg8::StaticOrder, true, true>(ldsg, g, S, E);
            } else if (PHM & 512) { ph_rowpass(P, 2, l); if (l + 1 < DEPTH) ph_convert(P, l + 1, ldsf); }
        }
#if DUPM
        if (ph + 1 < NPH || rep + 1 < nrep) { if (ph == 0 && rep == 0) cg::this_grid().sync(); else xcd_barrier(make_bar(lds_raw)); }
#else
        if (ph + 1 < NPH) { if (ph == 0) cg::this_grid().sync(); else xcd_barrier(make_bar(lds_raw)); }
#endif
        if (ph == 1) for (int xs = 0; xs < XSYNC; ++xs) xcd_barrier(make_bar(lds_raw));
        }
    }
}

#ifndef MK_MULTI
#define MK_MULTI 0
#endif
extern "C" void kernel_launch(void* const* d_in, const int* in_sizes, int n_in, void* d_out, int out_size, void* d_ws, size_t ws_size, hipStream_t stream) {
    static int grid = 0;
    if (grid == 0) {
        int dev = 0, cus = 0, per_cu = 0;
        if (n_in != 33 || ws_size < WS_END) { fprintf(stderr, "kernel_launch: unexpected n_in %d or ws_size %zu (< %zu)\n", n_in, ws_size, (size_t)WS_END); grid = -1; return; }
        hipGetDevice(&dev);
        hipDeviceGetAttribute(&cus, hipDeviceAttributeMultiprocessorCount, dev);
        if (hipFuncSetAttribute((const void*)mega, hipFuncAttributeMaxDynamicSharedMemorySize, LDS_BYTES) != hipSuccess) { fprintf(stderr, "hipFuncSetAttribute failed\n"); grid = -1; return; }
        if (hipOccupancyMaxActiveBlocksPerMultiprocessor(&per_cu, (const void*)mega, NT, LDS_BYTES) != hipSuccess || per_cu < 1) { fprintf(stderr, "occupancy query failed (%d)\n", per_cu); grid = -1; return; }
        grid = cus;
    }
    if (grid < 0) return;
    Params p{};
    for (int i = 0; i < 33; ++i) p.in[i] = (const float*)d_in[i];
    p.out = (float*)d_out; p.ws = (unsigned char*)d_ws;
    if (hipMemsetAsync(d_ws, 0, 16384, stream) != hipSuccess) { fprintf(stderr, "memset failed\n"); return; }
    p.ph_lo = 0; p.ph_hi = NPH;
    void* args[] = {&p};
    hipError_t e = hipLaunchCooperativeKernel((const void*)mega, dim3(grid), dim3(NT), args, LDS_BYTES, stream);
    if (e != hipSuccess) fprintf(stderr, "cooperative launch failed: %s (grid %d)\n", hipGetErrorString(e), grid);
}
```

```cpp
#include <hip/hip_runtime.h>
#include <hip/hip_cooperative_groups.h>
#include <cstdio>
#include <cstdint>
namespace cg = cooperative_groups;

namespace pg8 {
#define PG8_LAS __attribute__((address_space(3)))
typedef unsigned short bf16_t;
typedef short bf16x8 __attribute__((ext_vector_type(8)));
typedef float f32x4 __attribute__((ext_vector_type(4)));
typedef unsigned u32x4 __attribute__((ext_vector_type(4)));
constexpr int BM = 256, BK = 64, HALF = 128, HTB = HALF * BK * 2  , STAGE_BYTES = 8 * HTB, NXCD = 8, WGM = 8;

__host__ __device__ __forceinline__ int lds_byte(int r, int c) { const int st = (r >> 4) * 2 + (c >> 5), rr = r & 15, cc = c & 31, ob = rr * 64 + cc * 2; return st * 1024 + (ob ^ (((ob >> 9) & 1) << 5)); }
__host__ __device__ __forceinline__ void stage_rc(int b, int& R, int& C) { const int st = b / 1024, sb = b % 1024, swz = sb ^ (((sb >> 9) & 1) << 5); R = (st >> 1) * 16 + swz / 64; C = (st & 1) * 32 + (swz % 64) / 2; }
__host__ __device__ __forceinline__ int perm32(int rho) { const int n = rho >> 4, i = rho & 15; return 8 * (i >> 2) + 4 * n + (i & 3); }

struct Unit { int pm, pn; };
struct Gemm { const bf16_t* A; const bf16_t* Bt; int M, N, K; };

struct StaticOrder {
    int nM, nN, nwg, G, c;
    __host__ __device__ void init(int M, int N, int G_, int c_) { nM = M / BM; nN = N / BM; nwg = nM * nN; G = G_; c = c_; }
    __host__ __device__ bool next(int i, Unit& u) const {
        const long L = (long)i * G + c; if (L >= nwg) return false;
        int wgid = (int)L; { const int q = nwg / NXCD, r = nwg % NXCD, xcd = wgid % NXCD, off = wgid / NXCD; wgid = (xcd < r ? xcd * (q + 1) : r * (q + 1) + (xcd - r) * q) + off; }
        const int nig = WGM * nN, gid = wgid / nig, fm = gid * WGM, gsz = (nM - fm) < WGM ? (nM - fm) : WGM;
        u.pm = fm + ((wgid % nig) % gsz); u.pn = (wgid % nig) / gsz; return true;
    }
    __device__ __forceinline__ void a_ready(const Unit&) const {}
    __device__ __forceinline__ void done(const Unit&) const {}
};

typedef __bf16 bf16x2v __attribute__((ext_vector_type(2)));
typedef float f32x2v __attribute__((ext_vector_type(2)));
__device__ __forceinline__ unsigned cvt_pk_bf16(float lo, float hi) { const f32x2v v = {lo, hi}; const bf16x2v b = __builtin_convertvector(v, bf16x2v); return __builtin_bit_cast(unsigned, b); }
typedef float f32x2 __attribute__((ext_vector_type(2)));

__device__ __forceinline__ float sigm(float x) { return __builtin_amdgcn_rcpf(1.f + __expf(-x)); }
struct EpiProj {
    static constexpr bool PERM = true, AFTER_DRAIN = false;
    bf16_t* proj; bf16_t* lact;
    __device__ __forceinline__ void operator()(const f32x4 (&acc)[2][2][4][2], const Unit& u, int wr, int wc, int fr, int fq) const {
        const int row0 = u.pm * BM + wr * 64 + fr, col0 = u.pn * BM + wc * 32 + 8 * fq;
        if (u.pn < 24) {
#pragma unroll
            for (int ai = 0; ai < 2; ++ai)
#pragma unroll
                for (int m = 0; m < 4; ++m) { bf16_t* rowp = proj + (size_t)(row0 + ai * HALF + m * 16) * 6144 + col0;
#pragma unroll
                    for (int bj = 0; bj < 2; ++bj) { const f32x4 v0 = acc[ai][bj][m][0], v1 = acc[ai][bj][m][1];
                        u32x4 w; w.x = cvt_pk_bf16(v0[0], v0[1]); w.y = cvt_pk_bf16(v0[2], v0[3]); w.z = cvt_pk_bf16(v1[0], v1[1]); w.w = cvt_pk_bf16(v1[2], v1[3]);
                        *(u32x4*)(rowp + bj * HALF) = w; } }
        } else {
#pragma unroll
            for (int ai = 0; ai < 2; ++ai)
#pragma unroll
                for (int m = 0; m < 4; ++m) { bf16_t* rowp = lact + (size_t)(row0 + ai * HALF + m * 16) * 384;
#pragma unroll
                    for (int bj = 0; bj < 2; ++bj)
#pragma unroll
                        for (int n = 0; n < 2; ++n) {
                            const int cl = col0 - 6144 + bj * HALF + 4 * n;
                            if (cl < 384) {
                                f32x4 v = acc[ai][bj][m][n];
                                if (cl < 64) { v[0] = tanhf(v[0]); v[1] = tanhf(v[1]); v[2] = tanhf(v[2]); v[3] = tanhf(v[3]); }
                                else if (cl < 128) { }
                                else if (cl < 288) { v[0] = sigm(v[0]); v[1] = sigm(v[1]); v[2] = sigm(v[2]); v[3] = sigm(v[3]); }
                                else { v = (f32x4){0.f, 0.f, 0.f, 0.f}; }
                                uint2 w; w.x = cvt_pk_bf16(v[0], v[1]); w.y = cvt_pk_bf16(v[2], v[3]);
                                *(uint2*)(rowp + cl) = w;
                            }
                        } }
        }
    }
};
struct EpiLora {
    static constexpr bool PERM = false, AFTER_DRAIN = false;
    float* arr0; size_t arr_stride;
    const float* w0; const float* a0;
    template <int MODE>
    __device__ __forceinline__ void body(const f32x4 (&acc)[2][2][4][2], float* base, const float* bptr, int row0, int col0, float bsc, bool isg) const {
#pragma unroll
        for (int ai = 0; ai < 2; ++ai)
#pragma unroll
            for (int m = 0; m < 4; ++m) { float* rowp = base + (size_t)(row0 + ai * HALF + m * 16) * 1024 + col0;
#pragma unroll
                for (int bj = 0; bj < 2; ++bj)
#pragma unroll
                    for (int n = 0; n < 2; ++n) {
                        f32x4 v = acc[ai][bj][m][n];
                        v = v + *(const f32x4*)(bptr + col0 + bj * HALF + n * 16) * bsc;
#pragma unroll
                        for (int e = 0; e < 4; ++e) { const float sg = sigm(v[e]); v[e] = MODE == 0 ? __expf(-0.6065306597126334f * sg) : (isg ? v[e] : sg); }
                        *(f32x4*)(rowp + bj * HALF + n * 16) = v;
                    } }
    }
    __device__ __forceinline__ void operator()(const f32x4 (&acc)[2][2][4][2], const Unit& u, int wr, int wc, int fr, int fq) const {
        const int which = u.pn >> 2;
        const int row0 = u.pm * BM + wr * 64 + fr, col0 = (u.pn & 3) * BM + wc * 32 + 4 * fq;
        float* base = arr0 + (size_t)which * arr_stride;
        if (which < 2) body<0>(acc, base, w0 + which * 1024, row0, col0, 1.f, false);
        else body<1>(acc, base, a0 + ((which - 2) & 1) * 1024, row0, col0, which < 4 ? 1.f : 0.f, which >= 4);
    }
};
struct EpiRes {
    static constexpr bool PERM = false, AFTER_DRAIN = false;
    float* X; const float* gate;
    float alpha;
    __device__ __forceinline__ void operator()(const f32x4 (&acc)[2][2][4][2], const Unit& u, int wr, int wc, int fr, int fq) const {
        const int row0 = u.pm * BM + wr * 64 + fr, col0 = u.pn * BM + wc * 32 + 4 * fq;
        const int bidx = u.pm < 16 ? 0 : 1 + ((u.pm - 16) >> 2);
        const float* gp = gate + (size_t)bidx * 12288 + col0;
        f32x4 gv[2][2];
#pragma unroll
        for (int bj = 0; bj < 2; ++bj)
#pragma unroll
            for (int n = 0; n < 2; ++n) gv[bj][n] = *(const f32x4*)(gp + bj * HALF + n * 16);
#pragma unroll
        for (int ai = 0; ai < 2; ++ai)
#pragma unroll
            for (int m = 0; m < 4; ++m) { float* rowp = X + (size_t)(row0 + ai * HALF + m * 16) * 2048 + col0;
#pragma unroll
                for (int bj = 0; bj < 2; ++bj)
#pragma unroll
                    for (int n = 0; n < 2; ++n) {
                        f32x4* p = (f32x4*)(rowp + bj * HALF + n * 16);
                        const f32x4 xv = *p;
                        *p = xv * alpha + gv[bj][n] * acc[ai][bj][m][n];
                    } }
    }
};
struct EpiRelu2 {
    static constexpr bool PERM = true, AFTER_DRAIN = false;
    bf16_t* O; int ldc;
    __device__ __forceinline__ void operator()(const f32x4 (&acc)[2][2][4][2], const Unit& u, int wr, int wc, int fr, int fq) const {
        const int row0 = u.pm * BM + wr * 64 + fr, col0 = u.pn * BM + wc * 32 + 8 * fq;
#pragma unroll
        for (int ai = 0; ai < 2; ++ai)
#pragma unroll
            for (int m = 0; m < 4; ++m) { bf16_t* rowp = O + (size_t)(row0 + ai * HALF + m * 16) * ldc + col0;
#pragma unroll
                for (int bj = 0; bj < 2; ++bj) { f32x4 v0 = acc[ai][bj][m][0], v1 = acc[ai][bj][m][1];
#pragma unroll
                    for (int e = 0; e < 4; ++e) { const float a = fmaxf(v0[e], 0.f), b = fmaxf(v1[e], 0.f); v0[e] = a * a; v1[e] = b * b; }
                    u32x4 w; w.x = cvt_pk_bf16(v0[0], v0[1]); w.y = cvt_pk_bf16(v0[2], v0[3]); w.z = cvt_pk_bf16(v1[0], v1[1]); w.w = cvt_pk_bf16(v1[2], v1[3]);
                    *(u32x4*)(rowp + bj * HALF) = w; } }
    }
};

template <class Epi, class Sched, bool ALIGN_EPI = false, bool SP2 = false>
__device__ __forceinline__ void gemm_phase(PG8_LAS unsigned char* lds, const Gemm g, const Sched& S, const Epi& E) {
    int tid = threadIdx.x; asm volatile("" : "+v"(tid)); const int wid = __builtin_amdgcn_readfirstlane(tid >> 6), lane = tid & 63, wr = wid >> 2, wc = wid & 3, fr = lane & 15, fq = lane >> 4;
    const int K = g.K, nt = K / BK;
    unsigned voffA[2], voffB[2];
#pragma unroll
    for (int i = 0; i < 2; ++i) { int R, C; stage_rc(tid * 16 + i * 8192, R, C); const int Rb = Epi::PERM ? ((R & ~31) + perm32(R & 31)) : R;
        voffA[i] = (unsigned)(R * K + C) * 2u; voffB[i] = (unsigned)(Rb * K + C) * 2u; }
    const size_t kstep = (size_t)(BK * 2);
    const size_t hstep = (size_t)HALF * K * 2;
    const size_t tstep = 2 * hstep;
    const unsigned ldsw = (unsigned)wid * 1024u;
    const int aoff = lds_byte(wr * 64 + fr, fq * 8), boff = lds_byte(wc * 32 + fr, fq * 8);
#define PG8_SA(b, h) (((b) * 2 + (h)) * HTB)
#define PG8_SB(b, h) ((4 + (b) * 2 + (h)) * HTB)
#define PG8_STAGE(bufoff, gbase, voff) do { _Pragma("unroll") for (int _i = 0; _i < 2; ++_i) \
        __builtin_amdgcn_global_load_lds((const unsigned*)((const char*)(gbase) + (voff)[_i]), (PG8_LAS unsigned*)(lds + (bufoff) + ldsw + _i * 8192), 16, 0, 0); } while (0)
#define PG8_LDA(dst, b, h) do { _Pragma("unroll") for (int m = 0; m < 4; ++m) _Pragma("unroll") for (int k = 0; k < 2; ++k) dst[m][k] = *(const PG8_LAS bf16x8*)(lds + PG8_SA(b, h) + aoff + m * 2048 + k * 1024); } while (0)
#define PG8_LDB(dst, b, h) do { _Pragma("unroll") for (int n = 0; n < 2; ++n) _Pragma("unroll") for (int k = 0; k < 2; ++k) dst[n][k] = *(const PG8_LAS bf16x8*)(lds + PG8_SB(b, h) + boff + n * 2048 + k * 1024); } while (0)
#define PG8_MMA(ai, bj, At, Bt) do { __builtin_amdgcn_s_setprio(1); _Pragma("unroll") for (int m = 0; m < 4; ++m) _Pragma("unroll") for (int n = 0; n < 2; ++n) _Pragma("unroll") for (int k = 0; k < 2; ++k) \
        acc[ai][bj][m][n] = __builtin_amdgcn_mfma_f32_16x16x32_bf16(Bt[n][k], At[m][k], acc[ai][bj][m][n], 0, 0, 0); __builtin_amdgcn_s_setprio(0); } while (0)
#define PG8_WAIT_V(n) asm volatile("s_waitcnt vmcnt(" #n ")" ::: "memory")
#define PG8_WAIT_L(n) asm volatile("s_waitcnt lgkmcnt(" #n ")" ::: "memory")
#define PG8_BAR __builtin_amdgcn_s_barrier()
#define PG8_SCHED __builtin_amdgcn_sched_barrier(0)
    Unit cur, nxt; int ui = 0;
    if (!S.next(0, cur)) return;
    f32x4 acc[2][2][4][2];
#pragma unroll
    for (int a = 0; a < 2; ++a)
#pragma unroll
        for (int b = 0; b < 2; ++b)
#pragma unroll
            for (int m = 0; m < 4; ++m)
#pragma unroll
                for (int n = 0; n < 2; ++n) acc[a][b][m][n] = (f32x4){0.f, 0.f, 0.f, 0.f};
    bf16x8 At[4][2], B0[2][2], B1[2][2];
    const char* cA = (const char*)g.A + (size_t)cur.pm * tstep; const char* cB = (const char*)g.Bt + (size_t)cur.pn * tstep;
    S.a_ready(cur);
    if constexpr (SP2) {
        PG8_STAGE(PG8_SB(0, 0), cB, voffB); PG8_STAGE(PG8_SB(0, 1), cB + hstep, voffB); PG8_STAGE(PG8_SA(0, 0), cA, voffA); PG8_STAGE(PG8_SA(0, 1), cA + hstep, voffA);
        if (wr == 1) PG8_BAR;
        PG8_WAIT_V(2); PG8_BAR;
        PG8_STAGE(PG8_SB(1, 0), cB + kstep, voffB); PG8_STAGE(PG8_SA(1, 0), cA + kstep, voffA); PG8_STAGE(PG8_SB(1, 1), cB + hstep + kstep, voffB);
        PG8_WAIT_V(6); PG8_BAR;
    } else {
        PG8_STAGE(PG8_SB(0, 0), cB, voffB); PG8_STAGE(PG8_SA(0, 0), cA, voffA); PG8_STAGE(PG8_SB(0, 1), cB + hstep, voffB); PG8_STAGE(PG8_SA(0, 1), cA + hstep, voffA);
        if (wr == 1) PG8_BAR;
        PG8_WAIT_V(4); PG8_BAR;
        PG8_STAGE(PG8_SB(1, 0), cB + kstep, voffB); PG8_STAGE(PG8_SA(1, 0), cA + kstep, voffA); PG8_STAGE(PG8_SB(1, 1), cB + hstep + kstep, voffB);
        PG8_WAIT_V(6); PG8_BAR;
    }
    for (;;) {
        const bool has_next = S.next(ui + 1, nxt);
        const char* nA = has_next ? (const char*)g.A + (size_t)nxt.pm * tstep : cA; const char* nB = has_next ? (const char*)g.Bt + (size_t)nxt.pn * tstep : cB;
        for (int t = 0; t < nt; t += 2) {
            const bool last = (t == nt - 2);
            const char* a1 = cA + (size_t)(t + 1) * kstep;
            const char* a2 = last ? nA : cA + (size_t)(t + 2) * kstep; const char* b2 = last ? nB : cB + (size_t)(t + 2) * kstep;
            const char* a3 = a2 + kstep; const char* b3 = b2 + kstep;
            if (last && has_next) S.a_ready(nxt);
            if constexpr (SP2) {
            PG8_LDB(B0, 0, 0); PG8_LDB(B1, 0, 1); PG8_SCHED; PG8_LDA(At, 0, 0); PG8_STAGE(PG8_SA(1, 1), a1 + hstep, voffA);
            PG8_WAIT_V(8); PG8_WAIT_L(0); PG8_BAR; PG8_MMA(0, 0, At, B0); PG8_MMA(0, 1, At, B1); PG8_BAR; PG8_SCHED;
            PG8_LDA(At, 0, 1); PG8_STAGE(PG8_SB(0, 0), b2, voffB); PG8_STAGE(PG8_SB(0, 1), b2 + hstep, voffB); PG8_STAGE(PG8_SA(0, 0), a2, voffA);
            PG8_WAIT_V(8); PG8_WAIT_L(0); PG8_BAR; PG8_MMA(1, 0, At, B0); PG8_MMA(1, 1, At, B1); PG8_BAR; PG8_SCHED;
            PG8_LDB(B0, 1, 0); PG8_LDB(B1, 1, 1); PG8_SCHED; PG8_LDA(At, 1, 0); PG8_STAGE(PG8_SA(0, 1), a2 + hstep, voffA);
            PG8_WAIT_V(8); PG8_WAIT_L(0); PG8_BAR; PG8_MMA(0, 0, At, B0); PG8_MMA(0, 1, At, B1); PG8_BAR; PG8_SCHED;
            PG8_LDA(At, 1, 1); PG8_STAGE(PG8_SB(1, 0), b3, voffB); PG8_STAGE(PG8_SB(1, 1), b3 + hstep, voffB); PG8_STAGE(PG8_SA(1, 0), a3, voffA);
            PG8_WAIT_V(8); PG8_WAIT_L(0); PG8_BAR; PG8_MMA(1, 0, At, B0); PG8_MMA(1, 1, At, B1); PG8_BAR; PG8_SCHED;
            } else {
            PG8_LDB(B0, 0, 0); PG8_SCHED; PG8_LDA(At, 0, 0); PG8_STAGE(PG8_SA(1, 1), a1 + hstep, voffA);
            PG8_WAIT_L(8); PG8_BAR; PG8_WAIT_L(0); PG8_MMA(0, 0, At, B0); PG8_BAR; PG8_SCHED;
            PG8_LDB(B1, 0, 1); PG8_STAGE(PG8_SB(0, 0), b2, voffB);
            PG8_BAR; PG8_WAIT_L(0); PG8_MMA(0, 1, At, B1); PG8_BAR;
            PG8_LDA(At, 0, 1); PG8_STAGE(PG8_SA(0, 0), a2, voffA);
            PG8_BAR; PG8_WAIT_L(0); PG8_MMA(1, 0, At, B0); PG8_BAR; PG8_SCHED;
            PG8_STAGE(PG8_SB(0, 1), b2 + hstep, voffB);
            PG8_WAIT_V(6); PG8_BAR; PG8_MMA(1, 1, At, B1); PG8_BAR;
            PG8_LDB(B0, 1, 0); PG8_SCHED; PG8_LDA(At, 1, 0); PG8_STAGE(PG8_SA(0, 1), a2 + hstep, voffA);
            PG8_WAIT_L(8); PG8_BAR; PG8_WAIT_L(0); PG8_MMA(0, 0, At, B0); PG8_BAR; PG8_SCHED;
            PG8_LDB(B1, 1, 1); PG8_STAGE(PG8_SB(1, 0), b3, voffB);
            PG8_BAR; PG8_WAIT_L(0); PG8_MMA(0, 1, At, B1); PG8_BAR;
            PG8_LDA(At, 1, 1); PG8_STAGE(PG8_SA(1, 0), a3, voffA);
            PG8_BAR; PG8_WAIT_L(0); PG8_MMA(1, 0, At, B0); PG8_BAR; PG8_SCHED;
            PG8_STAGE(PG8_SB(1, 1), b3 + hstep, voffB);
            PG8_WAIT_V(6); PG8_BAR; PG8_MMA(1, 1, At, B1); PG8_BAR;
            }
        }
        if constexpr (ALIGN_EPI) { if (wr == 0) PG8_BAR; }
        if constexpr (!Epi::AFTER_DRAIN) { int t2 = threadIdx.x; asm volatile("" : "+v"(t2)); const int fr2 = t2 & 15, fq2 = (t2 & 63) >> 4; E(acc, cur, wr, wc, fr2, fq2); S.done(cur); }
        if (!has_next) break;
#pragma unroll
        for (int a = 0; a < 2; ++a)
#pragma unroll
            for (int b = 0; b < 2; ++b)
#pragma unroll
                for (int m = 0; m < 4; ++m)
#pragma unroll
                    for (int n = 0; n < 2; ++n) acc[a][b][m][n] = (f32x4){0.f, 0.f, 0.f, 0.f};
        cur = nxt; cA = nA; cB = nB; ++ui;
        if constexpr (ALIGN_EPI) { if (wr == 1) PG8_BAR; }
    }
    PG8_WAIT_V(0);
    if constexpr (!ALIGN_EPI) { if (wr == 0) PG8_BAR; }
    PG8_BAR;
    if constexpr (Epi::AFTER_DRAIN) { E.fused(acc, cur, wr, wc, fr, fq, lds, wid, lane); S.done(cur); }
#undef PG8_SA
#undef PG8_SB
#undef PG8_STAGE
#undef PG8_LDA
#undef PG8_LDB
#undef PG8_MMA
#undef PG8_WAIT_V
#undef PG8_WAIT_L
#undef PG8_BAR
#undef PG8_SCHED
}
}

using f4 = pg8::f32x4;
typedef unsigned short bf16_t;
constexpr int NT = 512;
constexpr int M = 8192, D = 2048, DR = 1024, NPAD = 6656, DFF = 8192, KL = 384, NL = 5120;
constexpr int DEPTH = 2;
constexpr float ALPHA = 1.4142135623730951f;
constexpr float LN_EPS = 1e-5f, GN_EPS = 64e-5f;
constexpr int LDS_BYTES = 147456;

constexpr size_t al256(size_t x) { return (x + 255) & ~(size_t)255; }
constexpr size_t FILT_CTX_PER = (size_t)2 * 1024 * 528, FILT_LAT_PER = (size_t)2 * 1024 * 2064;
constexpr size_t WS_MOD = 16384;
constexpr size_t WS_FH2 = al256(WS_MOD + (size_t)2 * 5 * 12288 * 4);
constexpr size_t WS_FILT = al256(WS_FH2 + (size_t)2 * 1280 * 64 * 4);
constexpr size_t WS_WIN = WS_FILT;
constexpr size_t WS_WOUT = WS_WIN + (size_t)NPAD * D * 2;
constexpr size_t WS_W1 = WS_WOUT + (size_t)D * D * 2;
constexpr size_t WS_W2 = WS_W1 + (size_t)DFF * D * 2;
constexpr size_t WS_WL = WS_W2 + (size_t)D * DFF * 2;
constexpr size_t WS_H = WS_WL + (size_t)NL * KL * 2;
constexpr size_t WS_MIX = WS_H + (size_t)M * D * 2;
constexpr size_t WS_LACT = WS_MIX + (size_t)M * D * 2;
constexpr size_t WS_PROJ = WS_LACT + (size_t)M * KL * 2;
constexpr size_t WS_RW = WS_PROJ + (size_t)M * 6144 * 2;
constexpr size_t WS_HT = WS_RW + (size_t)9 * M * 1024 * 4;
constexpr size_t WS_FILTB = WS_HT + (size_t)3 * 1024 * M * 2;
constexpr size_t FILTB_CTX = (size_t)2 * 1024 * 520, FILTB_LAT = (size_t)2 * 1024 * 2056, FILTB_PER = FILTB_CTX + FILTB_LAT;
constexpr size_t WS_END = WS_FILTB + 2 * FILTB_PER * 2;
static_assert(WS_END <= (size_t)805306368, "workspace map too large");
constexpr size_t AS = (size_t)M * 1024;
constexpr size_t OUT_STATE = (size_t)16777216;

__device__ __forceinline__ int tid_l() { int t = threadIdx.x; asm volatile("" : "+v"(t)); return t; }
struct Params { const float* in[33]; float* out; unsigned char* ws; int ph_lo, ph_hi; };
typedef const __attribute__((address_space(4))) Params CParams;

__device__ __forceinline__ float wave_sum(float v) {
#pragma unroll
    for (int o = 1; o < 64; o <<= 1) v += __shfl_xor(v, o);
    return v;
}
typedef __bf16 bf16x2_t __attribute__((ext_vector_type(2)));
typedef float f32x2_t __attribute__((ext_vector_type(2)));
__device__ __forceinline__ unsigned pk2(float lo, float hi) { const f32x2_t v = {lo, hi}; const bf16x2_t b = __builtin_convertvector(v, bf16x2_t); return __builtin_bit_cast(unsigned, b); }
__device__ __forceinline__ bf16_t f2bf(float f) { unsigned u = __float_as_uint(f); u += 0x7FFFu + ((u >> 16) & 1u); return (bf16_t)(u >> 16); }
__device__ __forceinline__ float bf2f(unsigned short b) { return __uint_as_float(((unsigned)b) << 16); }
__device__ __forceinline__ float sigmf(float x) { return __builtin_amdgcn_rcpf(1.f + __expf(-x)); }

__device__ __forceinline__ void ph_mod(CParams& P, float* lds) {
    const int tid = tid_l();
    float* scond = lds;
    float* red = lds + 5 * 2048;
    const float* c = P.in[2]; const float* cctx = P.in[4];
    for (int i = tid; i < 5 * 2048; i += NT) { const int b = i >> 11, k = i & 2047; const float x = b == 0 ? cctx[k] : c[(b - 1) * 2048 + k]; scond[i] = x / (1.f + __expf(-x)); }
    __syncthreads();
    const float* w_ada = P.in[5]; const float* b_ada = P.in[6];
    float* mod = (float*)(P.ws + WS_MOD);
    const int kg = tid >> 5, c4 = tid & 31;
    for (int item = blockIdx.x; item < 192; item += gridDim.x) {
        const int l = item / 96, c0 = (item % 96) * 128;
        f4 acc[5];
#pragma unroll
        for (int b = 0; b < 5; ++b) acc[b] = (f4){0.f, 0.f, 0.f, 0.f};
        const float* wp = w_ada + ((size_t)l * 2048 + kg * 128) * 12288 + c0 + c4 * 4;
        const float* sc = scond + kg * 128;
#pragma unroll 8
        for (int k = 0; k < 128; ++k) {
            const f4 w = *(const f4*)(wp + (size_t)k * 12288);
#pragma unroll
            for (int b = 0; b < 5; ++b) acc[b] += w * sc[b * 2048 + k];
        }
#pragma unroll
        for (int b = 0; b < 5; ++b) *(f4*)(red + (kg * 5 + b) * 128 + c4 * 4) = acc[b];
        __syncthreads();
        for (int idx = tid; idx < 640; idx += NT) {
            const int b = idx >> 7, cc = idx & 127; float s = 0.f;
#pragma unroll
            for (int g = 0; g < 16; ++g) s += red[(g * 5 + b) * 128 + cc];
            mod[(size_t)(l * 5 + b) * 12288 + c0 + cc] = s + b_ada[(size_t)l * 12288 + c0 + cc];
        }
        __syncthreads();
    }
}

__device__ __forceinline__ void ph_filt_hidden(CParams& P) {
    const int lane = tid_l() & 63, wave = tid_l() >> 6;
    const int gw = blockIdx.x * 8 + wave, ngw = gridDim.x * 8;
    float* fh2 = (float*)(P.ws + WS_FH2);
    for (int it = gw; it < 2 * 1280; it += ngw) {
        const int l = it / 1280, q = it % 1280;
        const int seq = q < 256 ? 256 : 1024, p = q < 256 ? q : q - 256;
        const float t = (float)p / (float)(seq - 1);
        const float wang = (float)(6.283185307179586 / (double)seq) * (float)p;
        float z = 0.f;
        if (lane == 0) z = t;
        else if (lane <= 32) {
            const int fi = (lane - 1) & 15; const float st = (float)fi / 15.f; const float f = 1e-4f * (1.f - st) + 15.f * st;
            z = lane <= 16 ? cosf(f * wang) : -sinf(f * wang);
        }
        const float* w1 = P.in[19] + (size_t)l * 33 * 64; const float* b1 = P.in[20] + l * 64;
        const float* w2 = P.in[21] + (size_t)l * 64 * 64; const float* b2 = P.in[22] + l * 64;
        const float* fr = P.in[24] + l * 128;
        float a = b1[lane];
        for (int i = 0; i < 33; ++i) a += __shfl(z, i) * w1[i * 64 + lane];
        const float h1 = sinf(fr[lane] * a);
        float a2 = b2[lane];
        for (int i = 0; i < 64; ++i) a2 += __shfl(h1, i) * w2[i * 64 + lane];
        const float h2 = sinf(fr[64 + lane] * a2);
        fh2[((size_t)l * 1280 + q) * 64 + lane] = h2;
    }
}

__device__ __forceinline__ void transpose_item(const float* W, int K, int N, bf16_t* WT, float* scr, int item, int lane) {
    const int nblk = N / 32, kb = item / nblk, nb = item % nblk, k0 = 64 * kb, n0 = 32 * nb;
    float tv[32];
#pragma unroll
    for (int i = 0; i < 32; ++i) { const int kk = 2 * i + (lane >> 5); tv[i] = W[(size_t)(k0 + kk) * N + n0 + (lane & 31)]; }
#pragma unroll
    for (int i = 0; i < 32; ++i) { const int kk = 2 * i + (lane >> 5); scr[kk * 33 + (lane & 31)] = tv[i]; }
    asm volatile("s_waitcnt lgkmcnt(0)" ::: "memory");
    const int c = lane & 7;
#pragma unroll
    for (int j = 0; j < 4; ++j) { const int n = (lane >> 3) + 8 * j; const float* s = scr + (8 * c) * 33 + n;
        uint4 o; o.x = pk2(s[0 * 33], s[1 * 33]); o.y = pk2(s[2 * 33], s[3 * 33]); o.z = pk2(s[4 * 33], s[5 * 33]); o.w = pk2(s[6 * 33], s[7 * 33]);
        *(uint4*)(WT + (size_t)(n0 + n) * K + k0 + 8 * c) = o; }
    asm volatile("s_waitcnt lgkmcnt(0)" ::: "memory");
}
__device__ __forceinline__ void ph_convert(CParams& P, int l, float* lds) {
    const int lane = tid_l() & 63, wave = tid_l() >> 6;
    const int gw = blockIdx.x * 8 + wave, ngw = gridDim.x * 8;
    float* scr = lds + wave * (64 * 33);
    constexpr int I_IN = 32 * 201, I_OUT = 32 * 64, I_1 = 32 * 256, I_2 = 128 * 64;
    const float* w_in = P.in[7] + (size_t)l * 2048 * 6432; const float* w_out = P.in[26] + (size_t)l * 2048 * 2048;
    const float* w1 = P.in[31] + (size_t)l * 2048 * 8192; const float* w2 = P.in[32] + (size_t)l * 8192 * 2048;
    bf16_t* WIN = (bf16_t*)(P.ws + WS_WIN); bf16_t* WOUT = (bf16_t*)(P.ws + WS_WOUT); bf16_t* W1 = (bf16_t*)(P.ws + WS_W1); bf16_t* W2 = (bf16_t*)(P.ws + WS_W2);
    for (int it = gw; it < I_IN + I_OUT + I_1 + I_2; it += ngw) {
        int r = it;
        if (r < I_IN) { transpose_item(w_in, 2048, 6432, WIN, scr, r, lane); continue; } r -= I_IN;
        if (r < I_OUT) { transpose_item(w_out, 2048, 2048, WOUT, scr, r, lane); continue; } r -= I_OUT;
        if (r < I_1) { transpose_item(w1, 2048, 8192, W1, scr, r, lane); continue; } r -= I_1;
        transpose_item(w2, 8192, 2048, W2, scr, r, lane);
    }
    { uint4* z = (uint4*)(WIN + (size_t)6432 * 2048); const int n16 = 224 * 2048 * 2 / 16;
      unsigned zz = 0u; asm volatile("" : "+v"(zz));
      for (int i = blockIdx.x * NT + tid_l(); i < n16; i += gridDim.x * NT) z[i] = make_uint4(zz, zz, zz, zz); }
    { bf16_t* WL = (bf16_t*)(P.ws + WS_WL);
      const float* wup = P.in[9] + (size_t)l * 2 * 64 * 1024; const float* aup = P.in[11] + (size_t)l * 2 * 64 * 1024; const float* gup = P.in[13] + (size_t)l * 160 * 1024;
      for (int i = blockIdx.x * NT + tid_l(); i < NL * KL; i += gridDim.x * NT) {
          const int n = i / KL, k = i % KL; const int which = n >> 10, c = n & 1023; float v = 0.f;
          if (which < 2) { if (k < 64) v = wup[((size_t)which * 64 + k) * 1024 + c]; }
          else if (which < 4) { if (k >= 64 && k < 128) v = aup[((size_t)(which - 2) * 64 + (k - 64)) * 1024 + c]; }
          else { if (k >= 128 && k < 288) v = gup[(size_t)(k - 128) * 1024 + c]; }
          WL[i] = f2bf(v);
      } }
}

__device__ __forceinline__ void row_pass4(const float* src, float* dstX, const float* ag, const float* ab, const float* msh, const float* msc, bf16_t* hrow, int lane) {
    f4 v[4][8]; float s[4];
#pragma unroll
    for (int r = 0; r < 4; ++r) {
        s[r] = 0.f;
#pragma unroll
        for (int j = 0; j < 8; ++j) v[r][j] = *(const f4*)(src + (size_t)r * 2048 + j * 256 + lane * 4);
    }
#pragma unroll
    for (int r = 0; r < 4; ++r)
#pragma unroll
        for (int j = 0; j < 8; ++j) s[r] += (v[r][j][0] + v[r][j][1]) + (v[r][j][2] + v[r][j][3]);
    if (ag) {
        float s2[4], rstd[4];
#pragma unroll
        for (int r = 0; r < 4; ++r) { const float mean = wave_sum(s[r]) * (1.f / 2048.f); s2[r] = 0.f;
#pragma unroll
            for (int j = 0; j < 8; ++j) { v[r][j] = v[r][j] - mean; s2[r] += (v[r][j][0] * v[r][j][0] + v[r][j][1] * v[r][j][1]) + (v[r][j][2] * v[r][j][2] + v[r][j][3] * v[r][j][3]); } }
#pragma unroll
        for (int r = 0; r < 4; ++r) { rstd[r] = rsqrtf(wave_sum(s2[r]) * (1.f / 2048.f) + LN_EPS); s[r] = 0.f; }
#pragma unroll
        for (int j = 0; j < 8; ++j) { const f4 g = *(const f4*)(ag + j * 256 + lane * 4), b = *(const f4*)(ab + j * 256 + lane * 4);
#pragma unroll
            for (int r = 0; r < 4; ++r) { v[r][j] = v[r][j] * rstd[r] * g + b; s[r] += (v[r][j][0] + v[r][j][1]) + (v[r][j][2] + v[r][j][3]); } }
    }
#pragma unroll
    for (int r = 0; r < 4; ++r)
#pragma unroll
        for (int j = 0; j < 8; ++j) *(f4*)(dstX + (size_t)r * 2048 + j * 256 + lane * 4) = v[r][j];
    if (msh) {
        float s2[4], rstd[4];
#pragma unroll
        for (int r = 0; r < 4; ++r) { const float mean = wave_sum(s[r]) * (1.f / 2048.f); s2[r] = 0.f;
#pragma unroll
            for (int j = 0; j < 8; ++j) { v[r][j] = v[r][j] - mean; s2[r] += (v[r][j][0] * v[r][j][0] + v[r][j][1] * v[r][j][1]) + (v[r][j][2] * v[r][j][2] + v[r][j][3] * v[r][j][3]); } }
#pragma unroll
        for (int r = 0; r < 4; ++r) rstd[r] = rsqrtf(wave_sum(s2[r]) * (1.f / 2048.f) + LN_EPS);
#pragma unroll
        for (int j = 0; j < 8; ++j) { const f4 sh = *(const f4*)(msh + j * 256 + lane * 4), sc = *(const f4*)(msc + j * 256 + lane * 4) + 1.f;
#pragma unroll
            for (int r = 0; r < 4; ++r) { const f4 h = v[r][j] * rstd[r] * sc + sh;
                uint2 w; w.x = pk2(h[0], h[1]); w.y = pk2(h[2], h[3]);
                *(uint2*)(hrow + (size_t)r * 2048 + j * 256 + lane * 4) = w; } }
    }
}
__device__ __forceinline__ void ph_rowpass(CParams& P, int mode, int l) {
    const int lane = tid_l() & 63, wave = tid_l() >> 6;
    const int gw = blockIdx.x * 8 + wave, ngw = gridDim.x * 8;
    const float* mod = (const float*)(P.ws + WS_MOD);
    bf16_t* H = (bf16_t*)(P.ws + WS_H);
    for (int m = gw * 4; m < M; m += ngw * 4) {
        const int bidx = m < 4096 ? 0 : 1 + ((m - 4096) >> 10);
        const float* src; const float* ag = nullptr; const float* ab = nullptr; const float* msh = nullptr; const float* msc = nullptr;
        float* dst = P.out + (size_t)m * 2048;
        if (mode == 0) { src = m < 4096 ? P.in[0] + (size_t)m * 2048 : P.in[1] + (size_t)(m - 4096) * 2048;
            msh = mod + (size_t)(0 * 5 + bidx) * 12288; msc = msh + 2048; }
        else if (mode == 1) { src = dst; ag = P.in[27] + l * 2048; ab = P.in[28] + l * 2048;
            msh = mod + (size_t)(l * 5 + bidx) * 12288 + 3 * 2048; msc = msh + 2048; }
        else { src = dst; ag = P.in[29] + l * 2048; ab = P.in[30] + l * 2048;
            if (l + 1 < DEPTH) { msh = mod + (size_t)((l + 1) * 5 + bidx) * 12288; msc = msh + 2048; } }
        row_pass4(src, dst, ag, ab, msh, msc, H + (size_t)m * 2048, lane);
    }
}

__device__ __forceinline__ void ph_filt_final(CParams& P, float* lds) {
    const int tid = tid_l(); const int cl = tid & 15, ps = tid >> 4;
    for (int it = blockIdx.x; it < 512; it += gridDim.x) {
        const int ss = it < 256 ? 1 : 0; const int item = it & 255;
        const int cgp = item & 63, o = (item >> 6) & 1, l = item >> 7;
        const int L = ss ? 1024 : 256, GRL = 2 * L + 8, RS = 2 * L + 1;
        float* buf = lds; float* red = lds + 16 * 2049; float* invs = red + 512;
        const int c = cgp * 16 + cl;
        const float* h2 = (const float*)(P.ws + WS_FH2) + ((size_t)l * 1280 + (ss ? 256 : 0)) * 64;
        const float* w3 = P.in[23] + (size_t)l * 64 * 4096;
        float wf[64], wb[64];
#pragma unroll
        for (int j = 0; j < 64; ++j) { wf[j] = w3[(size_t)j * 4096 + (o * 2 + 0) * 1024 + c]; wb[j] = w3[(size_t)j * 4096 + (o * 2 + 1) * 1024 + c]; }
        const float st = (float)c / 1023.f;
        const float delta = fabsf(-3.0701134573253943f * (1.f - st) + -15.350567286626972f * st);
        float asum = 0.f;
        for (int p = ps; p < L; p += 32) {
            const float* hp = h2 + (size_t)p * 64;
            float af = 0.f, ab = 0.f;
#pragma unroll
            for (int j4 = 0; j4 < 16; ++j4) { const f4 hv = *(const f4*)(hp + j4 * 4);
#pragma unroll
                for (int e = 0; e < 4; ++e) { af += hv[e] * wf[j4 * 4 + e]; ab += hv[e] * wb[j4 * 4 + e]; } }
            const float t = (float)p / (float)(L - 1);
            const float dec = expf(-t * delta);
            af *= dec; ab *= dec;
            asum += fabsf(af) + fabsf(ab);
            buf[cl * RS + (L - 1 - p)] = af;
            if (p > 0) buf[cl * RS + (L - 1 + p)] = ab;
        }
        red[ps * 16 + cl] = asum;
        __syncthreads();
        if (tid < 16) { float tot = 0.f;
#pragma unroll
            for (int g = 0; g < 32; ++g) tot += red[g * 16 + tid];
            invs[tid] = 1.f / tot; }
        __syncthreads();
        bf16_t* gr = (bf16_t*)(P.ws + WS_FILTB) + (size_t)l * FILTB_PER + (ss ? FILTB_CTX : 0) + ((size_t)o * 1024 + cgp * 16) * GRL;
        const int half = GRL / 2;
        for (int idx = tid; idx < 16 * half; idx += NT) {
            const int cc = idx / half, x = (idx % half) * 2;
            const float iv = invs[cc];
            const float v0 = x < 2 * L - 1 ? buf[cc * RS + x] * iv : 0.f, v1 = x + 1 < 2 * L - 1 ? buf[cc * RS + x + 1] * iv : 0.f;
            *(unsigned*)(gr + (size_t)cc * GRL + x) = pk2(v0, v1);
        }
        __syncthreads();
    }
}

__device__ __forceinline__ float2 bfx2(unsigned u) { return make_float2(__uint_as_float(u << 16), __uint_as_float(u & 0xffff0000u)); }
template <bool LAT>
__device__ __forceinline__ void convprep_item(CParams& P, int l, bf16_t* tile, int ct2, int m0, int lane, int wave) {
    const bf16_t* proj = (const bf16_t*)(P.ws + WS_PROJ);
    float* RW = (float*)(P.ws + WS_RW);
    const float* cw = P.in[8] + (size_t)l * 9 * 6144;
    const int c = ct2 * 128 + 2 * lane;
    float2 wgt[9];
#pragma unroll
    for (int q = 0; q < 9; ++q) wgt[q] = *(const float2*)(cw + q * 6144 + c);
    const unsigned* pc = (const unsigned*)(proj + (size_t)m0 * 6144 + c);
    const int row0 = LAT ? (((m0 - 4096) & 1023) >> 6) : 0;
#pragma unroll 1
    for (int hv = 0; hv < 2; ++hv) {
        constexpr int NO = 16;
        float2 y[NO];
#define CP_TOK(i) (LAT ? ((2 * hv + ((i) >> 3)) * 64 + wave * 8 + ((i) & 7)) : (wave * 32 + hv * 16 + (i)))
        if (LAT) {
            unsigned u[4][10];
#pragma unroll
            for (int ry = 0; ry < 4; ++ry) {
                const int rl = 2 * hv + ry - 1;
                const int rr = row0 + rl; const bool rok = rr >= 0 && rr <= 15;
#pragma unroll
                for (int xx = 0; xx < 10; ++xx) { const int cc = wave * 8 + xx - 1; const bool ok = rok && cc >= 0 && cc <= 63;
                    u[ry][xx] = ok ? pc[(ptrdiff_t)(rl * 64 + cc) * 3072] : 0u; }
            }
#pragma unroll
            for (int ry = 0; ry < 2; ++ry)
#pragma unroll
                for (int i = 0; i < 8; ++i) {
                    float2 a = make_float2(0.f, 0.f);
#pragma unroll
                    for (int dy = 0; dy < 3; ++dy)
#pragma unroll
                        for (int dx = 0; dx < 3; ++dx) { const float2 uv = bfx2(u[ry + dy][i + dx]); a.x += uv.x * wgt[dy * 3 + dx].x; a.y += uv.y * wgt[dy * 3 + dx].y; }
                    y[ry * 8 + i] = a;
                }
        } else {
            unsigned u[18];
#pragma unroll
            for (int xx = 0; xx < 18; ++xx) { const int pp = wave * 32 + hv * 16 + xx - 1; const bool ok = pp >= 0 && pp <= 255; u[xx] = ok ? pc[(ptrdiff_t)pp * 3072] : 0u; }
#pragma unroll
            for (int i = 0; i < 16; ++i) {
                float2 a = make_float2(0.f, 0.f);
#pragma unroll
                for (int dx = 0; dx < 3; ++dx) { const float2 uv = bfx2(u[i + dx]); a.x += uv.x * wgt[3 + dx].x; a.y += uv.y * wgt[3 + dx].y; }
                y[i] = a;
            }
        }
        if (ct2 < 24) {
            const int arr = ct2 >> 3; const int cc = (ct2 & 7) * 128 + 2 * lane;
            float* dst = RW + (size_t)arr * AS + (size_t)m0 * 1024 + cc;
#pragma unroll
            for (int i = 0; i < NO; ++i) *(float2*)(dst + (size_t)CP_TOK(i) * 1024) = y[i];
            if (arr == 1) {
                const float2 kkw = *(const float2*)(P.in[14] + l * 1024 + cc);
                float* dk = RW + (size_t)3 * AS + (size_t)m0 * 1024 + cc;
#pragma unroll
                for (int i = 0; i < NO; ++i) { const float k0 = y[i].x * kkw.x, k1 = y[i].y * kkw.y; float ssq = k0 * k0 + k1 * k1;
#pragma unroll
                    for (int sh = 1; sh < 32; sh <<= 1) ssq += __shfl_xor(ssq, sh);
                    const float rs = rsqrtf(ssq + 1e-12f);
                    *(float2*)(dk + (size_t)CP_TOK(i) * 1024) = make_float2(k0 * rs, k1 * rs); }
            }
        } else {
#pragma unroll
            for (int i = 0; i < NO; ++i) { tile[(2 * lane) * 264 + CP_TOK(i)] = f2bf(y[i].x); tile[(2 * lane + 1) * 264 + CP_TOK(i)] = f2bf(y[i].y); }
        }
#undef CP_TOK
    }
}
__device__ __forceinline__ void ph_convprep(CParams& P, int l, float* lds) {
    const int tid = tid_l(), lane = tid & 63, wave = tid >> 6;
    bf16_t* tile = (bf16_t*)lds;
    bf16_t* HT = (bf16_t*)(P.ws + WS_HT);
    for (int item = blockIdx.x; item < 32 * 48; item += gridDim.x) {
        const int ct2 = item % 48, tt = item / 48;
        const int m0 = tt * 256;
        if (m0 >= 4096) convprep_item<true>(P, l, tile, ct2, m0, lane, wave);
        else convprep_item<false>(P, l, tile, ct2, m0, lane, wave);
        if (ct2 >= 24) {
            __syncthreads();
            const int which = (ct2 - 24) >> 3; const int cbase = ((ct2 - 24) & 7) * 128;
#pragma unroll
            for (int i = 0; i < 16; ++i) { const int ch = wave * 16 + i;
                *(uint2*)(HT + ((size_t)which * 1024 + cbase + ch) * M + m0 + lane * 4) = *(const uint2*)(tile + ch * 264 + lane * 4); }
            __syncthreads();
        }
    }
}

typedef float f32x16 __attribute__((ext_vector_type(16)));
typedef short s16x8 __attribute__((ext_vector_type(8)));
typedef short s16x4 __attribute__((ext_vector_type(4)));
typedef unsigned u32x4_t __attribute__((ext_vector_type(4)));
#define MFMA16(a, b, c) __builtin_amdgcn_mfma_f32_16x16x32_bf16((a), (b), (c), 0, 0, 0)
__device__ __forceinline__ s16x8 mk8(unsigned a, unsigned b, unsigned c, unsigned d) { u32x4_t v = {a, b, c, d}; return __builtin_bit_cast(s16x8, v); }
__device__ __forceinline__ s16x8 pack_lo(f4 x) { return mk8(pk2(x[0], x[1]), pk2(x[2], x[3]), 0u, 0u); }
__device__ __forceinline__ s16x8 pack_2(f4 lo, f4 hi) { return mk8(pk2(lo[0], lo[1]), pk2(lo[2], lo[3]), pk2(hi[0], hi[1]), pk2(hi[2], hi[3])); }
constexpr int SC_KQ = 0, SC_RQ = 2304, SC_KD = 4608, SC_BD = 6912, SC_KDCT = 9216, SC_NBDCT = 11264, SC_VT = 13312, SC_GC = 15360, SC_BUF = 15616;

__device__ __forceinline__ void chain_chunk(const unsigned char* buf, f4 (&H)[4][4], float* gO, int mrow0, int mstep, int lane) {
    const int r = lane & 15, g = lane >> 4;
    const f4 z = (f4){0.f, 0.f, 0.f, 0.f};
    const unsigned char* rb = buf + r * 144 + g * 16;
    const s16x8 fKq0 = *(const s16x8*)(rb + SC_KQ), fKq1 = *(const s16x8*)(rb + SC_KQ + 64);
    const s16x8 fRq0 = *(const s16x8*)(rb + SC_RQ), fRq1 = *(const s16x8*)(rb + SC_RQ + 64);
    const s16x8 fKd0 = *(const s16x8*)(rb + SC_KD), fKd1 = *(const s16x8*)(rb + SC_KD + 64);
    const s16x8 fBd0 = *(const s16x8*)(rb + SC_BD), fBd1 = *(const s16x8*)(rb + SC_BD + 64);
    f4 Xd = MFMA16(fKq1, fBd1, MFMA16(fKq0, fBd0, z));
    f4 XTd = MFMA16(fBd1, fKq1, MFMA16(fBd0, fKq0, z));
    f4 MkkT = MFMA16(fKd1, fKq1, MFMA16(fKd0, fKq0, z));
    f4 MrkT = MFMA16(fKd1, fRq1, MFMA16(fKd0, fRq0, z));
    f4 MrbT = MFMA16(fBd1, fRq1, MFMA16(fBd0, fRq0, z));
    f4 eye;
#pragma unroll
    for (int q = 0; q < 4; ++q) { const int ri = 4 * g + q;
        Xd[q] = ri > r ? -Xd[q] : 0.f; XTd[q] = ri < r ? -XTd[q] : 0.f; MkkT[q] = ri < r ? MkkT[q] : 0.f;
        MrkT[q] = ri <= r ? MrkT[q] : 0.f; MrbT[q] = ri <= r ? -MrbT[q] : 0.f; eye[q] = ri == r ? 1.f : 0.f; }
    const s16x8 pX = pack_lo(Xd), pXT = pack_lo(XTd);
    const f4 X2d = MFMA16(pXT, pX, z), X2Td = MFMA16(pX, pXT, z);
    const s16x8 pX2 = pack_lo(X2d), pX2T = pack_lo(X2Td);
    const f4 X4d = MFMA16(pX2T, pX2, z), X4Td = MFMA16(pX2, pX2T, z);
    const f4 X8d = MFMA16(pack_lo(X4Td), pack_lo(X4d), z);
    const f4 U1T = MFMA16(pack_lo(X2d + eye), pack_lo(XTd + eye), z);
    const f4 U2T = MFMA16(pack_lo(X4d + eye), pack_lo(U1T), z);
    const f4 TT = MFMA16(pack_lo(X8d + eye), pack_lo(U2T), z);
    const s16x8 fTT = pack_lo(TT), fMkkT = pack_lo(MkkT), fOrb = pack_2(MrkT, MrbT);
    const unsigned char* pb = buf + r * 144 + g * 8;
    const uint2 k0l = *(const uint2*)(pb + SC_KQ), k0h = *(const uint2*)(pb + SC_KQ + 32), k1l = *(const uint2*)(pb + SC_KQ + 64), k1h = *(const uint2*)(pb + SC_KQ + 96);
    const uint2 r0l = *(const uint2*)(pb + SC_RQ), r0h = *(const uint2*)(pb + SC_RQ + 32), r1l = *(const uint2*)(pb + SC_RQ + 64), r1h = *(const uint2*)(pb + SC_RQ + 96);
    const s16x8 aK0 = mk8(k0l.x, k0l.y, k0h.x, k0h.y), aK1 = mk8(k1l.x, k1l.y, k1h.x, k1h.y);
    const s16x8 aR0 = mk8(r0l.x, r0l.y, r0h.x, r0h.y), aR1 = mk8(r1l.x, r1l.y, r1h.x, r1h.y);
#pragma unroll
    for (int vt = 0; vt < 4; ++vt) {
        const s16x8 h0 = pack_2(H[0][vt], H[1][vt]), h1 = pack_2(H[2][vt], H[3][vt]);
        f4 P0 = MFMA16(aK1, h1, MFMA16(aK0, h0, z));
        f4 O = MFMA16(aR1, h1, MFMA16(aR0, h0, z));
        const uint2 vv = *(const uint2*)(buf + SC_VT + (16 * vt + r) * 32 + g * 8);
        P0 = MFMA16(fMkkT, mk8(vv.x, vv.y, 0u, 0u), P0);
        const f4 Pm = MFMA16(fTT, pack_lo(P0), z);
        const s16x8 fB = mk8(vv.x, vv.y, pk2(Pm[0], Pm[1]), pk2(Pm[2], Pm[3]));
        O = MFMA16(fOrb, fB, O);
#pragma unroll
        for (int q = 0; q < 4; ++q) gO[(ptrdiff_t)(mrow0 + mstep * (4 * g + q)) * 1024 + 16 * vt + r] = O[q];
#pragma unroll
        for (int kt = 0; kt < 4; ++kt) {
            const unsigned char* pk = buf + SC_KDCT + (16 * kt + r) * 32 + g * 8;
            const uint2 al = *(const uint2*)pk, ah = *(const uint2*)(pk + 2048);
            const f4 gc = *(const f4*)(buf + SC_GC + (16 * kt + 4 * g) * 4);
            H[kt][vt] = MFMA16(mk8(al.x, al.y, ah.x, ah.y), fB, H[kt][vt] * gc);
        }
    }
}
typedef float f32x8 __attribute__((ext_vector_type(8)));
struct RawH { f32x16 w; f32x8 r, k, v, kk, a; };
__device__ __forceinline__ void prep_load(RawH& R, const float* RW, int d, int hf, int mrow0, int mstep, unsigned colx) {
    const float* wb = RW + (size_t)(4 + d) * AS;
#pragma unroll
    for (int t = 0; t < 16; ++t) { const float* rp = wb + (size_t)(unsigned)(mrow0 + mstep * t) * 1024; R.w[t] = rp[colx]; }
    const float* ab = RW + (size_t)(6 + d) * AS;
#pragma unroll
    for (int j = 0; j < 8; ++j) { const size_t ro = (size_t)(unsigned)(mrow0 + mstep * (8 * hf + j)) * 1024;
        const float* p0 = RW + ro; const float* p1 = RW + AS + ro; const float* p2 = RW + 2 * AS + ro; const float* p3 = RW + 3 * AS + ro; const float* p4 = ab + ro;
        R.r[j] = p0[colx]; R.k[j] = p1[colx]; R.v[j] = p2[colx]; R.kk[j] = p3[colx]; R.a[j] = p4[colx]; }
}
__device__ __forceinline__ void prep_proc(const RawH& R, unsigned char* buf, int hf, float ka, int lane) {
    float G = 1.f;
    if (hf) {
#pragma unroll
        for (int t = 0; t < 8; ++t) G *= R.w[t]; }
    float GC = 1.f;
#pragma unroll
    for (int t = 0; t < 16; ++t) GC *= R.w[t];
    f32x8 kdi, bdi;
#pragma unroll
    for (int j = 0; j < 8; ++j) {
        const int t = 8 * hf + j;
        *(bf16_t*)(buf + SC_KQ + t * 144 + lane * 2) = (bf16_t)pk2(R.kk[j] * G, 0.f);
        G *= hf ? R.w[8 + j] : R.w[j];
        *(bf16_t*)(buf + SC_RQ + t * 144 + lane * 2) = (bf16_t)pk2(R.r[j] * G, 0.f);
        const float iG = __builtin_amdgcn_rcpf(G);
        const float kd = R.k[j] * (1.f + (R.a[j] - 1.f) * ka), bb = R.kk[j] * R.a[j];
        kdi[j] = kd * iG; bdi[j] = bb * iG;
        *(bf16_t*)(buf + SC_KD + t * 144 + lane * 2) = (bf16_t)pk2(kdi[j], 0.f);
        *(bf16_t*)(buf + SC_BD + t * 144 + lane * 2) = (bf16_t)pk2(bdi[j], 0.f);
    }
    uint4 o1, o2, o3;
    o1.x = pk2(kdi[0] * GC, kdi[1] * GC); o1.y = pk2(kdi[2] * GC, kdi[3] * GC); o1.z = pk2(kdi[4] * GC, kdi[5] * GC); o1.w = pk2(kdi[6] * GC, kdi[7] * GC);
    o2.x = pk2(-bdi[0] * GC, -bdi[1] * GC); o2.y = pk2(-bdi[2] * GC, -bdi[3] * GC); o2.z = pk2(-bdi[4] * GC, -bdi[5] * GC); o2.w = pk2(-bdi[6] * GC, -bdi[7] * GC);
    o3.x = pk2(R.v[0], R.v[1]); o3.y = pk2(R.v[2], R.v[3]); o3.z = pk2(R.v[4], R.v[5]); o3.w = pk2(R.v[6], R.v[7]);
    *(uint4*)(buf + SC_KDCT + lane * 32 + hf * 16) = o1;
    *(uint4*)(buf + SC_NBDCT + lane * 32 + hf * 16) = o2;
    *(uint4*)(buf + SC_VT + lane * 32 + hf * 16) = o3;
    if (hf) *(float*)(buf + SC_GC + lane * 4) = GC;
}
__device__ __forceinline__ void lds_barrier() { asm volatile("s_waitcnt lgkmcnt(0)" ::: "memory"); __builtin_amdgcn_s_barrier(); asm volatile("" ::: "memory"); }
__device__ __forceinline__ void scan_item(CParams& P, int l, float* ldsf, int type, int b, int h) {
    unsigned char* lds = (unsigned char*)ldsf;
    const int tid = tid_l(), lane = tid & 63, wave = __builtin_amdgcn_readfirstlane(tid >> 6);
    const int L = type ? 256 : 1024, NCH = L / 16; const int mbase = type ? b * 256 : 4096 + b * 1024;
    if (wave < 2) {
        const int d = wave; const int mstep = d ? -1 : 1; const int mfirst = mbase + (d ? L - 1 : 0);
        const unsigned char* cbuf = lds + d * 2 * SC_BUF;
        float* gO = (float*)(P.ws + WS_PROJ) + (size_t)d * AS + h * 64;
        const int r = lane & 15, g = lane >> 4;
        f4 H[4][4];
        if (type == 0) { const float* s0 = P.in[3] + ((((size_t)b * 2 + l) * 2 + d) * 16 + h) * 4096;
#pragma unroll
            for (int kt = 0; kt < 4; ++kt)
#pragma unroll
                for (int vt = 0; vt < 4; ++vt) H[kt][vt] = *(const f4*)(s0 + (16 * vt + r) * 64 + 16 * kt + 4 * g); }
        else {
#pragma unroll
            for (int kt = 0; kt < 4; ++kt)
#pragma unroll
                for (int vt = 0; vt < 4; ++vt) H[kt][vt] = (f4){0.f, 0.f, 0.f, 0.f}; }
        lds_barrier();
        for (int c = 0; c < NCH; ++c) {
            chain_chunk(cbuf + (c & 1) * SC_BUF, H, gO, mfirst + mstep * 16 * c, mstep, lane);
            lds_barrier();
        }
        if (type == 1) { float* so = P.out + OUT_STATE + ((((size_t)b * 2 + l) * 2 + d) * 16 + h) * 4096;
#pragma unroll
            for (int kt = 0; kt < 4; ++kt)
#pragma unroll
                for (int vt = 0; vt < 4; ++vt) *(f4*)(so + (16 * vt + r) * 64 + 16 * kt + 4 * g) = H[kt][vt]; }
    } else if (wave != 4 && wave != 5) {
        const int d = wave & 1, hf = wave >> 2; const int mstep = d ? -1 : 1; const int mfirst = mbase + (d ? L - 1 : 0);
        unsigned char* cbuf = lds + d * 2 * SC_BUF;
        const float* RW = (const float*)(P.ws + WS_RW);
        const unsigned colx = (unsigned)(h * 64 + lane);
        const float ka = P.in[15][l * 1024 + colx];
        RawH RA, RB;
        prep_load(RA, RW, d, hf, mfirst, mstep, colx);
        for (int c = 0; c < NCH; c += 2) {
            prep_load(RB, RW, d, hf, mfirst + mstep * 16 * (c + 1), mstep, colx);
            prep_proc(RA, cbuf, hf, ka, lane);
            lds_barrier();
            if (c + 2 < NCH) prep_load(RA, RW, d, hf, mfirst + mstep * 16 * (c + 2), mstep, colx);
            prep_proc(RB, cbuf + SC_BUF, hf, ka, lane);
            lds_barrier();
        }
        lds_barrier();
    } else {
        for (int c = 0; c <= NCH; ++c) lds_barrier();
    }
}

template <int L>
__device__ __forceinline__ void hym_conv(const bf16_t* cps, const bf16_t* ubs, f32x16& acc) {
    constexpr int ND = (L == 1024) ? 39 : 15;
#pragma unroll 3
    for (int dd = 0; dd < ND; ++dd) {
#pragma unroll
        for (int kh = 0; kh < 2; ++kh) {
            const bf16_t* ap = cps - 32 * dd + 16 * kh; const bf16_t* bp = ubs - 32 * dd + 16 * kh;
            const s16x4 alo = *(const s16x4*)ap, ahi = *(const s16x4*)(ap + 4);
            const s16x8 av = __builtin_shufflevector(alo, ahi, 0, 1, 2, 3, 4, 5, 6, 7);
            const s16x8 bv = *(const s16x8*)bp;
            acc = __builtin_amdgcn_mfma_f32_32x32x16_bf16(av, bv, acc, 0, 0, 0);
        }
    }
}
template <int L>
__device__ __forceinline__ void hyena_item(CParams& P, int l, float* ldsf, int cp2) {
    constexpr bool LAT = (L == 1024); constexpr int NB = LAT ? 4 : 16; constexpr int GRL = 2 * L + 8; constexpr int ROWL = L + 448;
    bf16_t* sCP = (bf16_t*)ldsf;
    bf16_t* sU = sCP + 16 * GRL;
    bf16_t* sZ = sU + 2 * NB * ROWL;
    const int tid = tid_l(), lane = tid & 63, wave = tid >> 6;
    const int c0 = cp2 * 2; const int mbase = LAT ? 4096 : 0;
    bf16_t* HT = (bf16_t*)(P.ws + WS_HT);
    const bf16_t* filtb = (const bf16_t*)(P.ws + WS_FILTB) + (size_t)l * FILTB_PER + (LAT ? FILTB_CTX : 0);
    unsigned zz = 0u; asm volatile("" : "+v"(zz));
    for (int idx = tid; idx < 2 * NB * 56; idx += NT) { const int row = idx / 56, q = idx % 56;
        const int off = row * ROWL + (q < 28 ? q * 8 : 224 + L + (q - 28) * 8);
        *(uint4*)(sU + off) = make_uint4(zz, zz, zz, zz); *(uint4*)(sZ + off) = make_uint4(zz, zz, zz, zz); }
    for (int idx = tid; idx < 2 * 512; idx += NT) { const int ch = idx >> 9, q = idx & 511;
        const uint4 v = *(const uint4*)(HT + (size_t)(c0 + ch) * M + mbase + 8 * q);
        const int b = (8 * q) / L, t = (8 * q) % L; *(uint4*)(sU + (ch * NB + b) * ROWL + 224 + t) = v; }
    for (int idx = tid; idx < 16 * GRL; idx += NT) { const int y = idx % GRL, k = idx / GRL; const int sft = k & 3, o = (k >> 2) & 1, ch = k >> 3;
        const bf16_t* src = filtb + ((size_t)o * 1024 + c0 + ch) * GRL;
        sCP[idx] = (y + sft < GRL) ? src[y + sft] : (bf16_t)0; }
    __syncthreads();
    const int ch = wave >> 2, nt = wave & 3; const int c = c0 + ch;
    const int r = lane & 31, h = lane >> 5; const int Il = r >> 2, bl = r & 3;
    const int I = LAT ? 8 * nt + Il : Il; const int b = LAT ? bl : 4 * nt + bl;
    const int dlo = LAT ? 8 * nt - 31 : -7;
    const int X0 = L - 1 - (32 * dlo + r - 8 * h); const int sft = X0 & 3;
    const int urow = (ch * NB + b) * ROWL + 224;
    const int uoff = urow + 32 * (I - dlo) + 8 * h;
    f32x16 acc;
#pragma unroll
    for (int i = 0; i < 16; ++i) acc[i] = 0.f;
    hym_conv<L>(sCP + ((ch * 2 + 0) * 4 + sft) * GRL + (X0 - sft), sU + uoff, acc);
    const float bias1 = P.in[25][(l * 2 + 0) * 1024 + c], bias2 = P.in[25][(l * 2 + 1) * 1024 + c];
    const size_t gcol = (size_t)c * M + mbase + b * L + 32 * I + 4 * h;
    float z[16];
#pragma unroll
    for (int g4 = 0; g4 < 4; ++g4) {
        const int t0 = 32 * I + 8 * g4 + 4 * h;
        const uint2 xv = *(const uint2*)(HT + (size_t)1 * 1024 * M + gcol + 8 * g4);
        const uint2 uv = *(const uint2*)(sU + urow + t0);
        const float x1[4] = {__uint_as_float(xv.x << 16), __uint_as_float(xv.x & 0xffff0000u), __uint_as_float(xv.y << 16), __uint_as_float(xv.y & 0xffff0000u)};
        const float uu[4] = {__uint_as_float(uv.x << 16), __uint_as_float(uv.x & 0xffff0000u), __uint_as_float(uv.y << 16), __uint_as_float(uv.y & 0xffff0000u)};
#pragma unroll
        for (int e = 0; e < 4; ++e) z[4 * g4 + e] = x1[e] * (acc[4 * g4 + e] + bias1 * uu[e]);
        uint2 w; w.x = pk2(z[4 * g4], z[4 * g4 + 1]); w.y = pk2(z[4 * g4 + 2], z[4 * g4 + 3]);
        *(uint2*)(sZ + urow + t0) = w;
    }
    __syncthreads();
#pragma unroll
    for (int i = 0; i < 16; ++i) acc[i] = 0.f;
    hym_conv<L>(sCP + ((ch * 2 + 1) * 4 + sft) * GRL + (X0 - sft), sZ + uoff, acc);
#pragma unroll
    for (int g4 = 0; g4 < 4; ++g4) {
        const uint2 xv = *(const uint2*)(HT + (size_t)2 * 1024 * M + gcol + 8 * g4);
        const float x2[4] = {__uint_as_float(xv.x << 16), __uint_as_float(xv.x & 0xffff0000u), __uint_as_float(xv.y << 16), __uint_as_float(xv.y & 0xffff0000u)};
        float o4[4];
#pragma unroll
        for (int e = 0; e < 4; ++e) o4[e] = x2[e] * (acc[4 * g4 + e] + bias2 * z[4 * g4 + e]);
        uint2 w; w.x = pk2(o4[0], o4[1]); w.y = pk2(o4[2], o4[3]);
        *(uint2*)(HT + gcol + 8 * g4) = w;
    }
    __syncthreads();
}

__device__ __forceinline__ void ph_scan_hyena(CParams& P, int l, float* lds) {
    const int G = gridDim.x; constexpr int total = 64 + 256 + 512 + 512;
    for (int r = 0; r * G < total; ++r) {
        const int pos = (r & 1) ? G - 1 - (int)blockIdx.x : (int)blockIdx.x; const int j = r * G + pos;
        if (j >= total) continue;
        if (j < 64) scan_item(P, l, lds, 0, j >> 4, j & 15);
        else if (j < 320) scan_item(P, l, lds, 1, (j - 64) >> 4, (j - 64) & 15);
        else if (j < 832) hyena_item<1024>(P, l, lds, j - 320);
        else hyena_item<256>(P, l, lds, j - 832);
    }
}

__device__ __forceinline__ void ph_combine(CParams& P, int l, float* lds) {
    const int lane = tid_l() & 63, wave = tid_l() >> 6;
    const int gw = blockIdx.x * 8 + wave, ngw = gridDim.x * 8;
    const float* RW = (const float*)(P.ws + WS_RW);
    const float* O = (const float*)(P.ws + WS_PROJ);
    bf16_t* mix = (bf16_t*)(P.ws + WS_MIX);
    for (int m = gw; m < M; m += ngw) {
        const size_t rowo = (size_t)m * 1024 + lane * 4;
#pragma unroll
        for (int qi = 0; qi < 4; ++qi) {
            const size_t idx = rowo + qi * 256; const int cc = qi * 256 + lane * 4;
            const f4 o0 = *(const f4*)(O + idx), o1 = *(const f4*)(O + AS + idx);
            const f4 r = *(const f4*)(RW + idx), k = *(const f4*)(RW + AS + idx), v = *(const f4*)(RW + 2 * AS + idx);
            const f4 a0 = *(const f4*)(RW + 6 * AS + idx), a1 = *(const f4*)(RW + 7 * AS + idx), g = *(const f4*)(RW + 8 * AS + idx);
            const f4 lg = *(const f4*)(P.in[17] + l * 1024 + cc), lb = *(const f4*)(P.in[18] + l * 1024 + cc);
            const f4 ka = *(const f4*)(P.in[15] + l * 1024 + cc), rk = *(const f4*)(P.in[16] + l * 1024 + cc);
            const f4 o = o0 + o1;
            const f4 kds = k * ((a0 + a1 - 2.f) * ka + 2.f);
            const f4 pb = r * kds * rk;
            float s1 = (o[0] + o[1]) + (o[2] + o[3]);
            float s2 = (o[0] * o[0] + o[1] * o[1]) + (o[2] * o[2] + o[3] * o[3]);
            float s3 = (pb[0] + pb[1]) + (pb[2] + pb[3]);
#pragma unroll
            for (int sh = 1; sh < 16; sh <<= 1) { s1 += __shfl_xor(s1, sh); s2 += __shfl_xor(s2, sh); s3 += __shfl_xor(s3, sh); }
            const float mu = s1 * (1.f / 64.f); const float var = fmaxf(s2 * (1.f / 64.f) - mu * mu, 0.f);
            const float rs = rsqrtf(var + GN_EPS);
            const f4 res = ((o - mu) * rs * lg + lb + v * s3) * g;
            uint2 w; w.x = pk2(res[0], res[1]); w.y = pk2(res[2], res[3]);
            *(uint2*)(mix + (size_t)m * 2048 + cc) = w;
        }
    }
    bf16_t* tile = (bf16_t*)lds;
    const bf16_t* HT = (const bf16_t*)(P.ws + WS_HT);
    for (int item = blockIdx.x; item < 16 * 128; item += gridDim.x) {
        const int c0 = (item & 15) * 64, m0 = (item >> 4) * 64;
#pragma unroll
        for (int i = 0; i < 8; ++i) { const int ci = wave * 8 + i; tile[ci * 66 + lane] = HT[(size_t)(c0 + ci) * M + m0 + lane]; }
        __syncthreads();
#pragma unroll
        for (int i = 0; i < 8; ++i) { const int mi = wave * 8 + i; mix[(size_t)(m0 + mi) * 2048 + 1024 + c0 + lane] = tile[lane * 66 + mi]; }
        __syncthreads();
    }
}

#define XB_TMO      128
#define XB_XCNT(j)  (256  + 64 * (j))
#define XB_XSUB(j)  (1280 + 64 * (j))
#define XB_XGEN(j)  (2304 + 64 * (j))
#define XB_TOP      3328
#define XB_TOPGEN   3392
#define XCD_BAR_WORDS 3456
#define XB_SPIN_CAP (1u << 18)
#define LAS __attribute__((address_space(3)))

__device__ __forceinline__ unsigned xb_ld(unsigned* p)              { return __hip_atomic_load(p, __ATOMIC_RELAXED, __HIP_MEMORY_SCOPE_AGENT); }
__device__ __forceinline__ unsigned xb_add(unsigned* p, unsigned v) { return __hip_atomic_fetch_add(p, v, __ATOMIC_RELAXED, __HIP_MEMORY_SCOPE_AGENT); }
__device__ __forceinline__ unsigned xb_xcc_id() { return (unsigned)__builtin_amdgcn_s_getreg((3 << 11) | 20) & 0xFu; }
#define XB_SPIN(cond, bar) do { unsigned _sp = 0; while (cond) { __builtin_amdgcn_s_sleep(1); \
    if ((++_sp & 255u) == 0u) { if (xb_ld(&(bar)[XB_TMO])) break; if (_sp > XB_SPIN_CAP) { atomicAdd(&(bar)[XB_TMO], 1u); break; } } } } while (0)

struct XcdBarrier {
    unsigned* bar; unsigned x;
    volatile LAS unsigned* st;
};

__device__ __forceinline__ XcdBarrier xcd_barrier_post(unsigned* bar, volatile LAS unsigned* st) {
    XcdBarrier b; b.bar = bar; b.x = xb_xcc_id(); b.st = st;
    if (threadIdx.x == 0) (void)xb_add(&bar[XB_XCNT(b.x)], 1u);
    return b;
}
__device__ __forceinline__ void xcd_barrier_complete(unsigned* bar, unsigned x, unsigned& nloc, unsigned& nx) {
    const unsigned G = gridDim.x * gridDim.y * gridDim.z;
    unsigned sum, cnt, mine, sp = 0u;
    for (;;) {
        sum = 0u; cnt = 0u; mine = 0u;
#pragma unroll
        for (unsigned j = 0; j < 16; ++j) { const unsigned c = xb_ld(&bar[XB_XCNT(j)]); sum += c; cnt += (c > 0u) ? 1u : 0u; mine = (j == x) ? c : mine; }
        if (sum == G) break;
        __builtin_amdgcn_s_sleep(1);
        if ((++sp & 255u) == 0u) { if (xb_ld(&bar[XB_TMO])) break; if (sp > XB_SPIN_CAP) { atomicAdd(&bar[XB_TMO], 1u); break; } }
    }
    nloc = mine > 0u ? mine : 1u; nx = cnt > 0u ? cnt : 1u;
}

__device__ __forceinline__ void xcd_barrier(const XcdBarrier& b) {
    asm volatile("s_waitcnt vmcnt(0)" ::: "memory");
    __syncthreads();
    if (threadIdx.x == 0) {
        unsigned* bar = b.bar;
        __builtin_amdgcn_s_waitcnt(0);
        unsigned nloc = b.st[0], nx = b.st[1];
        if (nloc == 0u) { xcd_barrier_complete(bar, b.x, nloc, nx); b.st[0] = nloc; b.st[1] = nx; }
        const unsigned old = xb_add(&bar[XB_XSUB(b.x)], 1u);
        const unsigned gen = old / nloc;
        if (old + 1u == (gen + 1u) * nloc) {
            __builtin_amdgcn_fence(__ATOMIC_RELEASE, "agent");
            asm volatile("s_waitcnt vmcnt(0)" ::: "memory");
            const unsigned og = xb_add(&bar[XB_TOP], 1u);
            const unsigned tg = og / nx;
            if (og + 1u == (tg + 1u) * nx) xb_add(&bar[XB_TOPGEN], 1u);
            else XB_SPIN(xb_ld(&bar[XB_TOPGEN]) == tg, bar);
            __builtin_amdgcn_fence(__ATOMIC_ACQUIRE, "agent");
            xb_add(&bar[XB_XGEN(b.x)], 1u);
            asm volatile("s_waitcnt vmcnt(0)" ::: "memory");
        } else {
            XB_SPIN(xb_ld(&bar[XB_XGEN(b.x)]) == gen, bar);
            __builtin_amdgcn_fence(__ATOMIC_ACQUIRE, "agent");
            asm volatile("s_waitcnt vmcnt(0)" ::: "memory");
        }
    }
    __syncthreads();
}


constexpr int NPH = 2 + 9 * DEPTH;
#ifndef PHM
#define PHM 1023
#endif
#ifndef DUPM
#define DUPM 0
#endif
#ifndef XSYNC
#define XSYNC 0
#endif
__device__ __forceinline__ XcdBarrier make_bar(unsigned char* lds_raw) {
    CParams* kp = (CParams*)__builtin_amdgcn_kernarg_segment_ptr(); asm volatile("" : "+s"(kp));
    XcdBarrier b; b.bar = (unsigned*)kp->ws; b.x = xb_xcc_id(); b.st = (volatile LAS unsigned*)(lds_raw + (LDS_BYTES - 16)); return b;
}
__global__ void __launch_bounds__(NT, 2) mega(Params Pv) {
    extern __shared__ __attribute__((aligned(16))) unsigned char lds_raw[];
    { volatile LAS unsigned* xst = (volatile LAS unsigned*)(lds_raw + (LDS_BYTES - 16));
      if (threadIdx.x == 0) { xst[0] = 0u; xst[1] = 0u; }
      __syncthreads();
      (void)xcd_barrier_post((unsigned*)Pv.ws, xst); }
#pragma unroll 1
    for (int ph = 0; ph < NPH; ++ph) {
#if DUPM
        const int nrep = (ph >= 2 && ((DUPM >> ((ph - 2) % 9)) & 1)) ? 2 : ((ph < 2 && ((DUPM >> (10 + ph)) & 1)) ? 2 : 1);
        for (int rep = 0; rep < nrep; ++rep) {
#else
        {
#endif
        CParams* kp = (CParams*)__builtin_amdgcn_kernarg_segment_ptr(); asm volatile("" : "+s"(kp));
        CParams& P = *kp;
        float* ldsf = (float*)lds_raw;
        PG8_LAS unsigned char* ldsg = (PG8_LAS unsigned char*)lds_raw;
        const int G = gridDim.x, bid = blockIdx.x;
        if (ph == 0 && (PHM & 1)) { ph_mod(P, ldsf); ph_filt_hidden(P); __syncthreads(); ph_convert(P, 0, ldsf); }
        else if (ph == 1 && (PHM & 2)) { ph_rowpass(P, 0, 0); ph_filt_final(P, ldsf); }
        else {
            const int l = (ph - 2) / 9, s = (ph - 2) % 9;
            const float* mod = (const float*)(P.ws + WS_MOD);
            if (s == 0 && (PHM & 4)) {
                pg8::Gemm g{(const bf16_t*)(P.ws + WS_H), (const bf16_t*)(P.ws + WS_WIN), M, NPAD, D}; pg8::StaticOrder S; S.init(M, NPAD, G, bid);
                pg8::EpiProj E{(bf16_t*)(P.ws + WS_PROJ), (bf16_t*)(P.ws + WS_LACT)};
                pg8::gemm_phase<pg8::EpiProj, pg8::StaticOrder, true, true>(ldsg, g, S, E);
            } else if (s == 1 && (PHM & 8)) {
                pg8::Gemm g{(const bf16_t*)(P.ws + WS_LACT), (const bf16_t*)(P.ws + WS_WL), M, NL, KL}; pg8::StaticOrder S; S.init(M, NL, G, bid);
                pg8::EpiLora E{(float*)(P.ws + WS_RW) + 4 * AS, AS, P.in[10] + l * 2048, P.in[12] + l * 2048};
                pg8::gemm_phase<pg8::EpiLora, pg8::StaticOrder, true, true>(ldsg, g, S, E);
                __syncthreads();
                ph_convprep(P, l, ldsf);
            } else if (s == 2 && (PHM & 16)) { ph_scan_hyena(P, l, ldsf); }
            else if (s == 3 && (PHM & 32)) { ph_combine(P, l, ldsf); }
            else if ((s == 4 || s == 7) && (PHM & 64)) {
                pg8::Gemm g{(const bf16_t*)(P.ws + (s == 4 ? WS_MIX : WS_PROJ)), (const bf16_t*)(P.ws + (s == 4 ? WS_WOUT : WS_W2)), M, D, s == 4 ? D : DFF}; pg8::StaticOrder S; S.init(M, D, G, bid);
                pg8::EpiRes E{P.out, mod + (size_t)l * 5 * 12288 + (s == 4 ? 2 : 5) * 2048, ALPHA};
                pg8::gemm_phase<pg8::EpiRes, pg8::StaticOrder, true, true>(ldsg, g, S, E);
            } else if (s == 5 && (PHM & 128)) { ph_rowpass(P, 1, l); }
            else if (s == 6 && (PHM & 256)) {
                pg8::Gemm g{(const bf16_t*)(P.ws + WS_H), (const bf16_t*)(P.ws + WS_W1), M, DFF, D}; pg8::StaticOrder S; S.init(M, DFF, G, bid);
                pg8::EpiRelu2 E{(bf16_t*)(P.ws + WS_PROJ), DFF};
                pg8::gemm_phase<pg8::EpiRelu2, pg8::StaticOrder, true, true>(ldsg, g, S, E);
            } else if (PHM & 512) { ph_rowpass(P, 2, l); if (l + 1 < DEPTH) ph_convert(P, l + 1, ldsf); }
        }
#if DUPM
        if (ph + 1 < NPH || rep + 1 < nrep) { if (ph == 0 && rep == 0) cg::this_grid().sync(); else xcd_barrier(make_bar(lds_raw)); }
#else
        if (ph + 1 < NPH) { if (ph == 0) cg::this_grid().sync(); else xcd_barrier(make_bar(lds_raw)); }
#endif
        if (ph == 1) for (int xs = 0; xs < XSYNC; ++xs) xcd_barrier(make_bar(lds_raw));
        }
    }
}

#ifndef MK_MULTI
#define MK_MULTI 0
#endif
extern "C" void kernel_launch(void* const* d_in, const int* in_sizes, int n_in, void* d_out, int out_size, void* d_ws, size_t ws_size, hipStream_t stream) {
    static int grid = 0;
    if (grid == 0) {
        int dev = 0, cus = 0, per_cu = 0;
        if (n_in != 33 || ws_size < WS_END) { fprintf(stderr, "kernel_launch: unexpected n_in %d or ws_size %zu (< %zu)\n", n_in, ws_size, (size_t)WS_END); grid = -1; return; }
        hipGetDevice(&dev);
        hipDeviceGetAttribute(&cus, hipDeviceAttributeMultiprocessorCount, dev);
        if (hipFuncSetAttribute((const void*)mega, hipFuncAttributeMaxDynamicSharedMemorySize, LDS_BYTES) != hipSuccess) { fprintf(stderr, "hipFuncSetAttribute failed\n"); grid = -1; return; }
        if (hipOccupancyMaxActiveBlocksPerMultiprocessor(&per_cu, (const void*)mega, NT, LDS_BYTES) != hipSuccess || per_cu < 1) { fprintf(stderr, "occupancy query failed (%d)\n", per_cu); grid = -1; return; }
        grid = cus;
    }
    if (grid < 0) return;
    Params p{};
    for (int i = 0; i < 33; ++i) p.in[i] = (const float*)d_in[i];
    p.out = (float*)d_out; p.ws = (unsigned char*)d_ws;
    if (hipMemsetAsync(d_ws, 0, 16384, stream) != hipSuccess) { fprintf(stderr, "memset failed\n"); return; }
    p.ph_lo = 0; p.ph_hi = NPH;
    void* args[] = {&p};
    hipError_t e = hipLaunchCooperativeKernel((const void*)mega, dim3(grid), dim3(NT), args, LDS_BYTES, stream);
    if (e != hipSuccess) fprintf(stderr, "cooperative launch failed: %s (grid %d)\n", hipGetErrorString(e), grid);
}
```

```cpp
#include <hip/hip_runtime.h>
#include <hip/hip_cooperative_groups.h>
#include <cstdio>
#include <cstdint>
namespace cg = cooperative_groups;

namespace pg8 {
#define PG8_LAS __attribute__((address_space(3)))
typedef unsigned short bf16_t;
typedef short bf16x8 __attribute__((ext_vector_type(8)));
typedef float f32x4 __attribute__((ext_vector_type(4)));
typedef unsigned u32x4 __attribute__((ext_vector_type(4)));
constexpr int BM = 256, BK = 64, HALF = 128, HTB = HALF * BK * 2  , STAGE_BYTES = 8 * HTB, NXCD = 8, WGM = 8;

__host__ __device__ __forceinline__ int lds_byte(int r, int c) { const int st = (r >> 4) * 2 + (c >> 5), rr = r & 15, cc = c & 31, ob = rr * 64 + cc * 2; return st * 1024 + (ob ^ (((ob >> 9) & 1) << 5)); }
__host__ __device__ __forceinline__ void stage_rc(int b, int& R, int& C) { const int st = b / 1024, sb = b % 1024, swz = sb ^ (((sb >> 9) & 1) << 5); R = (st >> 1) * 16 + swz / 64; C = (st & 1) * 32 + (swz % 64) / 2; }
__host__ __device__ __forceinline__ int perm32(int rho) { const int n = rho >> 4, i = rho & 15; return 8 * (i >> 2) + 4 * n + (i & 3); }

struct Unit { int pm, pn; };
struct Gemm { const bf16_t* A; const bf16_t* Bt; int M, N, K; };

struct StaticOrder {
    int nM, nN, nwg, G, c;
    __host__ __device__ void init(int M, int N, int G_, int c_) { nM = M / BM; nN = N / BM; nwg = nM * nN; G = G_; c = c_; }
    __host__ __device__ bool next(int i, Unit& u) const {
        const long L = (long)i * G + c; if (L >= nwg) return false;
        int wgid = (int)L; { const int q = nwg / NXCD, r = nwg % NXCD, xcd = wgid % NXCD, off = wgid / NXCD; wgid = (xcd < r ? xcd * (q + 1) : r * (q + 1) + (xcd - r) * q) + off; }
        const int nig = WGM * nN, gid = wgid / nig, fm = gid * WGM, gsz = (nM - fm) < WGM ? (nM - fm) : WGM;
        u.pm = fm + ((wgid % nig) % gsz); u.pn = (wgid % nig) / gsz; return true;
    }
    __device__ __forceinline__ void a_ready(const Unit&) const {}
    __device__ __forceinline__ void done(const Unit&) const {}
};

typedef __bf16 bf16x2v __attribute__((ext_vector_type(2)));
typedef float f32x2v __attribute__((ext_vector_type(2)));
__device__ __forceinline__ unsigned cvt_pk_bf16(float lo, float hi) { const f32x2v v = {lo, hi}; const bf16x2v b = __builtin_convertvector(v, bf16x2v); return __builtin_bit_cast(unsigned, b); }
typedef float f32x2 __attribute__((ext_vector_type(2)));

__device__ __forceinline__ float sigm(float x) { return __builtin_amdgcn_rcpf(1.f + __expf(-x)); }
struct EpiProj {
    static constexpr bool PERM = true, AFTER_DRAIN = false;
    bf16_t* proj; bf16_t* lact;
    __device__ __forceinline__ void operator()(const f32x4 (&acc)[2][2][4][2], const Unit& u, int wr, int wc, int fr, int fq) const {
        const int row0 = u.pm * BM + wr * 64 + fr, col0 = u.pn * BM + wc * 32 + 8 * fq;
        if (u.pn < 24) {
#pragma unroll
            for (int ai = 0; ai < 2; ++ai)
#pragma unroll
                for (int m = 0; m < 4; ++m) { bf16_t* rowp = proj + (size_t)(row0 + ai * HALF + m * 16) * 6144 + col0;
#pragma unroll
                    for (int bj = 0; bj < 2; ++bj) { const f32x4 v0 = acc[ai][bj][m][0], v1 = acc[ai][bj][m][1];
                        u32x4 w; w.x = cvt_pk_bf16(v0[0], v0[1]); w.y = cvt_pk_bf16(v0[2], v0[3]); w.z = cvt_pk_bf16(v1[0], v1[1]); w.w = cvt_pk_bf16(v1[2], v1[3]);
                        *(u32x4*)(rowp + bj * HALF) = w; } }
        } else {
#pragma unroll
            for (int ai = 0; ai < 2; ++ai)
#pragma unroll
                for (int m = 0; m < 4; ++m) { bf16_t* rowp = lact + (size_t)(row0 + ai * HALF + m * 16) * 384;
#pragma unroll
                    for (int bj = 0; bj < 2; ++bj)
#pragma unroll
                        for (int n = 0; n < 2; ++n) {
                            const int cl = col0 - 6144 + bj * HALF + 4 * n;
                            if (cl < 384) {
                                f32x4 v = acc[ai][bj][m][n];
                                if (cl < 64) { v[0] = tanhf(v[0]); v[1] = tanhf(v[1]); v[2] = tanhf(v[2]); v[3] = tanhf(v[3]); }
                                else if (cl < 128) { }
                                else if (cl < 288) { v[0] = sigm(v[0]); v[1] = sigm(v[1]); v[2] = sigm(v[2]); v[3] = sigm(v[3]); }
                                else { v = (f32x4){0.f, 0.f, 0.f, 0.f}; }
                                uint2 w; w.x = cvt_pk_bf16(v[0], v[1]); w.y = cvt_pk_bf16(v[2], v[3]);
                                *(uint2*)(rowp + cl) = w;
                            }
                        } }
        }
    }
};
struct EpiLora {
    static constexpr bool PERM = false, AFTER_DRAIN = false;
    float* arr0; size_t arr_stride;
    const float* w0; const float* a0;
    template <int MODE>
    __device__ __forceinline__ void body(const f32x4 (&acc)[2][2][4][2], float* base, const float* bptr, int row0, int col0, float bsc, bool isg) const {
#pragma unroll
        for (int ai = 0; ai < 2; ++ai)
#pragma unroll
            for (int m = 0; m < 4; ++m) { float* rowp = base + (size_t)(row0 + ai * HALF + m * 16) * 1024 + col0;
#pragma unroll
                for (int bj = 0; bj < 2; ++bj)
#pragma unroll
                    for (int n = 0; n < 2; ++n) {
                        f32x4 v = acc[ai][bj][m][n];
                        v = v + *(const f32x4*)(bptr + col0 + bj * HALF + n * 16) * bsc;
#pragma unroll
                        for (int e = 0; e < 4; ++e) { const float sg = sigm(v[e]); v[e] = MODE == 0 ? __expf(-0.6065306597126334f * sg) : (isg ? v[e] : sg); }
                        *(f32x4*)(rowp + bj * HALF + n * 16) = v;
                    } }
    }
    __device__ __forceinline__ void operator()(const f32x4 (&acc)[2][2][4][2], const Unit& u, int wr, int wc, int fr, int fq) const {
        const int which = u.pn >> 2;
        const int row0 = u.pm * BM + wr * 64 + fr, col0 = (u.pn & 3) * BM + wc * 32 + 4 * fq;
        float* base = arr0 + (size_t)which * arr_stride;
        if (which < 2) body<0>(acc, base, w0 + which * 1024, row0, col0, 1.f, false);
        else body<1>(acc, base, a0 + ((which - 2) & 1) * 1024, row0, col0, which < 4 ? 1.f : 0.f, which >= 4);
    }
};
struct EpiRes {
    static constexpr bool PERM = false, AFTER_DRAIN = false;
    float* X; const float* gate;
    float alpha;
    __device__ __forceinline__ void operator()(const f32x4 (&acc)[2][2][4][2], const Unit& u, int wr, int wc, int fr, int fq) const {
        const int row0 = u.pm * BM + wr * 64 + fr, col0 = u.pn * BM + wc * 32 + 4 * fq;
        const int bidx = u.pm < 16 ? 0 : 1 + ((u.pm - 16) >> 2);
        const float* gp = gate + (size_t)bidx * 12288 + col0;
        f32x4 gv[2][2];
#pragma unroll
        for (int bj = 0; bj < 2; ++bj)
#pragma unroll
            for (int n = 0; n < 2; ++n) gv[bj][n] = *(const f32x4*)(gp + bj * HALF + n * 16);
#pragma unroll
        for (int ai = 0; ai < 2; ++ai)
#pragma unroll
            for (int m = 0; m < 4; ++m) { float* rowp = X + (size_t)(row0 + ai * HALF + m * 16) * 2048 + col0;
#pragma unroll
                for (int bj = 0; bj < 2; ++bj)
#pragma unroll
                    for (int n = 0; n < 2; ++n) {
                        f32x4* p = (f32x4*)(rowp + bj * HALF + n * 16);
                        const f32x4 xv = *p;
                        *p = xv * alpha + gv[bj][n] * acc[ai][bj][m][n];
                    } }
    }
};
struct EpiRelu2 {
    static constexpr bool PERM = true, AFTER_DRAIN = false;
    bf16_t* O; int ldc;
    __device__ __forceinline__ void operator()(const f32x4 (&acc)[2][2][4][2], const Unit& u, int wr, int wc, int fr, int fq) const {
        const int row0 = u.pm * BM + wr * 64 + fr, col0 = u.pn * BM + wc * 32 + 8 * fq;
#pragma unroll
        for (int ai = 0; ai < 2; ++ai)
#pragma unroll
            for (int m = 0; m < 4; ++m) { bf16_t* rowp = O + (size_t)(row0 + ai * HALF + m * 16) * ldc + col0;
#pragma unroll
                for (int bj = 0; bj < 2; ++bj) { f32x4 v0 = acc[ai][bj][m][0], v1 = acc[ai][bj][m][1];
#pragma unroll
                    for (int e = 0; e < 4; ++e) { const float a = fmaxf(v0[e], 0.f), b = fmaxf(v1[e], 0.f); v0[e] = a * a; v1[e] = b * b; }
                    u32x4 w; w.x = cvt_pk_bf16(v0[0], v0[1]); w.y = cvt_pk_bf16(v0[2], v0[3]); w.z = cvt_pk_bf16(v1[0], v1[1]); w.w = cvt_pk_bf16(v1[2], v1[3]);
                    *(u32x4*)(rowp + bj * HALF) = w; } }
    }
};

template <class Epi, class Sched, bool ALIGN_EPI = false, bool SP2 = false>
__device__ __forceinline__ void gemm_phase(PG8_LAS unsigned char* lds, const Gemm g, const Sched& S, const Epi& E) {
    int tid = threadIdx.x; asm volatile("" : "+v"(tid)); const int wid = __builtin_amdgcn_readfirstlane(tid >> 6), lane = tid & 63, wr = wid >> 2, wc = wid & 3, fr = lane & 15, fq = lane >> 4;
    const int K = g.K, nt = K / BK;
    unsigned voffA[2], voffB[2];
#pragma unroll
    for (int i = 0; i < 2; ++i) { int R, C; stage_rc(tid * 16 + i * 8192, R, C); const int Rb = Epi::PERM ? ((R & ~31) + perm32(R & 31)) : R;
        voffA[i] = (unsigned)(R * K + C) * 2u; voffB[i] = (unsigned)(Rb * K + C) * 2u; }
    const size_t kstep = (size_t)(BK * 2);
    const size_t hstep = (size_t)HALF * K * 2;
    const size_t tstep = 2 * hstep;
    const unsigned ldsw = (unsigned)wid * 1024u;
    const int aoff = lds_byte(wr * 64 + fr, fq * 8), boff = lds_byte(wc * 32 + fr, fq * 8);
#define PG8_SA(b, h) (((b) * 2 + (h)) * HTB)
#define PG8_SB(b, h) ((4 + (b) * 2 + (h)) * HTB)
#define PG8_STAGE(bufoff, gbase, voff) do { _Pragma("unroll") for (int _i = 0; _i < 2; ++_i) \
        __builtin_amdgcn_global_load_lds((const unsigned*)((const char*)(gbase) + (voff)[_i]), (PG8_LAS unsigned*)(lds + (bufoff) + ldsw + _i * 8192), 16, 0, 0); } while (0)
#define PG8_LDA(dst, b, h) do { _Pragma("unroll") for (int m = 0; m < 4; ++m) _Pragma("unroll") for (int k = 0; k < 2; ++k) dst[m][k] = *(const PG8_LAS bf16x8*)(lds + PG8_SA(b, h) + aoff + m * 2048 + k * 1024); } while (0)
#define PG8_LDB(dst, b, h) do { _Pragma("unroll") for (int n = 0; n < 2; ++n) _Pragma("unroll") for (int k = 0; k < 2; ++k) dst[n][k] = *(const PG8_LAS bf16x8*)(lds + PG8_SB(b, h) + boff + n * 2048 + k * 1024); } while (0)
#define PG8_MMA(ai, bj, At, Bt) do { __builtin_amdgcn_s_setprio(1); _Pragma("unroll") for (int m = 0; m < 4; ++m) _Pragma("unroll") for (int n = 0; n < 2; ++n) _Pragma("unroll") for (int k = 0; k < 2; ++k) \
        acc[ai][bj][m][n] = __builtin_amdgcn_mfma_f32_16x16x32_bf16(Bt[n][k], At[m][k], acc[ai][bj][m][n], 0, 0, 0); __builtin_amdgcn_s_setprio(0); } while (0)
#define PG8_WAIT_V(n) asm volatile("s_waitcnt vmcnt(" #n ")" ::: "memory")
#define PG8_WAIT_L(n) asm volatile("s_waitcnt lgkmcnt(" #n ")" ::: "memory")
#define PG8_BAR __builtin_amdgcn_s_barrier()
#define PG8_SCHED __builtin_amdgcn_sched_barrier(0)
    Unit cur, nxt; int ui = 0;
    if (!S.next(0, cur)) return;
    f32x4 acc[2][2][4][2];
#pragma unroll
    for (int a = 0; a < 2; ++a)
#pragma unroll
        for (int b = 0; b < 2; ++b)
#pragma unroll
            for (int m = 0; m < 4; ++m)
#pragma unroll
                for (int n = 0; n < 2; ++n) acc[a][b][m][n] = (f32x4){0.f, 0.f, 0.f, 0.f};
    bf16x8 At[4][2], B0[2][2], B1[2][2];
    const char* cA = (const char*)g.A + (size_t)cur.pm * tstep; const char* cB = (const char*)g.Bt + (size_t)cur.pn * tstep;
    S.a_ready(cur);
    if constexpr (SP2) {
        PG8_STAGE(PG8_SB(0, 0), cB, voffB); PG8_STAGE(PG8_SB(0, 1), cB + hstep, voffB); PG8_STAGE(PG8_SA(0, 0), cA, voffA); PG8_STAGE(PG8_SA(0, 1), cA + hstep, voffA);
        if (wr == 1) PG8_BAR;
        PG8_WAIT_V(2); PG8_BAR;
        PG8_STAGE(PG8_SB(1, 0), cB + kstep, voffB); PG8_STAGE(PG8_SA(1, 0), cA + kstep, voffA); PG8_STAGE(PG8_SB(1, 1), cB + hstep + kstep, voffB);
        PG8_WAIT_V(6); PG8_BAR;
    } else {
        PG8_STAGE(PG8_SB(0, 0), cB, voffB); PG8_STAGE(PG8_SA(0, 0), cA, voffA); PG8_STAGE(PG8_SB(0, 1), cB + hstep, voffB); PG8_STAGE(PG8_SA(0, 1), cA + hstep, voffA);
        if (wr == 1) PG8_BAR;
        PG8_WAIT_V(4); PG8_BAR;
        PG8_STAGE(PG8_SB(1, 0), cB + kstep, voffB); PG8_STAGE(PG8_SA(1, 0), cA + kstep, voffA); PG8_STAGE(PG8_SB(1, 1), cB + hstep + kstep, voffB);
        PG8_WAIT_V(6); PG8_BAR;
    }
    for (;;) {
        const bool has_next = S.next(ui + 1, nxt);
        const char* nA = has_next ? (const char*)g.A + (size_t)nxt.pm * tstep : cA; const char* nB = has_next ? (const char*)g.Bt + (size_t)nxt.pn * tstep : cB;
        for (int t = 0; t < nt; t += 2) {
            const bool last = (t == nt - 2);
            const char* a1 = cA + (size_t)(t + 1) * kstep;
            const char* a2 = last ? nA : cA + (size_t)(t + 2) * kstep; const char* b2 = last ? nB : cB + (size_t)(t + 2) * kstep;
            const char* a3 = a2 + kstep; const char* b3 = b2 + kstep;
            if (last && has_next) S.a_ready(nxt);
            if constexpr (SP2) {
            PG8_LDB(B0, 0, 0); PG8_LDB(B1, 0, 1); PG8_SCHED; PG8_LDA(At, 0, 0); PG8_STAGE(PG8_SA(1, 1), a1 + hstep, voffA);
            PG8_WAIT_V(8); PG8_WAIT_L(0); PG8_BAR; PG8_MMA(0, 0, At, B0); PG8_MMA(0, 1, At, B1); PG8_BAR; PG8_SCHED;
            PG8_LDA(At, 0, 1); PG8_STAGE(PG8_SB(0, 0), b2, voffB); PG8_STAGE(PG8_SB(0, 1), b2 + hstep, voffB); PG8_STAGE(PG8_SA(0, 0), a2, voffA);
            PG8_WAIT_V(8); PG8_WAIT_L(0); PG8_BAR; PG8_MMA(1, 0, At, B0); PG8_MMA(1, 1, At, B1); PG8_BAR; PG8_SCHED;
            PG8_LDB(B0, 1, 0); PG8_LDB(B1, 1, 1); PG8_SCHED; PG8_LDA(At, 1, 0); PG8_STAGE(PG8_SA(0, 1), a2 + hstep, voffA);
            PG8_WAIT_V(8); PG8_WAIT_L(0); PG8_BAR; PG8_MMA(0, 0, At, B0); PG8_MMA(0, 1, At, B1); PG8_BAR; PG8_SCHED;
            PG8_LDA(At, 1, 1); PG8_STAGE(PG8_SB(1, 0), b3, voffB); PG8_STAGE(PG8_SB(1, 1), b3 + hstep, voffB); PG8_STAGE(PG8_SA(1, 0), a3, voffA);
            PG8_WAIT_V(8); PG8_WAIT_L(0); PG8_BAR; PG8_MMA(1, 0, At, B0); PG8_MMA(1, 1, At, B1); PG8_BAR; PG8_SCHED;
            } else {
            PG8_LDB(B0, 0, 0); PG8_SCHED; PG8_LDA(At, 0, 0); PG8_STAGE(PG8_SA(1, 1), a1 + hstep, voffA);
            PG8_WAIT_L(8); PG8_BAR; PG8_WAIT_L(0); PG8_MMA(0, 0, At, B0); PG8_BAR; PG8_SCHED;
            PG8_LDB(B1, 0, 1); PG8_STAGE(PG8_SB(0, 0), b2, voffB);
            PG8_BAR; PG8_WAIT_L(0); PG8_MMA(0, 1, At, B1); PG8_BAR;
            PG8_LDA(At, 0, 1); PG8_STAGE(PG8_SA(0, 0), a2, voffA);
            PG8_BAR; PG8_WAIT_L(0); PG8_MMA(1, 0, At, B0); PG8_BAR; PG8_SCHED;
            PG8_STAGE(PG8_SB(0, 1), b2 + hstep, voffB);
            PG8_WAIT_V(6); PG8_BAR; PG8_MMA(1, 1, At, B1); PG8_BAR;
            PG8_LDB(B0, 1, 0); PG8_SCHED; PG8_LDA(At, 1, 0); PG8_STAGE(PG8_SA(0, 1), a2 + hstep, voffA);
            PG8_WAIT_L(8); PG8_BAR; PG8_WAIT_L(0); PG8_MMA(0, 0, At, B0); PG8_BAR; PG8_SCHED;
            PG8_LDB(B1, 1, 1); PG8_STAGE(PG8_SB(1, 0), b3, voffB);
            PG8_BAR; PG8_WAIT_L(0); PG8_MMA(0, 1, At, B1); PG8_BAR;
            PG8_LDA(At, 1, 1); PG8_STAGE(PG8_SA(1, 0), a3, voffA);
            PG8_BAR; PG8_WAIT_L(0); PG8_MMA(1, 0, At, B0); PG8_BAR; PG8_SCHED;
            PG8_STAGE(PG8_SB(1, 1), b3 + hstep, voffB);
            PG8_WAIT_V(6); PG8_BAR; PG8_MMA(1, 1, At, B1); PG8_BAR;
            }
        }
        if constexpr (ALIGN_EPI) { if (wr == 0) PG8_BAR; }
        if constexpr (!Epi::AFTER_DRAIN) { int t2 = threadIdx.x; asm volatile("" : "+v"(t2)); const int fr2 = t2 & 15, fq2 = (t2 & 63) >> 4; E(acc, cur, wr, wc, fr2, fq2); S.done(cur); }
        if (!has_next) break;
#pragma unroll
        for (int a = 0; a < 2; ++a)
#pragma unroll
            for (int b = 0; b < 2; ++b)
#pragma unroll
                for (int m = 0; m < 4; ++m)
#pragma unroll
                    for (int n = 0; n < 2; ++n) acc[a][b][m][n] = (f32x4){0.f, 0.f, 0.f, 0.f};
        cur = nxt; cA = nA; cB = nB; ++ui;
        if constexpr (ALIGN_EPI) { if (wr == 1) PG8_BAR; }
    }
    PG8_WAIT_V(0);
    if constexpr (!ALIGN_EPI) { if (wr == 0) PG8_BAR; }
    PG8_BAR;
    if constexpr (Epi::AFTER_DRAIN) { E.fused(acc, cur, wr, wc, fr, fq, lds, wid, lane); S.done(cur); }
#undef PG8_SA
#undef PG8_SB
#undef PG8_STAGE
#undef PG8_LDA
#undef PG8_LDB
#undef PG8_MMA
#undef PG8_WAIT_V
#undef PG8_WAIT_L
#undef PG8_BAR
#undef PG8_SCHED
}
}

using f4 = pg8::f32x4;
typedef unsigned short bf16_t;
constexpr int NT = 512;
constexpr int M = 8192, D = 2048, DR = 1024, NPAD = 6656, DFF = 8192, KL = 384, NL = 5120;
constexpr int DEPTH = 2;
constexpr float ALPHA = 1.4142135623730951f;
constexpr float LN_EPS = 1e-5f, GN_EPS = 64e-5f;
constexpr int LDS_BYTES = 147456;

constexpr size_t al256(size_t x) { return (x + 255) & ~(size_t)255; }
constexpr size_t FILT_CTX_PER = (size_t)2 * 1024 * 528, FILT_LAT_PER = (size_t)2 * 1024 * 2064;
constexpr size_t WS_MOD = 16384;
constexpr size_t WS_FH2 = al256(WS_MOD + (size_t)2 * 5 * 12288 * 4);
constexpr size_t WS_FILT = al256(WS_FH2 + (size_t)2 * 1280 * 64 * 4);
constexpr size_t WS_WIN = WS_FILT;
constexpr size_t WS_WOUT = WS_WIN + (size_t)NPAD * D * 2;
constexpr size_t WS_W1 = WS_WOUT + (size_t)D * D * 2;
constexpr size_t WS_W2 = WS_W1 + (size_t)DFF * D * 2;
constexpr size_t WS_WL = WS_W2 + (size_t)D * DFF * 2;
constexpr size_t WS_H = WS_WL + (size_t)NL * KL * 2;
constexpr size_t WS_MIX = WS_H + (size_t)M * D * 2;
constexpr size_t WS_LACT = WS_MIX + (size_t)M * D * 2;
constexpr size_t WS_PROJ = WS_LACT + (size_t)M * KL * 2;
constexpr size_t WS_RW = WS_PROJ + (size_t)M * 6144 * 2;
constexpr size_t WS_HT = WS_RW + (size_t)9 * M * 1024 * 4;
constexpr size_t WS_FILTB = WS_HT + (size_t)3 * 1024 * M * 2;
constexpr size_t FILTB_CTX = (size_t)2 * 1024 * 520, FILTB_LAT = (size_t)2 * 1024 * 2056, FILTB_PER = FILTB_CTX + FILTB_LAT;
constexpr size_t WS_END = WS_FILTB + 2 * FILTB_PER * 2;
static_assert(WS_END <= (size_t)805306368, "workspace map too large");
constexpr size_t AS = (size_t)M * 1024;
constexpr size_t OUT_STATE = (size_t)16777216;

__device__ __forceinline__ int tid_l() { int t = threadIdx.x; asm volatile("" : "+v"(t)); return t; }
struct Params { const float* in[33]; float* out; unsigned char* ws; int ph_lo, ph_hi; };
typedef const __attribute__((address_space(4))) Params CParams;

__device__ __forceinline__ float wave_sum(float v) {
#pragma unroll
    for (int o = 1; o < 64; o <<= 1) v += __shfl_xor(v, o);
    return v;
}
typedef __bf16 bf16x2_t __attribute__((ext_vector_type(2)));
typedef float f32x2_t __attribute__((ext_vector_type(2)));
__device__ __forceinline__ unsigned pk2(float lo, float hi) { const f32x2_t v = {lo, hi}; const bf16x2_t b = __builtin_convertvector(v, bf16x2_t); return __builtin_bit_cast(unsigned, b); }
__device__ __forceinline__ bf16_t f2bf(float f) { unsigned u = __float_as_uint(f); u += 0x7FFFu + ((u >> 16) & 1u); return (bf16_t)(u >> 16); }
__device__ __forceinline__ float bf2f(unsigned short b) { return __uint_as_float(((unsigned)b) << 16); }
__device__ __forceinline__ float sigmf(float x) { return __builtin_amdgcn_rcpf(1.f + __expf(-x)); }

__device__ __forceinline__ void ph_mod(CParams& P, float* lds) {
    const int tid = tid_l();
    float* scond = lds;
    float* red = lds + 5 * 2048;
    const float* c = P.in[2]; const float* cctx = P.in[4];
    for (int i = tid; i < 5 * 2048; i += NT) { const int b = i >> 11, k = i & 2047; const float x = b == 0 ? cctx[k] : c[(b - 1) * 2048 + k]; scond[i] = x / (1.f + __expf(-x)); }
    __syncthreads();
    const float* w_ada = P.in[5]; const float* b_ada = P.in[6];
    float* mod = (float*)(P.ws + WS_MOD);
    const int kg = tid >> 5, c4 = tid & 31;
    for (int item = blockIdx.x; item < 192; item += gridDim.x) {
        const int l = item / 96, c0 = (item % 96) * 128;
        f4 acc[5];
#pragma unroll
        for (int b = 0; b < 5; ++b) acc[b] = (f4){0.f, 0.f, 0.f, 0.f};
        const float* wp = w_ada + ((size_t)l * 2048 + kg * 128) * 12288 + c0 + c4 * 4;
        const float* sc = scond + kg * 128;
#pragma unroll 8
        for (int k = 0; k < 128; ++k) {
            const f4 w = *(const f4*)(wp + (size_t)k * 12288);
#pragma unroll
            for (int b = 0; b < 5; ++b) acc[b] += w * sc[b * 2048 + k];
        }
#pragma unroll
        for (int b = 0; b < 5; ++b) *(f4*)(red + (kg * 5 + b) * 128 + c4 * 4) = acc[b];
        __syncthreads();
        for (int idx = tid; idx < 640; idx += NT) {
            const int b = idx >> 7, cc = idx & 127; float s = 0.f;
#pragma unroll
            for (int g = 0; g < 16; ++g) s += red[(g * 5 + b) * 128 + cc];
            mod[(size_t)(l * 5 + b) * 12288 + c0 + cc] = s + b_ada[(size_t)l * 12288 + c0 + cc];
        }
        __syncthreads();
    }
}

__device__ __forceinline__ void ph_filt_hidden(CParams& P) {
    const int lane = tid_l() & 63, wave = tid_l() >> 6;
    const int gw = blockIdx.x * 8 + wave, ngw = gridDim.x * 8;
    float* fh2 = (float*)(P.ws + WS_FH2);
    for (int it = gw; it < 2 * 1280; it += ngw) {
        const int l = it / 1280, q = it % 1280;
        const int seq = q < 256 ? 256 : 1024, p = q < 256 ? q : q - 256;
        const float t = (float)p / (float)(seq - 1);
        const float wang = (float)(6.283185307179586 / (double)seq) * (float)p;
        float z = 0.f;
        if (lane == 0) z = t;
        else if (lane <= 32) {
            const int fi = (lane - 1) & 15; const float st = (float)fi / 15.f; const float f = 1e-4f * (1.f - st) + 15.f * st;
            z = lane <= 16 ? cosf(f * wang) : -sinf(f * wang);
        }
        const float* w1 = P.in[19] + (size_t)l * 33 * 64; const float* b1 = P.in[20] + l * 64;
        const float* w2 = P.in[21] + (size_t)l * 64 * 64; const float* b2 = P.in[22] + l * 64;
        const float* fr = P.in[24] + l * 128;
        float a = b1[lane];
        for (int i = 0; i < 33; ++i) a += __shfl(z, i) * w1[i * 64 + lane];
        const float h1 = sinf(fr[lane] * a);
        float a2 = b2[lane];
        for (int i = 0; i < 64; ++i) a2 += __shfl(h1, i) * w2[i * 64 + lane];
        const float h2 = sinf(fr[64 + lane] * a2);
        fh2[((size_t)l * 1280 + q) * 64 + lane] = h2;
    }
}

__device__ __forceinline__ void transpose_item(const float* W, int K, int N, bf16_t* WT, float* scr, int item, int lane) {
    const int nblk = N / 32, kb = item / nblk, nb = item % nblk, k0 = 64 * kb, n0 = 32 * nb;
    float tv[32];
#pragma unroll
    for (int i = 0; i < 32; ++i) { const int kk = 2 * i + (lane >> 5); tv[i] = W[(size_t)(k0 + kk) * N + n0 + (lane & 31)]; }
#pragma unroll
    for (int i = 0; i < 32; ++i) { const int kk = 2 * i + (lane >> 5); scr[kk * 33 + (lane & 31)] = tv[i]; }
    asm volatile("s_waitcnt lgkmcnt(0)" ::: "memory");
    const int c = lane & 7;
#pragma unroll
    for (int j = 0; j < 4; ++j) { const int n = (lane >> 3) + 8 * j; const float* s = scr + (8 * c) * 33 + n;
        uint4 o; o.x = pk2(s[0 * 33], s[1 * 33]); o.y = pk2(s[2 * 33], s[3 * 33]); o.z = pk2(s[4 * 33], s[5 * 33]); o.w = pk2(s[6 * 33], s[7 * 33]);
        *(uint4*)(WT + (size_t)(n0 + n) * K + k0 + 8 * c) = o; }
    asm volatile("s_waitcnt lgkmcnt(0)" ::: "memory");
}
__device__ __forceinline__ void ph_convert(CParams& P, int l, float* lds) {
    const int lane = tid_l() & 63, wave = tid_l() >> 6;
    const int gw = blockIdx.x * 8 + wave, ngw = gridDim.x * 8;
    float* scr = lds + wave * (64 * 33);
    constexpr int I_IN = 32 * 201, I_OUT = 32 * 64, I_1 = 32 * 256, I_2 = 128 * 64;
    const float* w_in = P.in[7] + (size_t)l * 2048 * 6432; const float* w_out = P.in[26] + (size_t)l * 2048 * 2048;
    const float* w1 = P.in[31] + (size_t)l * 2048 * 8192; const float* w2 = P.in[32] + (size_t)l * 8192 * 2048;
    bf16_t* WIN = (bf16_t*)(P.ws + WS_WIN); bf16_t* WOUT = (bf16_t*)(P.ws + WS_WOUT); bf16_t* W1 = (bf16_t*)(P.ws + WS_W1); bf16_t* W2 = (bf16_t*)(P.ws + WS_W2);
    for (int it = gw; it < I_IN + I_OUT + I_1 + I_2; it += ngw) {
        int r = it;
        if (r < I_IN) { transpose_item(w_in, 2048, 6432, WIN, scr, r, lane); continue; } r -= I_IN;
        if (r < I_OUT) { transpose_item(w_out, 2048, 2048, WOUT, scr, r, lane); continue; } r -= I_OUT;
        if (r < I_1) { transpose_item(w1, 2048, 8192, W1, scr, r, lane); continue; } r -= I_1;
        transpose_item(w2, 8192, 2048, W2, scr, r, lane);
    }
    { uint4* z = (uint4*)(WIN + (size_t)6432 * 2048); const int n16 = 224 * 2048 * 2 / 16;
      unsigned zz = 0u; asm volatile("" : "+v"(zz));
      for (int i = blockIdx.x * NT + tid_l(); i < n16; i += gridDim.x * NT) z[i] = make_uint4(zz, zz, zz, zz); }
    { bf16_t* WL = (bf16_t*)(P.ws + WS_WL);
      const float* wup = P.in[9] + (size_t)l * 2 * 64 * 1024; const float* aup = P.in[11] + (size_t)l * 2 * 64 * 1024; const float* gup = P.in[13] + (size_t)l * 160 * 1024;
      for (int i = blockIdx.x * NT + tid_l(); i < NL * KL; i += gridDim.x * NT) {
          const int n = i / KL, k = i % KL; const int which = n >> 10, c = n & 1023; float v = 0.f;
          if (which < 2) { if (k < 64) v = wup[((size_t)which * 64 + k) * 1024 + c]; }
          else if (which < 4) { if (k >= 64 && k < 128) v = aup[((size_t)(which - 2) * 64 + (k - 64)) * 1024 + c]; }
          else { if (k >= 128 && k < 288) v = gup[(size_t)(k - 128) * 1024 + c]; }
          WL[i] = f2bf(v);
      } }
}

__device__ __forceinline__ void row_pass4(const float* src, float* dstX, const float* ag, const float* ab, const float* msh, const float* msc, bf16_t* hrow, int lane) {
    f4 v[4][8]; float s[4];
#pragma unroll
    for (int r = 0; r < 4; ++r) {
        s[r] = 0.f;
#pragma unroll
        for (int j = 0; j < 8; ++j) v[r][j] = *(const f4*)(src + (size_t)r * 2048 + j * 256 + lane * 4);
    }
#pragma unroll
    for (int r = 0; r < 4; ++r)
#pragma unroll
        for (int j = 0; j < 8; ++j) s[r] += (v[r][j][0] + v[r][j][1]) + (v[r][j][2] + v[r][j][3]);
    if (ag) {
        float s2[4], rstd[4];
#pragma unroll
        for (int r = 0; r < 4; ++r) { const float mean = wave_sum(s[r]) * (1.f / 2048.f); s2[r] = 0.f;
#pragma unroll
            for (int j = 0; j < 8; ++j) { v[r][j] = v[r][j] - mean; s2[r] += (v[r][j][0] * v[r][j][0] + v[r][j][1] * v[r][j][1]) + (v[r][j][2] * v[r][j][2] + v[r][j][3] * v[r][j][3]); } }
#pragma unroll
        for (int r = 0; r < 4; ++r) { rstd[r] = rsqrtf(wave_sum(s2[r]) * (1.f / 2048.f) + LN_EPS); s[r] = 0.f; }
#pragma unroll
        for (int j = 0; j < 8; ++j) { const f4 g = *(const f4*)(ag + j * 256 + lane * 4), b = *(const f4*)(ab + j * 256 + lane * 4);
#pragma unroll
            for (int r = 0; r < 4; ++r) { v[r][j] = v[r][j] * rstd[r] * g + b; s[r] += (v[r][j][0] + v[r][j][1]) + (v[r][j][2] + v[r][j][3]); } }
    }
#pragma unroll
    for (int r = 0; r < 4; ++r)
#pragma unroll
        for (int j = 0; j < 8; ++j) *(f4*)(dstX + (size_t)r * 2048 + j * 256 + lane * 4) = v[r][j];
    if (msh) {
        float s2[4], rstd[4];
#pragma unroll
        for (int r = 0; r < 4; ++r) { const float mean = wave_sum(s[r]) * (1.f / 2048.f); s2[r] = 0.f;
#pragma unroll
            for (int j = 0; j < 8; ++j) { v[r][j] = v[r][j] - mean; s2[r] += (v[r][j][0] * v[r][j][0] + v[r][j][1] * v[r][j][1]) + (v[r][j][2] * v[r][j][2] + v[r][j][3] * v[r][j][3]); } }
#pragma unroll
        for (int r = 0; r < 4; ++r) rstd[r] = rsqrtf(wave_sum(s2[r]) * (1.f / 2048.f) + LN_EPS);
#pragma unroll
        for (int j = 0; j < 8; ++j) { const f4 sh = *(const f4*)(msh + j * 256 + lane * 4), sc = *(const f4*)(msc + j * 256 + lane * 4) + 1.f;
#pragma unroll
            for (int r = 0; r < 4; ++r) { const f4 h = v[r][j] * rstd[r] * sc + sh;
                uint2 w; w.x = pk2(h[0], h[1]); w.y = pk2(h[2], h[3]);
                *(uint2*)(hrow + (size_t)r * 2048 + j * 256 + lane * 4) = w; } }
    }
}
__device__ __forceinline__ void ph_rowpass(CParams& P, int mode, int l) {
    const int lane = tid_l() & 63, wave = tid_l() >> 6;
    const int gw = blockIdx.x * 8 + wave, ngw = gridDim.x * 8;
    const float* mod = (const float*)(P.ws + WS_MOD);
    bf16_t* H = (bf16_t*)(P.ws + WS_H);
    for (int m = gw * 4; m < M; m += ngw * 4) {
        const int bidx = m < 4096 ? 0 : 1 + ((m - 4096) >> 10);
        const float* src; const float* ag = nullptr; const float* ab = nullptr; const float* msh = nullptr; const float* msc = nullptr;
        float* dst = P.out + (size_t)m * 2048;
        if (mode == 0) { src = m < 4096 ? P.in[0] + (size_t)m * 2048 : P.in[1] + (size_t)(m - 4096) * 2048;
            msh = mod + (size_t)(0 * 5 + bidx) * 12288; msc = msh + 2048; }
        else if (mode == 1) { src = dst; ag = P.in[27] + l * 2048; ab = P.in[28] + l * 2048;
            msh = mod + (size_t)(l * 5 + bidx) * 12288 + 3 * 2048; msc = msh + 2048; }
        else { src = dst; ag = P.in[29] + l * 2048; ab = P.in[30] + l * 2048;
            if (l + 1 < DEPTH) { msh = mod + (size_t)((l + 1) * 5 + bidx) * 12288; msc = msh + 2048; } }
        row_pass4(src, dst, ag, ab, msh, msc, H + (size_t)m * 2048, lane);
    }
}

__device__ __forceinline__ void ph_filt_final(CParams& P, float* lds) {
    const int tid = tid_l(); const int cl = tid & 15, ps = tid >> 4;
    for (int it = blockIdx.x; it < 512; it += gridDim.x) {
        const int ss = it < 256 ? 1 : 0; const int item = it & 255;
        const int cgp = item & 63, o = (item >> 6) & 1, l = item >> 7;
        const int L = ss ? 1024 : 256, GRL = 2 * L + 8, RS = 2 * L + 1;
        float* buf = lds; float* red = lds + 16 * 2049; float* invs = red + 512;
        const int c = cgp * 16 + cl;
        const float* h2 = (const float*)(P.ws + WS_FH2) + ((size_t)l * 1280 + (ss ? 256 : 0)) * 64;
        const float* w3 = P.in[23] + (size_t)l * 64 * 4096;
        float wf[64], wb[64];
#pragma unroll
        for (int j = 0; j < 64; ++j) { wf[j] = w3[(size_t)j * 4096 + (o * 2 + 0) * 1024 + c]; wb[j] = w3[(size_t)j * 4096 + (o * 2 + 1) * 1024 + c]; }
        const float st = (float)c / 1023.f;
        const float delta = fabsf(-3.0701134573253943f * (1.f - st) + -15.350567286626972f * st);
        float asum = 0.f;
        for (int p = ps; p < L; p += 32) {
            const float* hp = h2 + (size_t)p * 64;
            float af = 0.f, ab = 0.f;
#pragma unroll
            for (int j4 = 0; j4 < 16; ++j4) { const f4 hv = *(const f4*)(hp + j4 * 4);
#pragma unroll
                for (int e = 0; e < 4; ++e) { af += hv[e] * wf[j4 * 4 + e]; ab += hv[e] * wb[j4 * 4 + e]; } }
            const float t = (float)p / (float)(L - 1);
            const float dec = expf(-t * delta);
            af *= dec; ab *= dec;
            asum += fabsf(af) + fabsf(ab);
            buf[cl * RS + (L - 1 - p)] = af;
            if (p > 0) buf[cl * RS + (L - 1 + p)] = ab;
        }
        red[ps * 16 + cl] = asum;
        __syncthreads();
        if (tid < 16) { float tot = 0.f;
#pragma unroll
            for (int g = 0; g < 32; ++g) tot += red[g * 16 + tid];
            invs[tid] = 1.f / tot; }
        __syncthreads();
        bf16_t* gr = (bf16_t*)(P.ws + WS_FILTB) + (size_t)l * FILTB_PER + (ss ? FILTB_CTX : 0) + ((size_t)o * 1024 + cgp * 16) * GRL;
        const int half = GRL / 2;
        for (int idx = tid; idx < 16 * half; idx += NT) {
            const int cc = idx / half, x = (idx % half) * 2;
            const float iv = invs[cc];
            const float v0 = x < 2 * L - 1 ? buf[cc * RS + x] * iv : 0.f, v1 = x + 1 < 2 * L - 1 ? buf[cc * RS + x + 1] * iv : 0.f;
            *(unsigned*)(gr + (size_t)cc * GRL + x) = pk2(v0, v1);
        }
        __syncthreads();
    }
}

__device__ __forceinline__ float2 bfx2(unsigned u) { return make_float2(__uint_as_float(u << 16), __uint_as_float(u & 0xffff0000u)); }
template <bool LAT>
__device__ __forceinline__ void convprep_item(CParams& P, int l, bf16_t* tile, int ct2, int m0, int lane, int wave) {
    const bf16_t* proj = (const bf16_t*)(P.ws + WS_PROJ);
    float* RW = (float*)(P.ws + WS_RW);
    const float* cw = P.in[8] + (size_t)l * 9 * 6144;
    const int c = ct2 * 128 + 2 * lane;
    float2 wgt[9];
#pragma unroll
    for (int q = 0; q < 9; ++q) wgt[q] = *(const float2*)(cw + q * 6144 + c);
    const unsigned* pc = (const unsigned*)(proj + (size_t)m0 * 6144 + c);
    const int row0 = LAT ? (((m0 - 4096) & 1023) >> 6) : 0;
#pragma unroll 1
    for (int hv = 0; hv < 2; ++hv) {
        constexpr int NO = 16;
        float2 y[NO];
#define CP_TOK(i) (LAT ? ((2 * hv + ((i) >> 3)) * 64 + wave * 8 + ((i) & 7)) : (wave * 32 + hv * 16 + (i)))
        if (LAT) {
            unsigned u[4][10];
#pragma unroll
            for (int ry = 0; ry < 4; ++ry) {
                const int rl = 2 * hv + ry - 1;
                const int rr = row0 + rl; const bool rok = rr >= 0 && rr <= 15;
#pragma unroll
                for (int xx = 0; xx < 10; ++xx) { const int cc = wave * 8 + xx - 1; const bool ok = rok && cc >= 0 && cc <= 63;
                    u[ry][xx] = ok ? pc[(ptrdiff_t)(rl * 64 + cc) * 3072] : 0u; }
            }
#pragma unroll
            for (int ry = 0; ry < 2; ++ry)
#pragma unroll
                for (int i = 0; i < 8; ++i) {
                    float2 a = make_float2(0.f, 0.f);
#pragma unroll
                    for (int dy = 0; dy < 3; ++dy)
#pragma unroll
                        for (int dx = 0; dx < 3; ++dx) { const float2 uv = bfx2(u[ry + dy][i + dx]); a.x += uv.x * wgt[dy * 3 + dx].x; a.y += uv.y * wgt[dy * 3 + dx].y; }
                    y[ry * 8 + i] = a;
                }
        } else {
            unsigned u[18];
#pragma unroll
            for (int xx = 0; xx < 18; ++xx) { const int pp = wave * 32 + hv * 16 + xx - 1; const bool ok = pp >= 0 && pp <= 255; u[xx] = ok ? pc[(ptrdiff_t)pp * 3072] : 0u; }
#pragma unroll
            for (int i = 0; i < 16; ++i) {
                float2 a = make_float2(0.f, 0.f);
#pragma unroll
                for (int dx = 0; dx < 3; ++dx) { const float2 uv = bfx2(u[i + dx]); a.x += uv.x * wgt[3 + dx].x; a.y += uv.y * wgt[3 + dx].y; }
                y[i] = a;
            }
        }
        if (ct2 < 24) {
            const int arr = ct2 >> 3; const int cc = (ct2 & 7) * 128 + 2 * lane;
            float* dst = RW + (size_t)arr * AS + (size_t)m0 * 1024 + cc;
#pragma unroll
            for (int i = 0; i < NO; ++i) *(float2*)(dst + (size_t)CP_TOK(i) * 1024) = y[i];
            if (arr == 1) {
                const float2 kkw = *(const float2*)(P.in[14] + l * 1024 + cc);
                float* dk = RW + (size_t)3 * AS + (size_t)m0 * 1024 + cc;
#pragma unroll
                for (int i = 0; i < NO; ++i) { const float k0 = y[i].x * kkw.x, k1 = y[i].y * kkw.y; float ssq = k0 * k0 + k1 * k1;
#pragma unroll
                    for (int sh = 1; sh < 32; sh <<= 1) ssq += __shfl_xor(ssq, sh);
                    const float rs = rsqrtf(ssq + 1e-12f);
                    *(float2*)(dk + (size_t)CP_TOK(i) * 1024) = make_float2(k0 * rs, k1 * rs); }
            }
        } else {
#pragma unroll
            for (int i = 0; i < NO; ++i) { tile[(2 * lane) * 264 + CP_TOK(i)] = f2bf(y[i].x); tile[(2 * lane + 1) * 264 + CP_TOK(i)] = f2bf(y[i].y); }
        }
#undef CP_TOK
    }
}
__device__ __forceinline__ void ph_convprep(CParams& P, int l, float* lds) {
    const int tid = tid_l(), lane = tid & 63, wave = tid >> 6;
    bf16_t* tile = (bf16_t*)lds;
    bf16_t* HT = (bf16_t*)(P.ws + WS_HT);
    for (int item = blockIdx.x; item < 32 * 48; item += gridDim.x) {
        const int ct2 = item % 48, tt = item / 48;
        const int m0 = tt * 256;
        if (m0 >= 4096) convprep_item<true>(P, l, tile, ct2, m0, lane, wave);
        else convprep_item<false>(P, l, tile, ct2, m0, lane, wave);
        if (ct2 >= 24) {
            __syncthreads();
            const int which = (ct2 - 24) >> 3; const int cbase = ((ct2 - 24) & 7) * 128;
#pragma unroll
            for (int i = 0; i < 16; ++i) { const int ch = wave * 16 + i;
                *(uint2*)(HT + ((size_t)which * 1024 + cbase + ch) * M + m0 + lane * 4) = *(const uint2*)(tile + ch * 264 + lane * 4); }
            __syncthreads();
        }
    }
}

typedef float f32x16 __attribute__((ext_vector_type(16)));
typedef short s16x8 __attribute__((ext_vector_type(8)));
typedef short s16x4 __attribute__((ext_vector_type(4)));
typedef unsigned u32x4_t __attribute__((ext_vector_type(4)));
#define MFMA16(a, b, c) __builtin_amdgcn_mfma_f32_16x16x32_bf16((a), (b), (c), 0, 0, 0)
__device__ __forceinline__ s16x8 mk8(unsigned a, unsigned b, unsigned c, unsigned d) { u32x4_t v = {a, b, c, d}; return __builtin_bit_cast(s16x8, v); }
__device__ __forceinline__ s16x8 pack_lo(f4 x) { return mk8(pk2(x[0], x[1]), pk2(x[2], x[3]), 0u, 0u); }
__device__ __forceinline__ s16x8 pack_2(f4 lo, f4 hi) { return mk8(pk2(lo[0], lo[1]), pk2(lo[2], lo[3]), pk2(hi[0], hi[1]), pk2(hi[2], hi[3])); }
constexpr int SC_KQ = 0, SC_RQ = 2304, SC_KD = 4608, SC_BD = 6912, SC_KDCT = 9216, SC_NBDCT = 11264, SC_VT = 13312, SC_GC = 15360, SC_BUF = 15616;

__device__ __forceinline__ void chain_chunk(const unsigned char* buf, f4 (&H)[4][4], float* gO, int mrow0, int mstep, int lane) {
    const int r = lane & 15, g = lane >> 4;
    const f4 z = (f4){0.f, 0.f, 0.f, 0.f};
    const unsigned char* rb = buf + r * 144 + g * 16;
    const s16x8 fKq0 = *(const s16x8*)(rb + SC_KQ), fKq1 = *(const s16x8*)(rb + SC_KQ + 64);
    const s16x8 fRq0 = *(const s16x8*)(rb + SC_RQ), fRq1 = *(const s16x8*)(rb + SC_RQ + 64);
    const s16x8 fKd0 = *(const s16x8*)(rb + SC_KD), fKd1 = *(const s16x8*)(rb + SC_KD + 64);
    const s16x8 fBd0 = *(const s16x8*)(rb + SC_BD), fBd1 = *(const s16x8*)(rb + SC_BD + 64);
    f4 Xd = MFMA16(fKq1, fBd1, MFMA16(fKq0, fBd0, z));
    f4 XTd = MFMA16(fBd1, fKq1, MFMA16(fBd0, fKq0, z));
    f4 MkkT = MFMA16(fKd1, fKq1, MFMA16(fKd0, fKq0, z));
    f4 MrkT = MFMA16(fKd1, fRq1, MFMA16(fKd0, fRq0, z));
    f4 MrbT = MFMA16(fBd1, fRq1, MFMA16(fBd0, fRq0, z));
    f4 eye;
#pragma unroll
    for (int q = 0; q < 4; ++q) { const int ri = 4 * g + q;
        Xd[q] = ri > r ? -Xd[q] : 0.f; XTd[q] = ri < r ? -XTd[q] : 0.f; MkkT[q] = ri < r ? MkkT[q] : 0.f;
        MrkT[q] = ri <= r ? MrkT[q] : 0.f; MrbT[q] = ri <= r ? -MrbT[q] : 0.f; eye[q] = ri == r ? 1.f : 0.f; }
    const s16x8 pX = pack_lo(Xd), pXT = pack_lo(XTd);
    const f4 X2d = MFMA16(pXT, pX, z), X2Td = MFMA16(pX, pXT, z);
    const s16x8 pX2 = pack_lo(X2d), pX2T = pack_lo(X2Td);
    const f4 X4d = MFMA16(pX2T, pX2, z), X4Td = MFMA16(pX2, pX2T, z);
    const f4 X8d = MFMA16(pack_lo(X4Td), pack_lo(X4d), z);
    const f4 U1T = MFMA16(pack_lo(X2d + eye), pack_lo(XTd + eye), z);
    const f4 U2T = MFMA16(pack_lo(X4d + eye), pack_lo(U1T), z);
    const f4 TT = MFMA16(pack_lo(X8d + eye), pack_lo(U2T), z);
    const s16x8 fTT = pack_lo(TT), fMkkT = pack_lo(MkkT), fOrb = pack_2(MrkT, MrbT);
    const unsigned char* pb = buf + r * 144 + g * 8;
    const uint2 k0l = *(const uint2*)(pb + SC_KQ), k0h = *(const uint2*)(pb + SC_KQ + 32), k1l = *(const uint2*)(pb + SC_KQ + 64), k1h = *(const uint2*)(pb + SC_KQ + 96);
    const uint2 r0l = *(const uint2*)(pb + SC_RQ), r0h = *(const uint2*)(pb + SC_RQ + 32), r1l = *(const uint2*)(pb + SC_RQ + 64), r1h = *(const uint2*)(pb + SC_RQ + 96);
    const s16x8 aK0 = mk8(k0l.x, k0l.y, k0h.x, k0h.y), aK1 = mk8(k1l.x, k1l.y, k1h.x, k1h.y);
    const s16x8 aR0 = mk8(r0l.x, r0l.y, r0h.x, r0h.y), aR1 = mk8(r1l.x, r1l.y, r1h.x, r1h.y);
#pragma unroll
    for (int vt = 0; vt < 4; ++vt) {
        const s16x8 h0 = pack_2(H[0][vt], H[1][vt]), h1 = pack_2(H[2][vt], H[3][vt]);
        f4 P0 = MFMA16(aK1, h1, MFMA16(aK0, h0, z));
        f4 O = MFMA16(aR1, h1, MFMA16(aR0, h0, z));
        const uint2 vv = *(const uint2*)(buf + SC_VT + (16 * vt + r) * 32 + g * 8);
        P0 = MFMA16(fMkkT, mk8(vv.x, vv.y, 0u, 0u), P0);
        const f4 Pm = MFMA16(fTT, pack_lo(P0), z);
        const s16x8 fB = mk8(vv.x, vv.y, pk2(Pm[0], Pm[1]), pk2(Pm[2], Pm[3]));
        O = MFMA16(fOrb, fB, O);
#pragma unroll
        for (int q = 0; q < 4; ++q) gO[(ptrdiff_t)(mrow0 + mstep * (4 * g + q)) * 1024 + 16 * vt + r] = O[q];
#pragma unroll
        for (int kt = 0; kt < 4; ++kt) {
            const unsigned char* pk = buf + SC_KDCT + (16 * kt + r) * 32 + g * 8;
            const uint2 al = *(const uint2*)pk, ah = *(const uint2*)(pk + 2048);
            const f4 gc = *(const f4*)(buf + SC_GC + (16 * kt + 4 * g) * 4);
            H[kt][vt] = MFMA16(mk8(al.x, al.y, ah.x, ah.y), fB, H[kt][vt] * gc);
        }
    }
}
typedef float f32x8 __attribute__((ext_vector_type(8)));
struct RawH { f32x16 w; f32x8 r, k, v, kk, a; };
__device__ __forceinline__ void prep_load(RawH& R, const float* RW, int d, int hf, int mrow0, int mstep, unsigned colx) {
    const float* wb = RW + (size_t)(4 + d) * AS;
#pragma unroll
    for (int t = 0; t < 16; ++t) { const float* rp = wb + (size_t)(unsigned)(mrow0 + mstep * t) * 1024; R.w[t] = rp[colx]; }
    const float* ab = RW + (size_t)(6 + d) * AS;
#pragma unroll
    for (int j = 0; j < 8; ++j) { const size_t ro = (size_t)(unsigned)(mrow0 + mstep * (8 * hf + j)) * 1024;
        const float* p0 = RW + ro; const float* p1 = RW + AS + ro; const float* p2 = RW + 2 * AS + ro; const float* p3 = RW + 3 * AS + ro; const float* p4 = ab + ro;
        R.r[j] = p0[colx]; R.k[j] = p1[colx]; R.v[j] = p2[colx]; R.kk[j] = p3[colx]; R.a[j] = p4[colx]; }
}
__device__ __forceinline__ void prep_proc(const RawH& R, unsigned char* buf, int hf, float ka, int lane) {
    float G = 1.f;
    if (hf) {
#pragma unroll
        for (int t = 0; t < 8; ++t) G *= R.w[t]; }
    float GC = 1.f;
#pragma unroll
    for (int t = 0; t < 16; ++t) GC *= R.w[t];
    f32x8 kdi, bdi;
#pragma unroll
    for (int j = 0; j < 8; ++j) {
        const int t = 8 * hf + j;
        *(bf16_t*)(buf + SC_KQ + t * 144 + lane * 2) = (bf16_t)pk2(R.kk[j] * G, 0.f);
        G *= hf ? R.w[8 + j] : R.w[j];
        *(bf16_t*)(buf + SC_RQ + t * 144 + lane * 2) = (bf16_t)pk2(R.r[j] * G, 0.f);
        const float iG = __builtin_amdgcn_rcpf(G);
        const float kd = R.k[j] * (1.f + (R.a[j] - 1.f) * ka), bb = R.kk[j] * R.a[j];
        kdi[j] = kd * iG; bdi[j] = bb * iG;
        *(bf16_t*)(buf + SC_KD + t * 144 + lane * 2) = (bf16_t)pk2(kdi[j], 0.f);
        *(bf16_t*)(buf + SC_BD + t * 144 + lane * 2) = (bf16_t)pk2(bdi[j], 0.f);
    }
    uint4 o1, o2, o3;
    o1.x = pk2(kdi[0] * GC, kdi[1] * GC); o1.y = pk2(kdi[2] * GC, kdi[3] * GC); o1.z = pk2(kdi[4] * GC, kdi[5] * GC); o1.w = pk2(kdi[6] * GC, kdi[7] * GC);
    o2.x = pk2(-bdi[0] * GC, -bdi[1] * GC); o2.y = pk2(-bdi[2] * GC, -bdi[3] * GC); o2.z = pk2(-bdi[4] * GC, -bdi[5] * GC); o2.w = pk2(-bdi[6] * GC, -bdi[7] * GC);
    o3.x = pk2(R.v[0], R.v[1]); o3.y = pk2(R.v[2], R.v[3]); o3.z = pk2(R.v[4], R.v[5]); o3.w = pk2(R.v[6], R.v[7]);
    *(uint4*)(buf + SC_KDCT + lane * 32 + hf * 16) = o1;
    *(uint4*)(buf + SC_NBDCT + lane * 32 + hf * 16) = o2;
    *(uint4*)(buf + SC_VT + lane * 32 + hf * 16) = o3;
    if (hf) *(float*)(buf + SC_GC + lane * 4) = GC;
}
__device__ __forceinline__ void lds_barrier() { asm volatile("s_waitcnt lgkmcnt(0)" ::: "memory"); __builtin_amdgcn_s_barrier(); asm volatile("" ::: "memory"); }
__device__ __forceinline__ void scan_item(CParams& P, int l, float* ldsf, int type, int b, int h) {
    unsigned char* lds = (unsigned char*)ldsf;
    const int tid = tid_l(), lane = tid & 63, wave = __builtin_amdgcn_readfirstlane(tid >> 6);
    const int L = type ? 256 : 1024, NCH = L / 16; const int mbase = type ? b * 256 : 4096 + b * 1024;
    if (wave < 2) {
        const int d = wave; const int mstep = d ? -1 : 1; const int mfirst = mbase + (d ? L - 1 : 0);
        const unsigned char* cbuf = lds + d * 2 * SC_BUF;
        float* gO = (float*)(P.ws + WS_PROJ) + (size_t)d * AS + h * 64;
        const int r = lane & 15, g = lane >> 4;
        f4 H[4][4];
        if (type == 0) { const float* s0 = P.in[3] + ((((size_t)b * 2 + l) * 2 + d) * 16 + h) * 4096;
#pragma unroll
            for (int kt = 0; kt < 4; ++kt)
#pragma unroll
                for (int vt = 0; vt < 4; ++vt) H[kt][vt] = *(const f4*)(s0 + (16 * vt + r) * 64 + 16 * kt + 4 * g); }
        else {
#pragma unroll
            for (int kt = 0; kt < 4; ++kt)
#pragma unroll
                for (int vt = 0; vt < 4; ++vt) H[kt][vt] = (f4){0.f, 0.f, 0.f, 0.f}; }
        lds_barrier();
        for (int c = 0; c < NCH; ++c) {
            chain_chunk(cbuf + (c & 1) * SC_BUF, H, gO, mfirst + mstep * 16 * c, mstep, lane);
            lds_barrier();
        }
        if (type == 1) { float* so = P.out + OUT_STATE + ((((size_t)b * 2 + l) * 2 + d) * 16 + h) * 4096;
#pragma unroll
            for (int kt = 0; kt < 4; ++kt)
#pragma unroll
                for (int vt = 0; vt < 4; ++vt) *(f4*)(so + (16 * vt + r) * 64 + 16 * kt + 4 * g) = H[kt][vt]; }
    } else if (wave != 4 && wave != 5) {
        const int d = wave & 1, hf = wave >> 2; const int mstep = d ? -1 : 1; const int mfirst = mbase + (d ? L - 1 : 0);
        unsigned char* cbuf = lds + d * 2 * SC_BUF;
        const float* RW = (const float*)(P.ws + WS_RW);
        const unsigned colx = (unsigned)(h * 64 + lane);
        const float ka = P.in[15][l * 1024 + colx];
        RawH RA, RB;
        prep_load(RA, RW, d, hf, mfirst, mstep, colx);
        for (int c = 0; c < NCH; c += 2) {
            prep_load(RB, RW, d, hf, mfirst + mstep * 16 * (c + 1), mstep, colx);
            prep_proc(RA, cbuf, hf, ka, lane);
            lds_barrier();
            if (c + 2 < NCH) prep_load(RA, RW, d, hf, mfirst + mstep * 16 * (c + 2), mstep, colx);
            prep_proc(RB, cbuf + SC_BUF, hf, ka, lane);
            lds_barrier();
        }
        lds_barrier();
    } else {
        for (int c = 0; c <= NCH; ++c) lds_barrier();
    }
}

template <int L>
__device__ __forceinline__ void hym_conv(const bf16_t* cps, const bf16_t* ubs, f32x16& acc) {
    constexpr int ND = (L == 1024) ? 39 : 15;
#pragma unroll 3
    for (int dd = 0; dd < ND; ++dd) {
#pragma unroll
        for (int kh = 0; kh < 2; ++kh) {
            const bf16_t* ap = cps - 32 * dd + 16 * kh; const bf16_t* bp = ubs - 32 * dd + 16 * kh;
            const s16x4 alo = *(const s16x4*)ap, ahi = *(const s16x4*)(ap + 4);
            const s16x8 av = __builtin_shufflevector(alo, ahi, 0, 1, 2, 3, 4, 5, 6, 7);
            const s16x8 bv = *(const s16x8*)bp;
            acc = __builtin_amdgcn_mfma_f32_32x32x16_bf16(av, bv, acc, 0, 0, 0);
        }
    }
}
template <int L>
__device__ __forceinline__ void hyena_item(CParams& P, int l, float* ldsf, int cp2) {
    constexpr bool LAT = (L == 1024); constexpr int NB = LAT ? 4 : 16; constexpr int GRL = 2 * L + 8; constexpr int ROWL = L + 448;
    bf16_t* sCP = (bf16_t*)ldsf;
    bf16_t* sU = sCP + 16 * GRL;
    bf16_t* sZ = sU + 2 * NB * ROWL;
    const int tid = tid_l(), lane = tid & 63, wave = tid >> 6;
    const int c0 = cp2 * 2; const int mbase = LAT ? 4096 : 0;
    bf16_t* HT = (bf16_t*)(P.ws + WS_HT);
    const bf16_t* filtb = (const bf16_t*)(P.ws + WS_FILTB) + (size_t)l * FILTB_PER + (LAT ? FILTB_CTX : 0);
    unsigned zz = 0u; asm volatile("" : "+v"(zz));
    for (int idx = tid; idx < 2 * NB * 56; idx += NT) { const int row = idx / 56, q = idx % 56;
        const int off = row * ROWL + (q < 28 ? q * 8 : 224 + L + (q - 28) * 8);
        *(uint4*)(sU + off) = make_uint4(zz, zz, zz, zz); *(uint4*)(sZ + off) = make_uint4(zz, zz, zz, zz); }
    for (int idx = tid; idx < 2 * 512; idx += NT) { const int ch = idx >> 9, q = idx & 511;
        const uint4 v = *(const uint4*)(HT + (size_t)(c0 + ch) * M + mbase + 8 * q);
        const int b = (8 * q) / L, t = (8 * q) % L; *(uint4*)(sU + (ch * NB + b) * ROWL + 224 + t) = v; }
    for (int idx = tid; idx < 16 * GRL; idx += NT) { const int y = idx % GRL, k = idx / GRL; const int sft = k & 3, o = (k >> 2) & 1, ch = k >> 3;
        const bf16_t* src = filtb + ((size_t)o * 1024 + c0 + ch) * GRL;
        sCP[idx] = (y + sft < GRL) ? src[y + sft] : (bf16_t)0; }
    __syncthreads();
    const int ch = wave >> 2, nt = wave & 3; const int c = c0 + ch;
    const int r = lane & 31, h = lane >> 5; const int Il = r >> 2, bl = r & 3;
    const int I = LAT ? 8 * nt + Il : Il; const int b = LAT ? bl : 4 * nt + bl;
    const int dlo = LAT ? 8 * nt - 31 : -7;
    const int X0 = L - 1 - (32 * dlo + r - 8 * h); const int sft = X0 & 3;
    const int urow = (ch * NB + b) * ROWL + 224;
    const int uoff = urow + 32 * (I - dlo) + 8 * h;
    f32x16 acc;
#pragma unroll
    for (int i = 0; i < 16; ++i) acc[i] = 0.f;
    hym_conv<L>(sCP + ((ch * 2 + 0) * 4 + sft) * GRL + (X0 - sft), sU + uoff, acc);
    const float bias1 = P.in[25][(l * 2 + 0) * 1024 + c], bias2 = P.in[25][(l * 2 + 1) * 1024 + c];
    const size_t gcol = (size_t)c * M + mbase + b * L + 32 * I + 4 * h;
    float z[16];
#pragma unroll
    for (int g4 = 0; g4 < 4; ++g4) {
        const int t0 = 32 * I + 8 * g4 + 4 * h;
        const uint2 xv = *(const uint2*)(HT + (size_t)1 * 1024 * M + gcol + 8 * g4);
        const uint2 uv = *(const uint2*)(sU + urow + t0);
        const float x1[4] = {__uint_as_float(xv.x << 16), __uint_as_float(xv.x & 0xffff0000u), __uint_as_float(xv.y << 16), __uint_as_float(xv.y & 0xffff0000u)};
        const float uu[4] = {__uint_as_float(uv.x << 16), __uint_as_float(uv.x & 0xffff0000u), __uint_as_float(uv.y << 16), __uint_as_float(uv.y & 0xffff0000u)};
#pragma unroll
        for (int e = 0; e < 4; ++e) z[4 * g4 + e] = x1[e] * (acc[4 * g4 + e] + bias1 * uu[e]);
        uint2 w; w.x = pk2(z[4 * g4], z[4 * g4 + 1]); w.y = pk2(z[4 * g4 + 2], z[4 * g4 + 3]);
        *(uint2*)(sZ + urow + t0) = w;
    }
    __syncthreads();
#pragma unroll
    for (int i = 0; i < 16; ++i) acc[i] = 0.f;
    hym_conv<L>(sCP + ((ch * 2 + 1) * 4 + sft) * GRL + (X0 - sft), sZ + uoff, acc);
#pragma unroll
    for (int g4 = 0; g4 < 4; ++g4) {
        const uint2 xv = *(const uint2*)(HT + (size_t)2 * 1024 * M + gcol + 8 * g4);
        const float x2[4] = {__uint_as_float(xv.x << 16), __uint_as_float(xv.x & 0xffff0000u), __uint_as_float(xv.y << 16), __uint_as_float(xv.y & 0xffff0000u)};
        float o4[4];
#pragma unroll
        for (int e = 0; e < 4; ++e) o4[e] = x2[e] * (acc[4 * g4 + e] + bias2 * z[4 * g4 + e]);
        uint2 w; w.x = pk2(o4[0], o4[1]); w.y = pk2(o4[2], o4[3]);
        *(uint2*)(HT + gcol + 8 * g4) = w;
    }
    __syncthreads();
}

__device__ __forceinline__ void ph_scan_hyena(CParams& P, int l, float* lds) {
    const int G = gridDim.x, bid = blockIdx.x;
    if (G < 128) {
        for (int j = bid; j < 1344; j += G) {
            if (j < 64) scan_item(P, l, lds, 0, j >> 4, j & 15);
            else if (j < 320) scan_item(P, l, lds, 1, (j - 64) >> 4, (j - 64) & 15);
            else if (j < 832) hyena_item<1024>(P, l, lds, j - 320);
            else hyena_item<256>(P, l, lds, j - 832);
        }
        return;
    }
    if (bid < 64) { scan_item(P, l, lds, 0, bid >> 4, bid & 15); return; }
    const int vb = bid - 64, nb = G - 64;
    for (int j = vb; j < 256 + 1024; j += nb) {
        if (j < 256) scan_item(P, l, lds, 1, j >> 4, j & 15);
        else if (j < 768) hyena_item<1024>(P, l, lds, j - 256);
        else hyena_item<256>(P, l, lds, j - 768);
    }
}

__device__ __forceinline__ void ph_combine(CParams& P, int l, float* lds) {
    const int lane = tid_l() & 63, wave = tid_l() >> 6;
    const int gw = blockIdx.x * 8 + wave, ngw = gridDim.x * 8;
    const float* RW = (const float*)(P.ws + WS_RW);
    const float* O = (const float*)(P.ws + WS_PROJ);
    bf16_t* mix = (bf16_t*)(P.ws + WS_MIX);
    for (int m = gw; m < M; m += ngw) {
        const size_t rowo = (size_t)m * 1024 + lane * 4;
#pragma unroll
        for (int qi = 0; qi < 4; ++qi) {
            const size_t idx = rowo + qi * 256; const int cc = qi * 256 + lane * 4;
            const f4 o0 = *(const f4*)(O + idx), o1 = *(const f4*)(O + AS + idx);
            const f4 r = *(const f4*)(RW + idx), k = *(const f4*)(RW + AS + idx), v = *(const f4*)(RW + 2 * AS + idx);
            const f4 a0 = *(const f4*)(RW + 6 * AS + idx), a1 = *(const f4*)(RW + 7 * AS + idx), g = *(const f4*)(RW + 8 * AS + idx);
            const f4 lg = *(const f4*)(P.in[17] + l * 1024 + cc), lb = *(const f4*)(P.in[18] + l * 1024 + cc);
            const f4 ka = *(const f4*)(P.in[15] + l * 1024 + cc), rk = *(const f4*)(P.in[16] + l * 1024 + cc);
            const f4 o = o0 + o1;
            const f4 kds = k * ((a0 + a1 - 2.f) * ka + 2.f);
            const f4 pb = r * kds * rk;
            float s1 = (o[0] + o[1]) + (o[2] + o[3]);
            float s2 = (o[0] * o[0] + o[1] * o[1]) + (o[2] * o[2] + o[3] * o[3]);
            float s3 = (pb[0] + pb[1]) + (pb[2] + pb[3]);
#pragma unroll
            for (int sh = 1; sh < 16; sh <<= 1) { s1 += __shfl_xor(s1, sh); s2 += __shfl_xor(s2, sh); s3 += __shfl_xor(s3, sh); }
            const float mu = s1 * (1.f / 64.f); const float var = fmaxf(s2 * (1.f / 64.f) - mu * mu, 0.f);
            const float rs = rsqrtf(var + GN_EPS);
            const f4 res = ((o - mu) * rs * lg + lb + v * s3) * g;
            uint2 w; w.x = pk2(res[0], res[1]); w.y = pk2(res[2], res[3]);
            *(uint2*)(mix + (size_t)m * 2048 + cc) = w;
        }
    }
    bf16_t* tile = (bf16_t*)lds;
    const bf16_t* HT = (const bf16_t*)(P.ws + WS_HT);
    for (int item = blockIdx.x; item < 16 * 128; item += gridDim.x) {
        const int c0 = (item & 15) * 64, m0 = (item >> 4) * 64;
#pragma unroll
        for (int i = 0; i < 8; ++i) { const int ci = wave * 8 + i; tile[ci * 66 + lane] = HT[(size_t)(c0 + ci) * M + m0 + lane]; }
        __syncthreads();
#pragma unroll
        for (int i = 0; i < 8; ++i) { const int mi = wave * 8 + i; mix[(size_t)(m0 + mi) * 2048 + 1024 + c0 + lane] = tile[lane * 66 + mi]; }
        __syncthreads();
    }
}

#define XB_TMO      128
#define XB_XCNT(j)  (256  + 64 * (j))
#define XB_XSUB(j)  (1280 + 64 * (j))
#define XB_XGEN(j)  (2304 + 64 * (j))
#define XB_TOP      3328
#define XB_TOPGEN   3392
#define XCD_BAR_WORDS 3456
#define XB_SPIN_CAP (1u << 18)
#define LAS __attribute__((address_space(3)))

__device__ __forceinline__ unsigned xb_ld(unsigned* p)              { return __hip_atomic_load(p, __ATOMIC_RELAXED, __HIP_MEMORY_SCOPE_AGENT); }
__device__ __forceinline__ unsigned xb_add(unsigned* p, unsigned v) { return __hip_atomic_fetch_add(p, v, __ATOMIC_RELAXED, __HIP_MEMORY_SCOPE_AGENT); }
__device__ __forceinline__ unsigned xb_xcc_id() { return (unsigned)__builtin_amdgcn_s_getreg((3 << 11) | 20) & 0xFu; }
#define XB_SPIN(cond, bar) do { unsigned _sp = 0; while (cond) { __builtin_amdgcn_s_sleep(1); \
    if ((++_sp & 255u) == 0u) { if (xb_ld(&(bar)[XB_TMO])) break; if (_sp > XB_SPIN_CAP) { atomicAdd(&(bar)[XB_TMO], 1u); break; } } } } while (0)

struct XcdBarrier {
    unsigned* bar; unsigned x;
    volatile LAS unsigned* st;
};

__device__ __forceinline__ XcdBarrier xcd_barrier_post(unsigned* bar, volatile LAS unsigned* st) {
    XcdBarrier b; b.bar = bar; b.x = xb_xcc_id(); b.st = st;
    if (threadIdx.x == 0) (void)xb_add(&bar[XB_XCNT(b.x)], 1u);
    return b;
}
__device__ __forceinline__ void xcd_barrier_complete(unsigned* bar, unsigned x, unsigned& nloc, unsigned& nx) {
    const unsigned G = gridDim.x * gridDim.y * gridDim.z;
    unsigned sum, cnt, mine, sp = 0u;
    for (;;) {
        sum = 0u; cnt = 0u; mine = 0u;
#pragma unroll
        for (unsigned j = 0; j < 16; ++j) { const unsigned c = xb_ld(&bar[XB_XCNT(j)]); sum += c; cnt += (c > 0u) ? 1u : 0u; mine = (j == x) ? c : mine; }
        if (sum == G) break;
        __builtin_amdgcn_s_sleep(1);
        if ((++sp & 255u) == 0u) { if (xb_ld(&bar[XB_TMO])) break; if (sp > XB_SPIN_CAP) { atomicAdd(&bar[XB_TMO], 1u); break; } }
    }
    nloc = mine > 0u ? mine : 1u; nx = cnt > 0u ? cnt : 1u;
}

__device__ __forceinline__ void xcd_barrier(const XcdBarrier& b) {
    asm volatile("s_waitcnt vmcnt(0)" ::: "memory");
    __syncthreads();
    if (threadIdx.x == 0) {
        unsigned* bar = b.bar;
        __builtin_amdgcn_s_waitcnt(0);
        unsigned nloc = b.st[0], nx = b.st[1];
        if (nloc == 0u) { xcd_barrier_complete(bar, b.x, nloc, nx); b.st[0] = nloc; b.st[1] = nx; }
        const unsigned old = xb_add(&bar[XB_XSUB(b.x)], 1u);
        const unsigned gen = old / nloc;
        if (old + 1u == (gen + 1u) * nloc) {
            __builtin_amdgcn_fence(__ATOMIC_RELEASE, "agent");
            asm volatile("s_waitcnt vmcnt(0)" ::: "memory");
            const unsigned og = xb_add(&bar[XB_TOP], 1u);
            const unsigned tg = og / nx;
            if (og + 1u == (tg + 1u) * nx) xb_add(&bar[XB_TOPGEN], 1u);
            else XB_SPIN(xb_ld(&bar[XB_TOPGEN]) == tg, bar);
            __builtin_amdgcn_fence(__ATOMIC_ACQUIRE, "agent");
            xb_add(&bar[XB_XGEN(b.x)], 1u);
            asm volatile("s_waitcnt vmcnt(0)" ::: "memory");
        } else {
            XB_SPIN(xb_ld(&bar[XB_XGEN(b.x)]) == gen, bar);
            __builtin_amdgcn_fence(__ATOMIC_ACQUIRE, "agent");
            asm volatile("s_waitcnt vmcnt(0)" ::: "memory");
        }
    }
    __syncthreads();
}


constexpr int NPH = 2 + 9 * DEPTH;
#ifndef PHM
#define PHM 1023
#endif
#ifndef DUPM
#define DUPM 0
#endif
#ifndef XSYNC
#define XSYNC 0
#endif
__device__ __forceinline__ XcdBarrier make_bar(unsigned char* lds_raw) {
    CParams* kp = (CParams*)__builtin_amdgcn_kernarg_segment_ptr(); asm volatile("" : "+s"(kp));
    XcdBarrier b; b.bar = (unsigned*)kp->ws; b.x = xb_xcc_id(); b.st = (volatile LAS unsigned*)(lds_raw + (LDS_BYTES - 16)); return b;
}
__global__ void __launch_bounds__(NT, 2) mega(Params Pv) {
    extern __shared__ __attribute__((aligned(16))) unsigned char lds_raw[];
    { volatile LAS unsigned* xst = (volatile LAS unsigned*)(lds_raw + (LDS_BYTES - 16));
      if (threadIdx.x == 0) { xst[0] = 0u; xst[1] = 0u; }
      __syncthreads();
      (void)xcd_barrier_post((unsigned*)Pv.ws, xst); }
#pragma unroll 1
    for (int ph = 0; ph < NPH; ++ph) {
#if DUPM
        const int nrep = (ph >= 2 && ((DUPM >> ((ph - 2) % 9)) & 1)) ? 2 : ((ph < 2 && ((DUPM >> (10 + ph)) & 1)) ? 2 : 1);
        for (int rep = 0; rep < nrep; ++rep) {
#else
        {
#endif
        CParams* kp = (CParams*)__builtin_amdgcn_kernarg_segment_ptr(); asm volatile("" : "+s"(kp));
        CParams& P = *kp;
        float* ldsf = (float*)lds_raw;
        PG8_LAS unsigned char* ldsg = (PG8_LAS unsigned char*)lds_raw;
        const int G = gridDim.x, bid = blockIdx.x;
        if (ph == 0 && (PHM & 1)) { ph_mod(P, ldsf); ph_filt_hidden(P); __syncthreads(); ph_convert(P, 0, ldsf); }
        else if (ph == 1 && (PHM & 2)) { ph_rowpass(P, 0, 0); ph_filt_final(P, ldsf); }
        else {
            const int l = (ph - 2) / 9, s = (ph - 2) % 9;
            const float* mod = (const float*)(P.ws + WS_MOD);
            if (s == 0 && (PHM & 4)) {
                pg8::Gemm g{(const bf16_t*)(P.ws + WS_H), (const bf16_t*)(P.ws + WS_WIN), M, NPAD, D}; pg8::StaticOrder S; S.init(M, NPAD, G, bid);
                pg8::EpiProj E{(bf16_t*)(P.ws + WS_PROJ), (bf16_t*)(P.ws + WS_LACT)};
                pg8::gemm_phase<pg8::EpiProj, pg8::StaticOrder, true, true>(ldsg, g, S, E);
            } else if (s == 1 && (PHM & 8)) {
                pg8::Gemm g{(const bf16_t*)(P.ws + WS_LACT), (const bf16_t*)(P.ws + WS_WL), M, NL, KL}; pg8::StaticOrder S; S.init(M, NL, G, bid);
                pg8::EpiLora E{(float*)(P.ws + WS_RW) + 4 * AS, AS, P.in[10] + l * 2048, P.in[12] + l * 2048};
                pg8::gemm_phase<pg8::EpiLora, pg8::StaticOrder, true, true>(ldsg, g, S, E);
                __syncthreads();
                ph_convprep(P, l, ldsf);
            } else if (s == 2 && (PHM & 16)) { ph_scan_hyena(P, l, ldsf); }
            else if (s == 3 && (PHM & 32)) { ph_combine(P, l, ldsf); }
            else if ((s == 4 || s == 7) && (PHM & 64)) {
                pg8::Gemm g{(const bf16_t*)(P.ws + (s == 4 ? WS_MIX : WS_PROJ)), (const bf16_t*)(P.ws + (s == 4 ? WS_WOUT : WS_W2)), M, D, s == 4 ? D : DFF}; pg8::StaticOrder S; S.init(M, D, G, bid);
                pg8::EpiRes E{P.out, mod + (size_t)l * 5 * 12288 + (s == 4 ? 2 : 5) * 2048, ALPHA};
                pg8::gemm_phase<pg8::EpiRes, pg8::StaticOrder, true, true>(ldsg, g, S, E);
            } else if (s == 5 && (PHM & 128)) { ph_rowpass(P, 1, l); }
            else if (s == 6 && (PHM & 256)) {
                pg8::Gemm g{(const bf16_t*)(P.ws + WS_H), (const bf16_t*)(P.ws + WS_W1), M, DFF, D}; pg8::StaticOrder S; S.init(M, DFF, G, bid);
                pg8::EpiRelu2 E{(bf16_t*)(P.ws + WS_PROJ), DFF};
                pg8::gemm_phase<pg8::EpiRelu2, pg8::StaticOrder, true, true>(ldsg, g, S, E);
            } else if (PHM & 512) { ph_rowpass(P, 2, l); if (l + 1 < DEPTH) ph_convert(P, l + 1, ldsf); }
        }
#if DUPM
        if (ph + 1 < NPH || rep + 1 < nrep) { if (ph == 0 && rep == 0) cg::this_grid().sync(); else xcd_barrier(make_bar(lds_raw)); }
#else
        if (ph + 1 < NPH) { if (ph == 0) cg::this_grid().sync(); else xcd_barrier(make_bar(lds_raw)); }
#endif
        if (ph == 1) for (int xs = 0; xs < XSYNC; ++xs) xcd_barrier(make_bar(lds_raw));
        }
    }
}

#ifndef MK_MULTI
#define MK_MULTI 0
#endif
extern "C" void kernel_launch(void* const* d_in, const int* in_sizes, int n_in, void* d_out, int out_size, void* d_ws, size_t ws_size, hipStream_t stream) {
    static int grid = 0;
    if (grid == 0) {
        int dev = 0, cus = 0, per_cu = 0;
        if (n_in != 33 || ws_size < WS_END) { fprintf(stderr, "kernel_launch: unexpected n_in %d or ws_size %zu (< %zu)\n", n_in, ws_size, (size_t)WS_END); grid = -1; return; }
        hipGetDevice(&dev);
        hipDeviceGetAttribute(&cus, hipDeviceAttributeMultiprocessorCount, dev);
        if (hipFuncSetAttribute((const void*)mega, hipFuncAttributeMaxDynamicSharedMemorySize, LDS_BYTES) != hipSuccess) { fprintf(stderr, "hipFuncSetAttribute failed\n"); grid = -1; return; }
        if (hipOccupancyMaxActiveBlocksPerMultiprocessor(&per_cu, (const void*)mega, NT, LDS_BYTES) != hipSuccess || per_cu < 1) { fprintf(stderr, "occupancy query failed (%d)\n", per_cu); grid = -1; return; }
        grid = cus;
    }
    if (grid < 0) return;
    Params p{};
    for (int i = 0; i < 33; ++i) p.in[i] = (const float*)d_in[i];
    p.out = (float*)d_out; p.ws = (unsigned char*)d_ws;
    if (hipMemsetAsync(d_ws, 0, 16384, stream) != hipSuccess) { fprintf(stderr, "memset failed\n"); return; }
    p.ph_lo = 0; p.ph_hi = NPH;
    void* args[] = {&p};
    hipError_t e = hipLaunchCooperativeKernel((const void*)mega, dim3(grid), dim3(NT), args, LDS_BYTES, stream);
    if (e != hipSuccess) fprintf(stderr, "cooperative launch failed: %s (grid %d)\n", hipGetErrorString(e), grid);
}
```

```cpp
#include <hip/hip_runtime.h>
#include <hip/hip_cooperative_groups.h>
#include <cstdio>
#include <cstdint>
namespace cg = cooperative_groups;

namespace pg8 {
#define PG8_LAS __attribute__((address_space(3)))
typedef unsigned short bf16_t;
typedef short bf16x8 __attribute__((ext_vector_type(8)));
typedef float f32x4 __attribute__((ext_vector_type(4)));
typedef unsigned u32x4 __attribute__((ext_vector_type(4)));
constexpr int BM = 256, BK = 64, HALF = 128, HTB = HALF * BK * 2  , STAGE_BYTES = 8 * HTB, NXCD = 8, WGM = 8;

__host__ __device__ __forceinline__ int lds_byte(int r, int c) { const int st = (r >> 4) * 2 + (c >> 5), rr = r & 15, cc = c & 31, ob = rr * 64 + cc * 2; return st * 1024 + (ob ^ (((ob >> 9) & 1) << 5)); }
__host__ __device__ __forceinline__ void stage_rc(int b, int& R, int& C) { const int st = b / 1024, sb = b % 1024, swz = sb ^ (((sb >> 9) & 1) << 5); R = (st >> 1) * 16 + swz / 64; C = (st & 1) * 32 + (swz % 64) / 2; }
__host__ __device__ __forceinline__ int perm32(int rho) { const int n = rho >> 4, i = rho & 15; return 8 * (i >> 2) + 4 * n + (i & 3); }

struct Unit { int pm, pn; };
struct Gemm { const bf16_t* A; const bf16_t* Bt; int M, N, K; };

struct StaticOrder {
    int nM, nN, nwg, G, c;
    __host__ __device__ void init(int M, int N, int G_, int c_) { nM = M / BM; nN = N / BM; nwg = nM * nN; G = G_; c = c_; }
    __host__ __device__ bool next(int i, Unit& u) const {
        const long L = (long)i * G + c; if (L >= nwg) return false;
        int wgid = (int)L; { const int q = nwg / NXCD, r = nwg % NXCD, xcd = wgid % NXCD, off = wgid / NXCD; wgid = (xcd < r ? xcd * (q + 1) : r * (q + 1) + (xcd - r) * q) + off; }
        const int nig = WGM * nN, gid = wgid / nig, fm = gid * WGM, gsz = (nM - fm) < WGM ? (nM - fm) : WGM;
        u.pm = fm + ((wgid % nig) % gsz); u.pn = (wgid % nig) / gsz; return true;
    }
    __device__ __forceinline__ void a_ready(const Unit&) const {}
    __device__ __forceinline__ void done(const Unit&) const {}
};

typedef __bf16 bf16x2v __attribute__((ext_vector_type(2)));
typedef float f32x2v __attribute__((ext_vector_type(2)));
__device__ __forceinline__ unsigned cvt_pk_bf16(float lo, float hi) { const f32x2v v = {lo, hi}; const bf16x2v b = __builtin_convertvector(v, bf16x2v); return __builtin_bit_cast(unsigned, b); }
typedef float f32x2 __attribute__((ext_vector_type(2)));

__device__ __forceinline__ float sigm(float x) { return __builtin_amdgcn_rcpf(1.f + __expf(-x)); }
struct EpiProj {
    static constexpr bool PERM = true, AFTER_DRAIN = false;
    bf16_t* proj; bf16_t* lact;
    __device__ __forceinline__ void operator()(const f32x4 (&acc)[2][2][4][2], const Unit& u, int wr, int wc, int fr, int fq) const {
        const int row0 = u.pm * BM + wr * 64 + fr, col0 = u.pn * BM + wc * 32 + 8 * fq;
        if (u.pn < 24) {
#pragma unroll
            for (int ai = 0; ai < 2; ++ai)
#pragma unroll
                for (int m = 0; m < 4; ++m) { bf16_t* rowp = proj + (size_t)(row0 + ai * HALF + m * 16) * 6144 + col0;
#pragma unroll
                    for (int bj = 0; bj < 2; ++bj) { const f32x4 v0 = acc[ai][bj][m][0], v1 = acc[ai][bj][m][1];
                        u32x4 w; w.x = cvt_pk_bf16(v0[0], v0[1]); w.y = cvt_pk_bf16(v0[2], v0[3]); w.z = cvt_pk_bf16(v1[0], v1[1]); w.w = cvt_pk_bf16(v1[2], v1[3]);
                        *(u32x4*)(rowp + bj * HALF) = w; } }
        } else {
#pragma unroll
            for (int ai = 0; ai < 2; ++ai)
#pragma unroll
                for (int m = 0; m < 4; ++m) { bf16_t* rowp = lact + (size_t)(row0 + ai * HALF + m * 16) * 384;
#pragma unroll
                    for (int bj = 0; bj < 2; ++bj)
#pragma unroll
                        for (int n = 0; n < 2; ++n) {
                            const int cl = col0 - 6144 + bj * HALF + 4 * n;
                            if (cl < 384) {
                                f32x4 v = acc[ai][bj][m][n];
                                if (cl < 64) { v[0] = tanhf(v[0]); v[1] = tanhf(v[1]); v[2] = tanhf(v[2]); v[3] = tanhf(v[3]); }
                                else if (cl < 128) { }
                                else if (cl < 288) { v[0] = sigm(v[0]); v[1] = sigm(v[1]); v[2] = sigm(v[2]); v[3] = sigm(v[3]); }
                                else { v = (f32x4){0.f, 0.f, 0.f, 0.f}; }
                                uint2 w; w.x = cvt_pk_bf16(v[0], v[1]); w.y = cvt_pk_bf16(v[2], v[3]);
                                *(uint2*)(rowp + cl) = w;
                            }
                        } }
        }
    }
};
struct EpiLora {
    static constexpr bool PERM = false, AFTER_DRAIN = false;
    float* arr0; size_t arr_stride;
    const float* w0; const float* a0;
    template <int MODE>
    __device__ __forceinline__ void body(const f32x4 (&acc)[2][2][4][2], float* base, const float* bptr, int row0, int col0, float bsc, bool isg) const {
#pragma unroll
        for (int ai = 0; ai < 2; ++ai)
#pragma unroll
            for (int m = 0; m < 4; ++m) { float* rowp = base + (size_t)(row0 + ai * HALF + m * 16) * 1024 + col0;
#pragma unroll
                for (int bj = 0; bj < 2; ++bj)
#pragma unroll
                    for (int n = 0; n < 2; ++n) {
                        f32x4 v = acc[ai][bj][m][n];
                        v = v + *(const f32x4*)(bptr + col0 + bj * HALF + n * 16) * bsc;
#pragma unroll
                        for (int e = 0; e < 4; ++e) { const float sg = sigm(v[e]); v[e] = MODE == 0 ? __expf(-0.6065306597126334f * sg) : (isg ? v[e] : sg); }
                        *(f32x4*)(rowp + bj * HALF + n * 16) = v;
                    } }
    }
    __device__ __forceinline__ void operator()(const f32x4 (&acc)[2][2][4][2], const Unit& u, int wr, int wc, int fr, int fq) const {
        const int which = u.pn >> 2;
        const int row0 = u.pm * BM + wr * 64 + fr, col0 = (u.pn & 3) * BM + wc * 32 + 4 * fq;
        float* base = arr0 + (size_t)which * arr_stride;
        if (which < 2) body<0>(acc, base, w0 + which * 1024, row0, col0, 1.f, false);
        else body<1>(acc, base, a0 + ((which - 2) & 1) * 1024, row0, col0, which < 4 ? 1.f : 0.f, which >= 4);
    }
};
struct EpiRes {
    static constexpr bool PERM = false, AFTER_DRAIN = false;
    float* X; const float* gate;
    float alpha;
    __device__ __forceinline__ void operator()(const f32x4 (&acc)[2][2][4][2], const Unit& u, int wr, int wc, int fr, int fq) const {
        const int row0 = u.pm * BM + wr * 64 + fr, col0 = u.pn * BM + wc * 32 + 4 * fq;
        const int bidx = u.pm < 16 ? 0 : 1 + ((u.pm - 16) >> 2);
        const float* gp = gate + (size_t)bidx * 12288 + col0;
        f32x4 gv[2][2];
#pragma unroll
        for (int bj = 0; bj < 2; ++bj)
#pragma unroll
            for (int n = 0; n < 2; ++n) gv[bj][n] = *(const f32x4*)(gp + bj * HALF + n * 16);
#pragma unroll
        for (int ai = 0; ai < 2; ++ai)
#pragma unroll
            for (int m = 0; m < 4; ++m) { float* rowp = X + (size_t)(row0 + ai * HALF + m * 16) * 2048 + col0;
#pragma unroll
                for (int bj = 0; bj < 2; ++bj)
#pragma unroll
                    for (int n = 0; n < 2; ++n) {
                        f32x4* p = (f32x4*)(rowp + bj * HALF + n * 16);
                        const f32x4 xv = *p;
                        *p = xv * alpha + gv[bj][n] * acc[ai][bj][m][n];
                    } }
    }
};
struct EpiRelu2 {
    static constexpr bool PERM = true, AFTER_DRAIN = false;
    bf16_t* O; int ldc;
    __device__ __forceinline__ void operator()(const f32x4 (&acc)[2][2][4][2], const Unit& u, int wr, int wc, int fr, int fq) const {
        const int row0 = u.pm * BM + wr * 64 + fr, col0 = u.pn * BM + wc * 32 + 8 * fq;
#pragma unroll
        for (int ai = 0; ai < 2; ++ai)
#pragma unroll
            for (int m = 0; m < 4; ++m) { bf16_t* rowp = O + (size_t)(row0 + ai * HALF + m * 16) * ldc + col0;
#pragma unroll
                for (int bj = 0; bj < 2; ++bj) { f32x4 v0 = acc[ai][bj][m][0], v1 = acc[ai][bj][m][1];
#pragma unroll
                    for (int e = 0; e < 4; ++e) { const float a = fmaxf(v0[e], 0.f), b = fmaxf(v1[e], 0.f); v0[e] = a * a; v1[e] = b * b; }
                    u32x4 w; w.x = cvt_pk_bf16(v0[0], v0[1]); w.y = cvt_pk_bf16(v0[2], v0[3]); w.z = cvt_pk_bf16(v1[0], v1[1]); w.w = cvt_pk_bf16(v1[2], v1[3]);
                    *(u32x4*)(rowp + bj * HALF) = w; } }
    }
};

template <class Epi, class Sched, bool ALIGN_EPI = false, bool SP2 = false>
__device__ __forceinline__ void gemm_phase(PG8_LAS unsigned char* lds, const Gemm g, const Sched& S, const Epi& E) {
    int tid = threadIdx.x; asm volatile("" : "+v"(tid)); const int wid = __builtin_amdgcn_readfirstlane(tid >> 6), lane = tid & 63, wr = wid >> 2, wc = wid & 3, fr = lane & 15, fq = lane >> 4;
    const int K = g.K, nt = K / BK;
    unsigned voffA[2], voffB[2];
#pragma unroll
    for (int i = 0; i < 2; ++i) { int R, C; stage_rc(tid * 16 + i * 8192, R, C); const int Rb = Epi::PERM ? ((R & ~31) + perm32(R & 31)) : R;
        voffA[i] = (unsigned)(R * K + C) * 2u; voffB[i] = (unsigned)(Rb * K + C) * 2u; }
    const size_t kstep = (size_t)(BK * 2);
    const size_t hstep = (size_t)HALF * K * 2;
    const size_t tstep = 2 * hstep;
    const unsigned ldsw = (unsigned)wid * 1024u;
    const int aoff = lds_byte(wr * 64 + fr, fq * 8), boff = lds_byte(wc * 32 + fr, fq * 8);
#define PG8_SA(b, h) (((b) * 2 + (h)) * HTB)
#define PG8_SB(b, h) ((4 + (b) * 2 + (h)) * HTB)
#define PG8_STAGE(bufoff, gbase, voff) do { _Pragma("unroll") for (int _i = 0; _i < 2; ++_i) \
        __builtin_amdgcn_global_load_lds((const unsigned*)((const char*)(gbase) + (voff)[_i]), (PG8_LAS unsigned*)(lds + (bufoff) + ldsw + _i * 8192), 16, 0, 0); } while (0)
#define PG8_LDA(dst, b, h) do { _Pragma("unroll") for (int m = 0; m < 4; ++m) _Pragma("unroll") for (int k = 0; k < 2; ++k) dst[m][k] = *(const PG8_LAS bf16x8*)(lds + PG8_SA(b, h) + aoff + m * 2048 + k * 1024); } while (0)
#define PG8_LDB(dst, b, h) do { _Pragma("unroll") for (int n = 0; n < 2; ++n) _Pragma("unroll") for (int k = 0; k < 2; ++k) dst[n][k] = *(const PG8_LAS bf16x8*)(lds + PG8_SB(b, h) + boff + n * 2048 + k * 1024); } while (0)
#define PG8_MMA(ai, bj, At, Bt) do { __builtin_amdgcn_s_setprio(1); _Pragma("unroll") for (int m = 0; m < 4; ++m) _Pragma("unroll") for (int n = 0; n < 2; ++n) _Pragma("unroll") for (int k = 0; k < 2; ++k) \
        acc[ai][bj][m][n] = __builtin_amdgcn_mfma_f32_16x16x32_bf16(Bt[n][k], At[m][k], acc[ai][bj][m][n], 0, 0, 0); __builtin_amdgcn_s_setprio(0); } while (0)
#define PG8_WAIT_V(n) asm volatile("s_waitcnt vmcnt(" #n ")" ::: "memory")
#define PG8_WAIT_L(n) asm volatile("s_waitcnt lgkmcnt(" #n ")" ::: "memory")
#define PG8_BAR __builtin_amdgcn_s_barrier()
#define PG8_SCHED __builtin_amdgcn_sched_barrier(0)
    Unit cur, nxt; int ui = 0;
    if (!S.next(0, cur)) return;
    f32x4 acc[2][2][4][2];
#pragma unroll
    for (int a = 0; a < 2; ++a)
#pragma unroll
        for (int b = 0; b < 2; ++b)
#pragma unroll
            for (int m = 0; m < 4; ++m)
#pragma unroll
                for (int n = 0; n < 2; ++n) acc[a][b][m][n] = (f32x4){0.f, 0.f, 0.f, 0.f};
    bf16x8 At[4][2], B0[2][2], B1[2][2];
    const char* cA = (const char*)g.A + (size_t)cur.pm * tstep; const char* cB = (const char*)g.Bt + (size_t)cur.pn * tstep;
    S.a_ready(cur);
    if constexpr (SP2) {
        PG8_STAGE(PG8_SB(0, 0), cB, voffB); PG8_STAGE(PG8_SB(0, 1), cB + hstep, voffB); PG8_STAGE(PG8_SA(0, 0), cA, voffA); PG8_STAGE(PG8_SA(0, 1), cA + hstep, voffA);
        if (wr == 1) PG8_BAR;
        PG8_WAIT_V(2); PG8_BAR;
        PG8_STAGE(PG8_SB(1, 0), cB + kstep, voffB); PG8_STAGE(PG8_SA(1, 0), cA + kstep, voffA); PG8_STAGE(PG8_SB(1, 1), cB + hstep + kstep, voffB);
        PG8_WAIT_V(6); PG8_BAR;
    } else {
        PG8_STAGE(PG8_SB(0, 0), cB, voffB); PG8_STAGE(PG8_SA(0, 0), cA, voffA); PG8_STAGE(PG8_SB(0, 1), cB + hstep, voffB); PG8_STAGE(PG8_SA(0, 1), cA + hstep, voffA);
        if (wr == 1) PG8_BAR;
        PG8_WAIT_V(4); PG8_BAR;
        PG8_STAGE(PG8_SB(1, 0), cB + kstep, voffB); PG8_STAGE(PG8_SA(1, 0), cA + kstep, voffA); PG8_STAGE(PG8_SB(1, 1), cB + hstep + kstep, voffB);
        PG8_WAIT_V(6); PG8_BAR;
    }
    for (;;) {
        const bool has_next = S.next(ui + 1, nxt);
        const char* nA = has_next ? (const char*)g.A + (size_t)nxt.pm * tstep : cA; const char* nB = has_next ? (const char*)g.Bt + (size_t)nxt.pn * tstep : cB;
        for (int t = 0; t < nt; t += 2) {
            const bool last = (t == nt - 2);
            const char* a1 = cA + (size_t)(t + 1) * kstep;
            const char* a2 = last ? nA : cA + (size_t)(t + 2) * kstep; const char* b2 = last ? nB : cB + (size_t)(t + 2) * kstep;
            const char* a3 = a2 + kstep; const char* b3 = b2 + kstep;
            if (last && has_next) S.a_ready(nxt);
            if constexpr (SP2) {
            PG8_LDB(B0, 0, 0); PG8_LDB(B1, 0, 1); PG8_SCHED; PG8_LDA(At, 0, 0); PG8_STAGE(PG8_SA(1, 1), a1 + hstep, voffA);
            PG8_WAIT_V(8); PG8_WAIT_L(0); PG8_BAR; PG8_MMA(0, 0, At, B0); PG8_MMA(0, 1, At, B1); PG8_BAR; PG8_SCHED;
            PG8_LDA(At, 0, 1); PG8_STAGE(PG8_SB(0, 0), b2, voffB); PG8_STAGE(PG8_SB(0, 1), b2 + hstep, voffB); PG8_STAGE(PG8_SA(0, 0), a2, voffA);
            PG8_WAIT_V(8); PG8_WAIT_L(0); PG8_BAR; PG8_MMA(1, 0, At, B0); PG8_MMA(1, 1, At, B1); PG8_BAR; PG8_SCHED;
            PG8_LDB(B0, 1, 0); PG8_LDB(B1, 1, 1); PG8_SCHED; PG8_LDA(At, 1, 0); PG8_STAGE(PG8_SA(0, 1), a2 + hstep, voffA);
            PG8_WAIT_V(8); PG8_WAIT_L(0); PG8_BAR; PG8_MMA(0, 0, At, B0); PG8_MMA(0, 1, At, B1); PG8_BAR; PG8_SCHED;
            PG8_LDA(At, 1, 1); PG8_STAGE(PG8_SB(1, 0), b3, voffB); PG8_STAGE(PG8_SB(1, 1), b3 + hstep, voffB); PG8_STAGE(PG8_SA(1, 0), a3, voffA);
            PG8_WAIT_V(8); PG8_WAIT_L(0); PG8_BAR; PG8_MMA(1, 0, At, B0); PG8_MMA(1, 1, At, B1); PG8_BAR; PG8_SCHED;
            } else {
            PG8_LDB(B0, 0, 0); PG8_SCHED; PG8_LDA(At, 0, 0); PG8_STAGE(PG8_SA(1, 1), a1 + hstep, voffA);
            PG8_WAIT_L(8); PG8_BAR; PG8_WAIT_L(0); PG8_MMA(0, 0, At, B0); PG8_BAR; PG8_SCHED;
            PG8_LDB(B1, 0, 1); PG8_STAGE(PG8_SB(0, 0), b2, voffB);
            PG8_BAR; PG8_WAIT_L(0); PG8_MMA(0, 1, At, B1); PG8_BAR;
            PG8_LDA(At, 0, 1); PG8_STAGE(PG8_SA(0, 0), a2, voffA);
            PG8_BAR; PG8_WAIT_L(0); PG8_MMA(1, 0, At, B0); PG8_BAR; PG8_SCHED;
            PG8_STAGE(PG8_SB(0, 1), b2 + hstep, voffB);
            PG8_WAIT_V(6); PG8_BAR; PG8_MMA(1, 1, At, B1); PG8_BAR;
            PG8_LDB(B0, 1, 0); PG8_SCHED; PG8_LDA(At, 1, 0); PG8_STAGE(PG8_SA(0, 1), a2 + hstep, voffA);
            PG8_WAIT_L(8); PG8_BAR; PG8_WAIT_L(0); PG8_MMA(0, 0, At, B0); PG8_BAR; PG8_SCHED;
            PG8_LDB(B1, 1, 1); PG8_STAGE(PG8_SB(1, 0), b3, voffB);
            PG8_BAR; PG8_WAIT_L(0); PG8_MMA(0, 1, At, B1); PG8_BAR;
            PG8_LDA(At, 1, 1); PG8_STAGE(PG8_SA(1, 0), a3, voffA);
            PG8_BAR; PG8_WAIT_L(0); PG8_MMA(1, 0, At, B0); PG8_BAR; PG8_SCHED;
            PG8_STAGE(PG8_SB(1, 1), b3 + hstep, voffB);
            PG8_WAIT_V(6); PG8_BAR; PG8_MMA(1, 1, At, B1); PG8_BAR;
            }
        }
        if constexpr (ALIGN_EPI) { if (wr == 0) PG8_BAR; }
        if constexpr (!Epi::AFTER_DRAIN) { int t2 = threadIdx.x; asm volatile("" : "+v"(t2)); const int fr2 = t2 & 15, fq2 = (t2 & 63) >> 4; E(acc, cur, wr, wc, fr2, fq2); S.done(cur); }
        if (!has_next) break;
#pragma unroll
        for (int a = 0; a < 2; ++a)
#pragma unroll
            for (int b = 0; b < 2; ++b)
#pragma unroll
                for (int m = 0; m < 4; ++m)
#pragma unroll
                    for (int n = 0; n < 2; ++n) acc[a][b][m][n] = (f32x4){0.f, 0.f, 0.f, 0.f};
        cur = nxt; cA = nA; cB = nB; ++ui;
        if constexpr (ALIGN_EPI) { if (wr == 1) PG8_BAR; }
    }
    PG8_WAIT_V(0);
    if constexpr (!ALIGN_EPI) { if (wr == 0) PG8_BAR; }
    PG8_BAR;
    if constexpr (Epi::AFTER_DRAIN) { E.fused(acc, cur, wr, wc, fr, fq, lds, wid, lane); S.done(cur); }
#undef PG8_SA
#undef PG8_SB
#undef PG8_STAGE
#undef PG8_LDA
#undef PG8_LDB
#undef PG8_MMA
#undef PG8_WAIT_V
#undef PG8_WAIT_L
#undef PG8_BAR
#undef PG8_SCHED
}
}

using f4 = pg8::f32x4;
typedef unsigned short bf16_t;
constexpr int NT = 512;
constexpr int M = 8192, D = 2048, DR = 1024, NPAD = 6656, DFF = 8192, KL = 384, NL = 5120;
constexpr int DEPTH = 2;
constexpr float ALPHA = 1.4142135623730951f;
constexpr float LN_EPS = 1e-5f, GN_EPS = 64e-5f;
constexpr int LDS_BYTES = 147456;

constexpr size_t al256(size_t x) { return (x + 255) & ~(size_t)255; }
constexpr size_t FILT_CTX_PER = (size_t)2 * 1024 * 528, FILT_LAT_PER = (size_t)2 * 1024 * 2064;
constexpr size_t WS_MOD = 16384;
constexpr size_t WS_FH2 = al256(WS_MOD + (size_t)2 * 5 * 12288 * 4);
constexpr size_t WS_FILT = al256(WS_FH2 + (size_t)2 * 1280 * 64 * 4);
constexpr size_t WS_WIN = WS_FILT;
constexpr size_t WS_WOUT = WS_WIN + (size_t)NPAD * D * 2;
constexpr size_t WS_W1 = WS_WOUT + (size_t)D * D * 2;
constexpr size_t WS_W2 = WS_W1 + (size_t)DFF * D * 2;
constexpr size_t WS_WL = WS_W2 + (size_t)D * DFF * 2;
constexpr size_t WS_H = WS_WL + (size_t)NL * KL * 2;
constexpr size_t WS_MIX = WS_H + (size_t)M * D * 2;
constexpr size_t WS_LACT = WS_MIX + (size_t)M * D * 2;
constexpr size_t WS_PROJ = WS_LACT + (size_t)M * KL * 2;
constexpr size_t WS_RW = WS_PROJ + (size_t)M * 6144 * 2;
constexpr size_t WS_HT = WS_RW + (size_t)9 * M * 1024 * 4;
constexpr size_t WS_FILTB = WS_HT + (size_t)3 * 1024 * M * 2;
constexpr size_t FILTB_CTX = (size_t)2 * 1024 * 520, FILTB_LAT = (size_t)2 * 1024 * 2056, FILTB_PER = FILTB_CTX + FILTB_LAT;
constexpr size_t WS_END = WS_FILTB + 2 * FILTB_PER * 2;
static_assert(WS_END <= (size_t)805306368, "workspace map too large");
constexpr size_t AS = (size_t)M * 1024;
constexpr size_t OUT_STATE = (size_t)16777216;

__device__ __forceinline__ int tid_l() { int t = threadIdx.x; asm volatile("" : "+v"(t)); return t; }
struct Params { const float* in[33]; float* out; unsigned char* ws; int ph_lo, ph_hi; };
typedef const __attribute__((address_space(4))) Params CParams;

__device__ __forceinline__ float wave_sum(float v) {
#pragma unroll
    for (int o = 1; o < 64; o <<= 1) v += __shfl_xor(v, o);
    return v;
}
typedef __bf16 bf16x2_t __attribute__((ext_vector_type(2)));
typedef float f32x2_t __attribute__((ext_vector_type(2)));
__device__ __forceinline__ unsigned pk2(float lo, float hi) { const f32x2_t v = {lo, hi}; const bf16x2_t b = __builtin_convertvector(v, bf16x2_t); return __builtin_bit_cast(unsigned, b); }
__device__ __forceinline__ bf16_t f2bf(float f) { unsigned u = __float_as_uint(f); u += 0x7FFFu + ((u >> 16) & 1u); return (bf16_t)(u >> 16); }
__device__ __forceinline__ float bf2f(unsigned short b) { return __uint_as_float(((unsigned)b) << 16); }
__device__ __forceinline__ float sigmf(float x) { return __builtin_amdgcn_rcpf(1.f + __expf(-x)); }

__device__ __forceinline__ void ph_mod(CParams& P, float* lds) {
    const int tid = tid_l();
    float* scond = lds;
    float* red = lds + 5 * 2048;
    const float* c = P.in[2]; const float* cctx = P.in[4];
    for (int i = tid; i < 5 * 2048; i += NT) { const int b = i >> 11, k = i & 2047; const float x = b == 0 ? cctx[k] : c[(b - 1) * 2048 + k]; scond[i] = x / (1.f + __expf(-x)); }
    __syncthreads();
    const float* w_ada = P.in[5]; const float* b_ada = P.in[6];
    float* mod = (float*)(P.ws + WS_MOD);
    const int kg = tid >> 5, c4 = tid & 31;
    for (int item = blockIdx.x; item < 192; item += gridDim.x) {
        const int l = item / 96, c0 = (item % 96) * 128;
        f4 acc[5];
#pragma unroll
        for (int b = 0; b < 5; ++b) acc[b] = (f4){0.f, 0.f, 0.f, 0.f};
        const float* wp = w_ada + ((size_t)l * 2048 + kg * 128) * 12288 + c0 + c4 * 4;
        const float* sc = scond + kg * 128;
#pragma unroll 8
        for (int k = 0; k < 128; ++k) {
            const f4 w = *(const f4*)(wp + (size_t)k * 12288);
#pragma unroll
            for (int b = 0; b < 5; ++b) acc[b] += w * sc[b * 2048 + k];
        }
#pragma unroll
        for (int b = 0; b < 5; ++b) *(f4*)(red + (kg * 5 + b) * 128 + c4 * 4) = acc[b];
        __syncthreads();
        for (int idx = tid; idx < 640; idx += NT) {
            const int b = idx >> 7, cc = idx & 127; float s = 0.f;
#pragma unroll
            for (int g = 0; g < 16; ++g) s += red[(g * 5 + b) * 128 + cc];
            mod[(size_t)(l * 5 + b) * 12288 + c0 + cc] = s + b_ada[(size_t)l * 12288 + c0 + cc];
        }
        __syncthreads();
    }
}

__device__ __forceinline__ void ph_filt_hidden(CParams& P) {
    const int lane = tid_l() & 63, wave = tid_l() >> 6;
    const int gw = blockIdx.x * 8 + wave, ngw = gridDim.x * 8;
    float* fh2 = (float*)(P.ws + WS_FH2);
    for (int it = gw; it < 2 * 1280; it += ngw) {
        const int l = it / 1280, q = it % 1280;
        const int seq = q < 256 ? 256 : 1024, p = q < 256 ? q : q - 256;
        const float t = (float)p / (float)(seq - 1);
        const float wang = (float)(6.283185307179586 / (double)seq) * (float)p;
        float z = 0.f;
        if (lane == 0) z = t;
        else if (lane <= 32) {
            const int fi = (lane - 1) & 15; const float st = (float)fi / 15.f; const float f = 1e-4f * (1.f - st) + 15.f * st;
            z = lane <= 16 ? cosf(f * wang) : -sinf(f * wang);
        }
        const float* w1 = P.in[19] + (size_t)l * 33 * 64; const float* b1 = P.in[20] + l * 64;
        const float* w2 = P.in[21] + (size_t)l * 64 * 64; const float* b2 = P.in[22] + l * 64;
        const float* fr = P.in[24] + l * 128;
        float a = b1[lane];
        for (int i = 0; i < 33; ++i) a += __shfl(z, i) * w1[i * 64 + lane];
        const float h1 = sinf(fr[lane] * a);
        float a2 = b2[lane];
        for (int i = 0; i < 64; ++i) a2 += __shfl(h1, i) * w2[i * 64 + lane];
        const float h2 = sinf(fr[64 + lane] * a2);
        fh2[((size_t)l * 1280 + q) * 64 + lane] = h2;
    }
}

__device__ __forceinline__ void transpose_item(const float* W, int K, int N, bf16_t* WT, float* scr, int item, int lane) {
    const int nblk = N / 32, kb = item / nblk, nb = item % nblk, k0 = 64 * kb, n0 = 32 * nb;
    float tv[32];
#pragma unroll
    for (int i = 0; i < 32; ++i) { const int kk = 2 * i + (lane >> 5); tv[i] = W[(size_t)(k0 + kk) * N + n0 + (lane & 31)]; }
#pragma unroll
    for (int i = 0; i < 32; ++i) { const int kk = 2 * i + (lane >> 5); scr[kk * 33 + (lane & 31)] = tv[i]; }
    asm volatile("s_waitcnt lgkmcnt(0)" ::: "memory");
    const int c = lane & 7;
#pragma unroll
    for (int j = 0; j < 4; ++j) { const int n = (lane >> 3) + 8 * j; const float* s = scr + (8 * c) * 33 + n;
        uint4 o; o.x = pk2(s[0 * 33], s[1 * 33]); o.y = pk2(s[2 * 33], s[3 * 33]); o.z = pk2(s[4 * 33], s[5 * 33]); o.w = pk2(s[6 * 33], s[7 * 33]);
        *(uint4*)(WT + (size_t)(n0 + n) * K + k0 + 8 * c) = o; }
    asm volatile("s_waitcnt lgkmcnt(0)" ::: "memory");
}
__device__ __forceinline__ void ph_convert(CParams& P, int l, float* lds) {
    const int lane = tid_l() & 63, wave = tid_l() >> 6;
    const int gw = blockIdx.x * 8 + wave, ngw = gridDim.x * 8;
    float* scr = lds + wave * (64 * 33);
    constexpr int I_IN = 32 * 201, I_OUT = 32 * 64, I_1 = 32 * 256, I_2 = 128 * 64;
    const float* w_in = P.in[7] + (size_t)l * 2048 * 6432; const float* w_out = P.in[26] + (size_t)l * 2048 * 2048;
    const float* w1 = P.in[31] + (size_t)l * 2048 * 8192; const float* w2 = P.in[32] + (size_t)l * 8192 * 2048;
    bf16_t* WIN = (bf16_t*)(P.ws + WS_WIN); bf16_t* WOUT = (bf16_t*)(P.ws + WS_WOUT); bf16_t* W1 = (bf16_t*)(P.ws + WS_W1); bf16_t* W2 = (bf16_t*)(P.ws + WS_W2);
    for (int it = gw; it < I_IN + I_OUT + I_1 + I_2; it += ngw) {
        int r = it;
        if (r < I_IN) { transpose_item(w_in, 2048, 6432, WIN, scr, r, lane); continue; } r -= I_IN;
        if (r < I_OUT) { transpose_item(w_out, 2048, 2048, WOUT, scr, r, lane); continue; } r -= I_OUT;
        if (r < I_1) { transpose_item(w1, 2048, 8192, W1, scr, r, lane); continue; } r -= I_1;
        transpose_item(w2, 8192, 2048, W2, scr, r, lane);
    }
    { uint4* z = (uint4*)(WIN + (size_t)6432 * 2048); const int n16 = 224 * 2048 * 2 / 16;
      unsigned zz = 0u; asm volatile("" : "+v"(zz));
      for (int i = blockIdx.x * NT + tid_l(); i < n16; i += gridDim.x * NT) z[i] = make_uint4(zz, zz, zz, zz); }
    { bf16_t* WL = (bf16_t*)(P.ws + WS_WL);
      const float* wup = P.in[9] + (size_t)l * 2 * 64 * 1024; const float* aup = P.in[11] + (size_t)l * 2 * 64 * 1024; const float* gup = P.in[13] + (size_t)l * 160 * 1024;
      for (int i = blockIdx.x * NT + tid_l(); i < NL * KL; i += gridDim.x * NT) {
          const int n = i / KL, k = i % KL; const int which = n >> 10, c = n & 1023; float v = 0.f;
          if (which < 2) { if (k < 64) v = wup[((size_t)which * 64 + k) * 1024 + c]; }
          else if (which < 4) { if (k >= 64 && k < 128) v = aup[((size_t)(which - 2) * 64 + (k - 64)) * 1024 + c]; }
          else { if (k >= 128 && k < 288) v = gup[(size_t)(k - 128) * 1024 + c]; }
          WL[i] = f2bf(v);
      } }
}

__device__ __forceinline__ void row_pass4(const float* src, float* dstX, const float* ag, const float* ab, const float* msh, const float* msc, bf16_t* hrow, int lane) {
    f4 v[4][8]; float s[4];
#pragma unroll
    for (int r = 0; r < 4; ++r) {
        s[r] = 0.f;
#pragma unroll
        for (int j = 0; j < 8; ++j) v[r][j] = *(const f4*)(src + (size_t)r * 2048 + j * 256 + lane * 4);
    }
#pragma unroll
    for (int r = 0; r < 4; ++r)
#pragma unroll
        for (int j = 0; j < 8; ++j) s[r] += (v[r][j][0] + v[r][j][1]) + (v[r][j][2] + v[r][j][3]);
    if (ag) {
        float s2[4], rstd[4];
#pragma unroll
        for (int r = 0; r < 4; ++r) { const float mean = wave_sum(s[r]) * (1.f / 2048.f); s2[r] = 0.f;
#pragma unroll
            for (int j = 0; j < 8; ++j) { v[r][j] = v[r][j] - mean; s2[r] += (v[r][j][0] * v[r][j][0] + v[r][j][1] * v[r][j][1]) + (v[r][j][2] * v[r][j][2] + v[r][j][3] * v[r][j][3]); } }
#pragma unroll
        for (int r = 0; r < 4; ++r) { rstd[r] = rsqrtf(wave_sum(s2[r]) * (1.f / 2048.f) + LN_EPS); s[r] = 0.f; }
#pragma unroll
        for (int j = 0; j < 8; ++j) { const f4 g = *(const f4*)(ag + j * 256 + lane * 4), b = *(const f4*)(ab + j * 256 + lane * 4);
#pragma unroll
            for (int r = 0; r < 4; ++r) { v[r][j] = v[r][j] * rstd[r] * g + b; s[r] += (v[r][j][0] + v[r][j][1]) + (v[r][j][2] + v[r][j][3]); } }
    }
#pragma unroll
    for (int r = 0; r < 4; ++r)
#pragma unroll
        for (int j = 0; j < 8; ++j) *(f4*)(dstX + (size_t)r * 2048 + j * 256 + lane * 4) = v[r][j];
    if (msh) {
        float s2[4], rstd[4];
#pragma unroll
        for (int r = 0; r < 4; ++r) { const float mean = wave_sum(s[r]) * (1.f / 2048.f); s2[r] = 0.f;
#pragma unroll
            for (int j = 0; j < 8; ++j) { v[r][j] = v[r][j] - mean; s2[r] += (v[r][j][0] * v[r][j][0] + v[r][j][1] * v[r][j][1]) + (v[r][j][2] * v[r][j][2] + v[r][j][3] * v[r][j][3]); } }
#pragma unroll
        for (int r = 0; r < 4; ++r) rstd[r] = rsqrtf(wave_sum(s2[r]) * (1.f / 2048.f) + LN_EPS);
#pragma unroll
        for (int j = 0; j < 8; ++j) { const f4 sh = *(const f4*)(msh + j * 256 + lane * 4), sc = *(const f4*)(msc + j * 256 + lane * 4) + 1.f;
#pragma unroll
            for (int r = 0; r < 4; ++r) { const f4 h = v[r][j] * rstd[r] * sc + sh;
                uint2 w; w.x = pk2(h[0], h[1]); w.y = pk2(h[2], h[3]);
                *(uint2*)(hrow + (size_t)r * 2048 + j * 256 + lane * 4) = w; } }
    }
}
__device__ __forceinline__ void ph_rowpass(CParams& P, int mode, int l) {
    const int lane = tid_l() & 63, wave = tid_l() >> 6;
    const int gw = blockIdx.x * 8 + wave, ngw = gridDim.x * 8;
    const float* mod = (const float*)(P.ws + WS_MOD);
    bf16_t* H = (bf16_t*)(P.ws + WS_H);
    for (int m = gw * 4; m < M; m += ngw * 4) {
        const int bidx = m < 4096 ? 0 : 1 + ((m - 4096) >> 10);
        const float* src; const float* ag = nullptr; const float* ab = nullptr; const float* msh = nullptr; const float* msc = nullptr;
        float* dst = P.out + (size_t)m * 2048;
        if (mode == 0) { src = m < 4096 ? P.in[0] + (size_t)m * 2048 : P.in[1] + (size_t)(m - 4096) * 2048;
            msh = mod + (size_t)(0 * 5 + bidx) * 12288; msc = msh + 2048; }
        else if (mode == 1) { src = dst; ag = P.in[27] + l * 2048; ab = P.in[28] + l * 2048;
            msh = mod + (size_t)(l * 5 + bidx) * 12288 + 3 * 2048; msc = msh + 2048; }
        else { src = dst; ag = P.in[29] + l * 2048; ab = P.in[30] + l * 2048;
            if (l + 1 < DEPTH) { msh = mod + (size_t)((l + 1) * 5 + bidx) * 12288; msc = msh + 2048; } }
        row_pass4(src, dst, ag, ab, msh, msc, H + (size_t)m * 2048, lane);
    }
}

__device__ __forceinline__ void ph_filt_final(CParams& P, float* lds) {
    const int tid = tid_l(); const int cl = tid & 15, ps = tid >> 4;
    for (int it = blockIdx.x; it < 512; it += gridDim.x) {
        const int ss = it < 256 ? 1 : 0; const int item = it & 255;
        const int cgp = item & 63, o = (item >> 6) & 1, l = item >> 7;
        const int L = ss ? 1024 : 256, GRL = 2 * L + 8, RS = 2 * L + 1;
        float* buf = lds; float* red = lds + 16 * 2049; float* invs = red + 512;
        const int c = cgp * 16 + cl;
        const float* h2 = (const float*)(P.ws + WS_FH2) + ((size_t)l * 1280 + (ss ? 256 : 0)) * 64;
        const float* w3 = P.in[23] + (size_t)l * 64 * 4096;
        float wf[64], wb[64];
#pragma unroll
        for (int j = 0; j < 64; ++j) { wf[j] = w3[(size_t)j * 4096 + (o * 2 + 0) * 1024 + c]; wb[j] = w3[(size_t)j * 4096 + (o * 2 + 1) * 1024 + c]; }
        const float st = (float)c / 1023.f;
        const float delta = fabsf(-3.0701134573253943f * (1.f - st) + -15.350567286626972f * st);
        float asum = 0.f;
        for (int p = ps; p < L; p += 32) {
            const float* hp = h2 + (size_t)p * 64;
            float af = 0.f, ab = 0.f;
#pragma unroll
            for (int j4 = 0; j4 < 16; ++j4) { const f4 hv = *(const f4*)(hp + j4 * 4);
#pragma unroll
                for (int e = 0; e < 4; ++e) { af += hv[e] * wf[j4 * 4 + e]; ab += hv[e] * wb[j4 * 4 + e]; } }
            const float t = (float)p / (float)(L - 1);
            const float dec = expf(-t * delta);
            af *= dec; ab *= dec;
            asum += fabsf(af) + fabsf(ab);
            buf[cl * RS + (L - 1 - p)] = af;
            if (p > 0) buf[cl * RS + (L - 1 + p)] = ab;
        }
        red[ps * 16 + cl] = asum;
        __syncthreads();
        if (tid < 16) { float tot = 0.f;
#pragma unroll
            for (int g = 0; g < 32; ++g) tot += red[g * 16 + tid];
            invs[tid] = 1.f / tot; }
        __syncthreads();
        bf16_t* gr = (bf16_t*)(P.ws + WS_FILTB) + (size_t)l * FILTB_PER + (ss ? FILTB_CTX : 0) + ((size_t)o * 1024 + cgp * 16) * GRL;
        const int half = GRL / 2;
        for (int idx = tid; idx < 16 * half; idx += NT) {
            const int cc = idx / half, x = (idx % half) * 2;
            const float iv = invs[cc];
            const float v0 = x < 2 * L - 1 ? buf[cc * RS + x] * iv : 0.f, v1 = x + 1 < 2 * L - 1 ? buf[cc * RS + x + 1] * iv : 0.f;
            *(unsigned*)(gr + (size_t)cc * GRL + x) = pk2(v0, v1);
        }
        __syncthreads();
    }
}

__device__ __forceinline__ float2 bfx2(unsigned u) { return make_float2(__uint_as_float(u << 16), __uint_as_float(u & 0xffff0000u)); }
template <bool LAT>
__device__ __forceinline__ void convprep_item(CParams& P, int l, bf16_t* tile, int ct2, int m0, int lane, int wave) {
    const bf16_t* proj = (const bf16_t*)(P.ws + WS_PROJ);
    float* RW = (float*)(P.ws + WS_RW);
    const float* cw = P.in[8] + (size_t)l * 9 * 6144;
    const int c = ct2 * 128 + 2 * lane;
    float2 wgt[9];
#pragma unroll
    for (int q = 0; q < 9; ++q) wgt[q] = *(const float2*)(cw + q * 6144 + c);
    const unsigned* pc = (const unsigned*)(proj + (size_t)m0 * 6144 + c);
    const int row0 = LAT ? (((m0 - 4096) & 1023) >> 6) : 0;
#pragma unroll 1
    for (int hv = 0; hv < 2; ++hv) {
        constexpr int NO = 16;
        float2 y[NO];
#define CP_TOK(i) (LAT ? ((2 * hv + ((i) >> 3)) * 64 + wave * 8 + ((i) & 7)) : (wave * 32 + hv * 16 + (i)))
        if (LAT) {
            unsigned u[4][10];
#pragma unroll
            for (int ry = 0; ry < 4; ++ry) {
                const int rl = 2 * hv + ry - 1;
                const int rr = row0 + rl; const bool rok = rr >= 0 && rr <= 15;
#pragma unroll
                for (int xx = 0; xx < 10; ++xx) { const int cc = wave * 8 + xx - 1; const bool ok = rok && cc >= 0 && cc <= 63;
                    u[ry][xx] = ok ? pc[(ptrdiff_t)(rl * 64 + cc) * 3072] : 0u; }
            }
#pragma unroll
            for (int ry = 0; ry < 2; ++ry)
#pragma unroll
                for (int i = 0; i < 8; ++i) {
                    float2 a = make_float2(0.f, 0.f);
#pragma unroll
                    for (int dy = 0; dy < 3; ++dy)
#pragma unroll
                        for (int dx = 0; dx < 3; ++dx) { const float2 uv = bfx2(u[ry + dy][i + dx]); a.x += uv.x * wgt[dy * 3 + dx].x; a.y += uv.y * wgt[dy * 3 + dx].y; }
                    y[ry * 8 + i] = a;
                }
        } else {
            unsigned u[18];
#pragma unroll
            for (int xx = 0; xx < 18; ++xx) { const int pp = wave * 32 + hv * 16 + xx - 1; const bool ok = pp >= 0 && pp <= 255; u[xx] = ok ? pc[(ptrdiff_t)pp * 3072] : 0u; }
#pragma unroll
            for (int i = 0; i < 16; ++i) {
                float2 a = make_float2(0.f, 0.f);
#pragma unroll
                for (int dx = 0; dx < 3; ++dx) { const float2 uv = bfx2(u[i + dx]); a.x += uv.x * wgt[3 + dx].x; a.y += uv.y * wgt[3 + dx].y; }
                y[i] = a;
            }
        }
        if (ct2 < 24) {
            const int arr = ct2 >> 3; const int cc = (ct2 & 7) * 128 + 2 * lane;
            float* dst = RW + (size_t)arr * AS + (size_t)m0 * 1024 + cc;
#pragma unroll
            for (int i = 0; i < NO; ++i) *(float2*)(dst + (size_t)CP_TOK(i) * 1024) = y[i];
            if (arr == 1) {
                const float2 kkw = *(const float2*)(P.in[14] + l * 1024 + cc);
                float* dk = RW + (size_t)3 * AS + (size_t)m0 * 1024 + cc;
#pragma unroll
                for (int i = 0; i < NO; ++i) { const float k0 = y[i].x * kkw.x, k1 = y[i].y * kkw.y; float ssq = k0 * k0 + k1 * k1;
#pragma unroll
                    for (int sh = 1; sh < 32; sh <<= 1) ssq += __shfl_xor(ssq, sh);
                    const float rs = rsqrtf(ssq + 1e-12f);
                    *(float2*)(dk + (size_t)CP_TOK(i) * 1024) = make_float2(k0 * rs, k1 * rs); }
            }
        } else {
#pragma unroll
            for (int i = 0; i < NO; ++i) { tile[(2 * lane) * 264 + CP_TOK(i)] = f2bf(y[i].x); tile[(2 * lane + 1) * 264 + CP_TOK(i)] = f2bf(y[i].y); }
        }
#undef CP_TOK
    }
}
__device__ __forceinline__ void ph_convprep(CParams& P, int l, float* lds) {
    const int tid = tid_l(), lane = tid & 63, wave = tid >> 6;
    bf16_t* tile = (bf16_t*)lds;
    bf16_t* HT = (bf16_t*)(P.ws + WS_HT);
    const bool g256 = gridDim.x == 256; const int bb = blockIdx.x;
    const int ifirst = !g256 ? bb : (bb < 128 ? bb : 640 + (bb - 128)), istep = !g256 ? (int)gridDim.x : 128, iend = !g256 ? 1536 : (bb < 128 ? 640 : 1536);
    for (int item = ifirst; item < iend; item += istep) {
        const int ct2 = item % 48, tt = item / 48;
        const int m0 = tt * 256;
        if (m0 >= 4096) convprep_item<true>(P, l, tile, ct2, m0, lane, wave);
        else convprep_item<false>(P, l, tile, ct2, m0, lane, wave);
        if (ct2 >= 24) {
            __syncthreads();
            const int which = (ct2 - 24) >> 3; const int cbase = ((ct2 - 24) & 7) * 128;
#pragma unroll
            for (int i = 0; i < 16; ++i) { const int ch = wave * 16 + i;
                *(uint2*)(HT + ((size_t)which * 1024 + cbase + ch) * M + m0 + lane * 4) = *(const uint2*)(tile + ch * 264 + lane * 4); }
            __syncthreads();
        }
    }
}

typedef float f32x16 __attribute__((ext_vector_type(16)));
typedef short s16x8 __attribute__((ext_vector_type(8)));
typedef short s16x4 __attribute__((ext_vector_type(4)));
typedef unsigned u32x4_t __attribute__((ext_vector_type(4)));
#define MFMA16(a, b, c) __builtin_amdgcn_mfma_f32_16x16x32_bf16((a), (b), (c), 0, 0, 0)
__device__ __forceinline__ s16x8 mk8(unsigned a, unsigned b, unsigned c, unsigned d) { u32x4_t v = {a, b, c, d}; return __builtin_bit_cast(s16x8, v); }
__device__ __forceinline__ s16x8 pack_lo(f4 x) { return mk8(pk2(x[0], x[1]), pk2(x[2], x[3]), 0u, 0u); }
__device__ __forceinline__ s16x8 pack_2(f4 lo, f4 hi) { return mk8(pk2(lo[0], lo[1]), pk2(lo[2], lo[3]), pk2(hi[0], hi[1]), pk2(hi[2], hi[3])); }
constexpr int SC_KQ = 0, SC_RQ = 2304, SC_KD = 4608, SC_BD = 6912, SC_KDCT = 9216, SC_NBDCT = 11264, SC_VT = 13312, SC_GC = 15360, SC_BUF = 15616;

__device__ __forceinline__ void chain_chunk(const unsigned char* buf, f4 (&H)[4][4], float* gO, int mrow0, int mstep, int lane) {
    const int r = lane & 15, g = lane >> 4;
    const f4 z = (f4){0.f, 0.f, 0.f, 0.f};
    const unsigned char* rb = buf + r * 144 + g * 16;
    const s16x8 fKq0 = *(const s16x8*)(rb + SC_KQ), fKq1 = *(const s16x8*)(rb + SC_KQ + 64);
    const s16x8 fRq0 = *(const s16x8*)(rb + SC_RQ), fRq1 = *(const s16x8*)(rb + SC_RQ + 64);
    const s16x8 fKd0 = *(const s16x8*)(rb + SC_KD), fKd1 = *(const s16x8*)(rb + SC_KD + 64);
    const s16x8 fBd0 = *(const s16x8*)(rb + SC_BD), fBd1 = *(const s16x8*)(rb + SC_BD + 64);
    f4 Xd = MFMA16(fKq1, fBd1, MFMA16(fKq0, fBd0, z));
    f4 XTd = MFMA16(fBd1, fKq1, MFMA16(fBd0, fKq0, z));
    f4 MkkT = MFMA16(fKd1, fKq1, MFMA16(fKd0, fKq0, z));
    f4 MrkT = MFMA16(fKd1, fRq1, MFMA16(fKd0, fRq0, z));
    f4 MrbT = MFMA16(fBd1, fRq1, MFMA16(fBd0, fRq0, z));
    f4 eye;
#pragma unroll
    for (int q = 0; q < 4; ++q) { const int ri = 4 * g + q;
        Xd[q] = ri > r ? -Xd[q] : 0.f; XTd[q] = ri < r ? -XTd[q] : 0.f; MkkT[q] = ri < r ? MkkT[q] : 0.f;
        MrkT[q] = ri <= r ? MrkT[q] : 0.f; MrbT[q] = ri <= r ? -MrbT[q] : 0.f; eye[q] = ri == r ? 1.f : 0.f; }
    const s16x8 pX = pack_lo(Xd), pXT = pack_lo(XTd);
    const f4 X2d = MFMA16(pXT, pX, z), X2Td = MFMA16(pX, pXT, z);
    const s16x8 pX2 = pack_lo(X2d), pX2T = pack_lo(X2Td);
    const f4 X4d = MFMA16(pX2T, pX2, z), X4Td = MFMA16(pX2, pX2T, z);
    const f4 X8d = MFMA16(pack_lo(X4Td), pack_lo(X4d), z);
    const f4 U1T = MFMA16(pack_lo(X2d + eye), pack_lo(XTd + eye), z);
    const f4 U2T = MFMA16(pack_lo(X4d + eye), pack_lo(U1T), z);
    const f4 TT = MFMA16(pack_lo(X8d + eye), pack_lo(U2T), z);
    const s16x8 fTT = pack_lo(TT), fMkkT = pack_lo(MkkT), fOrb = pack_2(MrkT, MrbT);
    const unsigned char* pb = buf + r * 144 + g * 8;
    const uint2 k0l = *(const uint2*)(pb + SC_KQ), k0h = *(const uint2*)(pb + SC_KQ + 32), k1l = *(const uint2*)(pb + SC_KQ + 64), k1h = *(const uint2*)(pb + SC_KQ + 96);
    const uint2 r0l = *(const uint2*)(pb + SC_RQ), r0h = *(const uint2*)(pb + SC_RQ + 32), r1l = *(const uint2*)(pb + SC_RQ + 64), r1h = *(const uint2*)(pb + SC_RQ + 96);
    const s16x8 aK0 = mk8(k0l.x, k0l.y, k0h.x, k0h.y), aK1 = mk8(k1l.x, k1l.y, k1h.x, k1h.y);
    const s16x8 aR0 = mk8(r0l.x, r0l.y, r0h.x, r0h.y), aR1 = mk8(r1l.x, r1l.y, r1h.x, r1h.y);
#pragma unroll
    for (int vt = 0; vt < 4; ++vt) {
        const s16x8 h0 = pack_2(H[0][vt], H[1][vt]), h1 = pack_2(H[2][vt], H[3][vt]);
        f4 P0 = MFMA16(aK1, h1, MFMA16(aK0, h0, z));
        f4 O = MFMA16(aR1, h1, MFMA16(aR0, h0, z));
        const uint2 vv = *(const uint2*)(buf + SC_VT + (16 * vt + r) * 32 + g * 8);
        P0 = MFMA16(fMkkT, mk8(vv.x, vv.y, 0u, 0u), P0);
        const f4 Pm = MFMA16(fTT, pack_lo(P0), z);
        const s16x8 fB = mk8(vv.x, vv.y, pk2(Pm[0], Pm[1]), pk2(Pm[2], Pm[3]));
        O = MFMA16(fOrb, fB, O);
#pragma unroll
        for (int q = 0; q < 4; ++q) gO[(ptrdiff_t)(mrow0 + mstep * (4 * g + q)) * 1024 + 16 * vt + r] = O[q];
#pragma unroll
        for (int kt = 0; kt < 4; ++kt) {
            const unsigned char* pk = buf + SC_KDCT + (16 * kt + r) * 32 + g * 8;
            const uint2 al = *(const uint2*)pk, ah = *(const uint2*)(pk + 2048);
            const f4 gc = *(const f4*)(buf + SC_GC + (16 * kt + 4 * g) * 4);
            H[kt][vt] = MFMA16(mk8(al.x, al.y, ah.x, ah.y), fB, H[kt][vt] * gc);
        }
    }
}
typedef float f32x8 __attribute__((ext_vector_type(8)));
struct RawH { f32x16 w; f32x8 r, k, v, kk, a; };
__device__ __forceinline__ void prep_load(RawH& R, const float* RW, int d, int hf, int mrow0, int mstep, unsigned colx) {
    const float* wb = RW + (size_t)(4 + d) * AS;
#pragma unroll
    for (int t = 0; t < 16; ++t) { const float* rp = wb + (size_t)(unsigned)(mrow0 + mstep * t) * 1024; R.w[t] = rp[colx]; }
    const float* ab = RW + (size_t)(6 + d) * AS;
#pragma unroll
    for (int j = 0; j < 8; ++j) { const size_t ro = (size_t)(unsigned)(mrow0 + mstep * (8 * hf + j)) * 1024;
        const float* p0 = RW + ro; const float* p1 = RW + AS + ro; const float* p2 = RW + 2 * AS + ro; const float* p3 = RW + 3 * AS + ro; const float* p4 = ab + ro;
        R.r[j] = p0[colx]; R.k[j] = p1[colx]; R.v[j] = p2[colx]; R.kk[j] = p3[colx]; R.a[j] = p4[colx]; }
}
__device__ __forceinline__ void prep_proc(const RawH& R, unsigned char* buf, int hf, float ka, int lane) {
    float G = 1.f;
    if (hf) {
#pragma unroll
        for (int t = 0; t < 8; ++t) G *= R.w[t]; }
    float GC = 1.f;
#pragma unroll
    for (int t = 0; t < 16; ++t) GC *= R.w[t];
    f32x8 kdi, bdi;
#pragma unroll
    for (int j = 0; j < 8; ++j) {
        const int t = 8 * hf + j;
        *(bf16_t*)(buf + SC_KQ + t * 144 + lane * 2) = (bf16_t)pk2(R.kk[j] * G, 0.f);
        G *= hf ? R.w[8 + j] : R.w[j];
        *(bf16_t*)(buf + SC_RQ + t * 144 + lane * 2) = (bf16_t)pk2(R.r[j] * G, 0.f);
        const float iG = __builtin_amdgcn_rcpf(G);
        const float kd = R.k[j] * (1.f + (R.a[j] - 1.f) * ka), bb = R.kk[j] * R.a[j];
        kdi[j] = kd * iG; bdi[j] = bb * iG;
        *(bf16_t*)(buf + SC_KD + t * 144 + lane * 2) = (bf16_t)pk2(kdi[j], 0.f);
        *(bf16_t*)(buf + SC_BD + t * 144 + lane * 2) = (bf16_t)pk2(bdi[j], 0.f);
    }
    uint4 o1, o2, o3;
    o1.x = pk2(kdi[0] * GC, kdi[1] * GC); o1.y = pk2(kdi[2] * GC, kdi[3] * GC); o1.z = pk2(kdi[4] * GC, kdi[5] * GC); o1.w = pk2(kdi[6] * GC, kdi[7] * GC);
    o2.x = pk2(-bdi[0] * GC, -bdi[1] * GC); o2.y = pk2(-bdi[2] * GC, -bdi[3] * GC); o2.z = pk2(-bdi[4] * GC, -bdi[5] * GC); o2.w = pk2(-bdi[6] * GC, -bdi[7] * GC);
    o3.x = pk2(R.v[0], R.v[1]); o3.y = pk2(R.v[2], R.v[3]); o3.z = pk2(R.v[4], R.v[5]); o3.w = pk2(R.v[6], R.v[7]);
    *(uint4*)(buf + SC_KDCT + lane * 32 + hf * 16) = o1;
    *(uint4*)(buf + SC_NBDCT + lane * 32 + hf * 16) = o2;
    *(uint4*)(buf + SC_VT + lane * 32 + hf * 16) = o3;
    if (hf) *(float*)(buf + SC_GC + lane * 4) = GC;
}
__device__ __forceinline__ void lds_barrier() { asm volatile("s_waitcnt lgkmcnt(0)" ::: "memory"); __builtin_amdgcn_s_barrier(); asm volatile("" ::: "memory"); }
__device__ __forceinline__ void scan_item(CParams& P, int l, float* ldsf, int type, int b, int h) {
    unsigned char* lds = (unsigned char*)ldsf;
    const int tid = tid_l(), lane = tid & 63, wave = __builtin_amdgcn_readfirstlane(tid >> 6);
    const int L = type ? 256 : 1024, NCH = L / 16; const int mbase = type ? b * 256 : 4096 + b * 1024;
    if (wave < 2) {
        const int d = wave; const int mstep = d ? -1 : 1; const int mfirst = mbase + (d ? L - 1 : 0);
        const unsigned char* cbuf = lds + d * 2 * SC_BUF;
        float* gO = (float*)(P.ws + WS_PROJ) + (size_t)d * AS + h * 64;
        const int r = lane & 15, g = lane >> 4;
        f4 H[4][4];
        if (type == 0) { const float* s0 = P.in[3] + ((((size_t)b * 2 + l) * 2 + d) * 16 + h) * 4096;
#pragma unroll
            for (int kt = 0; kt < 4; ++kt)
#pragma unroll
                for (int vt = 0; vt < 4; ++vt) H[kt][vt] = *(const f4*)(s0 + (16 * vt + r) * 64 + 16 * kt + 4 * g); }
        else {
#pragma unroll
            for (int kt = 0; kt < 4; ++kt)
#pragma unroll
                for (int vt = 0; vt < 4; ++vt) H[kt][vt] = (f4){0.f, 0.f, 0.f, 0.f}; }
        lds_barrier();
        for (int c = 0; c < NCH; ++c) {
            chain_chunk(cbuf + (c & 1) * SC_BUF, H, gO, mfirst + mstep * 16 * c, mstep, lane);
            lds_barrier();
        }
        if (type == 1) { float* so = P.out + OUT_STATE + ((((size_t)b * 2 + l) * 2 + d) * 16 + h) * 4096;
#pragma unroll
            for (int kt = 0; kt < 4; ++kt)
#pragma unroll
                for (int vt = 0; vt < 4; ++vt) *(f4*)(so + (16 * vt + r) * 64 + 16 * kt + 4 * g) = H[kt][vt]; }
    } else if (wave != 4 && wave != 5) {
        const int d = wave & 1, hf = wave >> 2; const int mstep = d ? -1 : 1; const int mfirst = mbase + (d ? L - 1 : 0);
        unsigned char* cbuf = lds + d * 2 * SC_BUF;
        const float* RW = (const float*)(P.ws + WS_RW);
        const unsigned colx = (unsigned)(h * 64 + lane);
        const float ka = P.in[15][l * 1024 + colx];
        RawH RA, RB;
        prep_load(RA, RW, d, hf, mfirst, mstep, colx);
        for (int c = 0; c < NCH; c += 2) {
            prep_load(RB, RW, d, hf, mfirst + mstep * 16 * (c + 1), mstep, colx);
            prep_proc(RA, cbuf, hf, ka, lane);
            lds_barrier();
            if (c + 2 < NCH) prep_load(RA, RW, d, hf, mfirst + mstep * 16 * (c + 2), mstep, colx);
            prep_proc(RB, cbuf + SC_BUF, hf, ka, lane);
            lds_barrier();
        }
        lds_barrier();
    } else {
        for (int c = 0; c <= NCH; ++c) lds_barrier();
    }
}

template <int L>
__device__ __forceinline__ void hym_conv(const bf16_t* cps, const bf16_t* ubs, f32x16& acc) {
    constexpr int ND = (L == 1024) ? 39 : 15;
    f32x16 acc1;
#pragma unroll
    for (int i = 0; i < 16; ++i) acc1[i] = 0.f;
#pragma unroll (L == 1024 ? 13 : 15)
    for (int dd = 0; dd < ND; ++dd) {
        const bf16_t* ap = cps - 32 * dd; const bf16_t* bp = ubs - 32 * dd;
        const s16x4 a0l = *(const s16x4*)ap, a0h = *(const s16x4*)(ap + 4), a1l = *(const s16x4*)(ap + 16), a1h = *(const s16x4*)(ap + 20);
        const s16x8 b0 = *(const s16x8*)bp, b1 = *(const s16x8*)(bp + 16);
        acc = __builtin_amdgcn_mfma_f32_32x32x16_bf16(__builtin_shufflevector(a0l, a0h, 0, 1, 2, 3, 4, 5, 6, 7), b0, acc, 0, 0, 0);
        acc1 = __builtin_amdgcn_mfma_f32_32x32x16_bf16(__builtin_shufflevector(a1l, a1h, 0, 1, 2, 3, 4, 5, 6, 7), b1, acc1, 0, 0, 0);
    }
    acc = acc + acc1;
}
template <int L>
__device__ __forceinline__ void hyena_item(CParams& P, int l, float* ldsf, int cp2) {
    constexpr bool LAT = (L == 1024); constexpr int NB = LAT ? 4 : 16; constexpr int GRL = 2 * L + 8; constexpr int ROWL = L + 448;
    bf16_t* sCP = (bf16_t*)ldsf;
    bf16_t* sU = sCP + 16 * GRL;
    bf16_t* sZ = sU + 2 * NB * ROWL;
    const int tid = tid_l(), lane = tid & 63, wave = tid >> 6;
    const int c0 = cp2 * 2; const int mbase = LAT ? 4096 : 0;
    bf16_t* HT = (bf16_t*)(P.ws + WS_HT);
    const bf16_t* filtb = (const bf16_t*)(P.ws + WS_FILTB) + (size_t)l * FILTB_PER + (LAT ? FILTB_CTX : 0);
    unsigned zz = 0u; asm volatile("" : "+v"(zz));
    for (int idx = tid; idx < 2 * NB * 56; idx += NT) { const int row = idx / 56, q = idx % 56;
        const int off = row * ROWL + (q < 28 ? q * 8 : 224 + L + (q - 28) * 8);
        *(uint4*)(sU + off) = make_uint4(zz, zz, zz, zz); *(uint4*)(sZ + off) = make_uint4(zz, zz, zz, zz); }
    for (int idx = tid; idx < 2 * 512; idx += NT) { const int ch = idx >> 9, q = idx & 511;
        const uint4 v = *(const uint4*)(HT + (size_t)(c0 + ch) * M + mbase + 8 * q);
        const int b = (8 * q) / L, t = (8 * q) % L; *(uint4*)(sU + (ch * NB + b) * ROWL + 224 + t) = v; }
    { constexpr int NCK = GRL / 8;
      for (int idx = tid; idx < 4 * NCK; idx += NT) { const int q = idx % NCK, k = idx / NCK; const int o = k & 1, ch = k >> 1;
        const uint4* src = (const uint4*)(filtb + ((size_t)o * 1024 + c0 + ch) * GRL) + q;
        const uint4 a = src[0]; uint4 b = make_uint4(zz, zz, zz, zz); if (q + 1 < NCK) b = src[1];
        const unsigned d[7] = {a.x, a.y, a.z, a.w, b.x, b.y, b.z};
        bf16_t* dst = sCP + ((ch * 2 + o) * 4) * GRL + 8 * q;
        *(uint4*)(dst) = a;
        *(uint4*)(dst + GRL) = make_uint4((d[0] >> 16) | (d[1] << 16), (d[1] >> 16) | (d[2] << 16), (d[2] >> 16) | (d[3] << 16), (d[3] >> 16) | (d[4] << 16));
        *(uint4*)(dst + 2 * GRL) = make_uint4(d[1], d[2], d[3], d[4]);
        *(uint4*)(dst + 3 * GRL) = make_uint4((d[1] >> 16) | (d[2] << 16), (d[2] >> 16) | (d[3] << 16), (d[3] >> 16) | (d[4] << 16), (d[4] >> 16) | (d[5] << 16)); } }
    __syncthreads();
    const int ch = wave >> 2, nt = wave & 3; const int c = c0 + ch;
    const int r = lane & 31, h = lane >> 5; const int Il = r >> 2, bl = r & 3;
    const int I = LAT ? 8 * nt + Il : Il; const int b = LAT ? bl : 4 * nt + bl;
    const int dlo = LAT ? 8 * nt - 31 : -7;
    const int X0 = L - 1 - (32 * dlo + r - 8 * h); const int sft = X0 & 3;
    const int urow = (ch * NB + b) * ROWL + 224;
    const int uoff = urow + 32 * (I - dlo) + 8 * h;
    f32x16 acc;
#pragma unroll
    for (int i = 0; i < 16; ++i) acc[i] = 0.f;
    hym_conv<L>(sCP + ((ch * 2 + 0) * 4 + sft) * GRL + (X0 - sft), sU + uoff, acc);
    const float bias1 = P.in[25][(l * 2 + 0) * 1024 + c], bias2 = P.in[25][(l * 2 + 1) * 1024 + c];
    const size_t gcol = (size_t)c * M + mbase + b * L + 32 * I + 4 * h;
    float z[16];
#pragma unroll
    for (int g4 = 0; g4 < 4; ++g4) {
        const int t0 = 32 * I + 8 * g4 + 4 * h;
        const uint2 xv = *(const uint2*)(HT + (size_t)1 * 1024 * M + gcol + 8 * g4);
        const uint2 uv = *(const uint2*)(sU + urow + t0);
        const float x1[4] = {__uint_as_float(xv.x << 16), __uint_as_float(xv.x & 0xffff0000u), __uint_as_float(xv.y << 16), __uint_as_float(xv.y & 0xffff0000u)};
        const float uu[4] = {__uint_as_float(uv.x << 16), __uint_as_float(uv.x & 0xffff0000u), __uint_as_float(uv.y << 16), __uint_as_float(uv.y & 0xffff0000u)};
#pragma unroll
        for (int e = 0; e < 4; ++e) z[4 * g4 + e] = x1[e] * (acc[4 * g4 + e] + bias1 * uu[e]);
        uint2 w; w.x = pk2(z[4 * g4], z[4 * g4 + 1]); w.y = pk2(z[4 * g4 + 2], z[4 * g4 + 3]);
        *(uint2*)(sZ + urow + t0) = w;
    }
    __syncthreads();
#pragma unroll
    for (int i = 0; i < 16; ++i) acc[i] = 0.f;
    hym_conv<L>(sCP + ((ch * 2 + 1) * 4 + sft) * GRL + (X0 - sft), sZ + uoff, acc);
#pragma unroll
    for (int g4 = 0; g4 < 4; ++g4) {
        const uint2 xv = *(const uint2*)(HT + (size_t)2 * 1024 * M + gcol + 8 * g4);
        const float x2[4] = {__uint_as_float(xv.x << 16), __uint_as_float(xv.x & 0xffff0000u), __uint_as_float(xv.y << 16), __uint_as_float(xv.y & 0xffff0000u)};
        float o4[4];
#pragma unroll
        for (int e = 0; e < 4; ++e) o4[e] = x2[e] * (acc[4 * g4 + e] + bias2 * z[4 * g4 + e]);
        uint2 w; w.x = pk2(o4[0], o4[1]); w.y = pk2(o4[2], o4[3]);
        *(uint2*)(HT + gcol + 8 * g4) = w;
    }
    __syncthreads();
}

__device__ __forceinline__ void ph_scan_hyena(CParams& P, int l, float* lds) {
    const int G = gridDim.x, bid = blockIdx.x;
    if (G < 128) {
        for (int j = bid; j < 1344; j += G) {
            if (j < 64) scan_item(P, l, lds, 0, j >> 4, j & 15);
            else if (j < 320) scan_item(P, l, lds, 1, (j - 64) >> 4, (j - 64) & 15);
            else if (j < 832) hyena_item<1024>(P, l, lds, j - 320);
            else hyena_item<256>(P, l, lds, j - 832);
        }
        return;
    }
    if (bid < 64) { scan_item(P, l, lds, 0, bid >> 4, bid & 15); return; }
    const int vb = bid - 64, nb = G - 64;
    for (int j = vb; j < 256 + 1024; j += nb) {
        if (j < 256) scan_item(P, l, lds, 1, j >> 4, j & 15);
        else if (j < 768) hyena_item<1024>(P, l, lds, j - 256);
        else hyena_item<256>(P, l, lds, j - 768);
    }
}

__device__ __forceinline__ void ph_combine(CParams& P, int l, float* lds) {
    const int lane = tid_l() & 63, wave = tid_l() >> 6;
    const int gw = blockIdx.x * 8 + wave, ngw = gridDim.x * 8;
    const float* RW = (const float*)(P.ws + WS_RW);
    const float* O = (const float*)(P.ws + WS_PROJ);
    bf16_t* mix = (bf16_t*)(P.ws + WS_MIX);
    for (int m = gw; m < M; m += ngw) {
        const size_t rowo = (size_t)m * 1024 + lane * 4;
#pragma unroll
        for (int qi = 0; qi < 4; ++qi) {
            const size_t idx = rowo + qi * 256; const int cc = qi * 256 + lane * 4;
            const f4 o0 = *(const f4*)(O + idx), o1 = *(const f4*)(O + AS + idx);
            const f4 r = *(const f4*)(RW + idx), k = *(const f4*)(RW + AS + idx), v = *(const f4*)(RW + 2 * AS + idx);
            const f4 a0 = *(const f4*)(RW + 6 * AS + idx), a1 = *(const f4*)(RW + 7 * AS + idx), g = *(const f4*)(RW + 8 * AS + idx);
            const f4 lg = *(const f4*)(P.in[17] + l * 1024 + cc), lb = *(const f4*)(P.in[18] + l * 1024 + cc);
            const f4 ka = *(const f4*)(P.in[15] + l * 1024 + cc), rk = *(const f4*)(P.in[16] + l * 1024 + cc);
            const f4 o = o0 + o1;
            const f4 kds = k * ((a0 + a1 - 2.f) * ka + 2.f);
            const f4 pb = r * kds * rk;
            float s1 = (o[0] + o[1]) + (o[2] + o[3]);
            float s2 = (o[0] * o[0] + o[1] * o[1]) + (o[2] * o[2] + o[3] * o[3]);
            float s3 = (pb[0] + pb[1]) + (pb[2] + pb[3]);
#pragma unroll
            for (int sh = 1; sh < 16; sh <<= 1) { s1 += __shfl_xor(s1, sh); s2 += __shfl_xor(s2, sh); s3 += __shfl_xor(s3, sh); }
            const float mu = s1 * (1.f / 64.f); const float var = fmaxf(s2 * (1.f / 64.f) - mu * mu, 0.f);
            const float rs = rsqrtf(var + GN_EPS);
            const f4 res = ((o - mu) * rs * lg + lb + v * s3) * g;
            uint2 w; w.x = pk2(res[0], res[1]); w.y = pk2(res[2], res[3]);
            *(uint2*)(mix + (size_t)m * 2048 + cc) = w;
        }
    }
    bf16_t* tile = (bf16_t*)lds;
    const bf16_t* HT = (const bf16_t*)(P.ws + WS_HT);
    for (int item = blockIdx.x; item < 16 * 128; item += gridDim.x) {
        const int c0 = (item & 15) * 64, m0 = (item >> 4) * 64;
#pragma unroll
        for (int i = 0; i < 8; ++i) { const int ci = wave * 8 + i; tile[ci * 66 + lane] = HT[(size_t)(c0 + ci) * M + m0 + lane]; }
        __syncthreads();
#pragma unroll
        for (int i = 0; i < 8; ++i) { const int mi = wave * 8 + i; mix[(size_t)(m0 + mi) * 2048 + 1024 + c0 + lane] = tile[lane * 66 + mi]; }
        __syncthreads();
    }
}

#define XB_TMO      128
#define XB_XCNT(j)  (256  + 64 * (j))
#define XB_XSUB(j)  (1280 + 64 * (j))
#define XB_XGEN(j)  (2304 + 64 * (j))
#define XB_TOP      3328
#define XB_TOPGEN   3392
#define XCD_BAR_WORDS 3456
#define XB_SPIN_CAP (1u << 18)
#define LAS __attribute__((address_space(3)))

__device__ __forceinline__ unsigned xb_ld(unsigned* p)              { return __hip_atomic_load(p, __ATOMIC_RELAXED, __HIP_MEMORY_SCOPE_AGENT); }
__device__ __forceinline__ unsigned xb_add(unsigned* p, unsigned v) { return __hip_atomic_fetch_add(p, v, __ATOMIC_RELAXED, __HIP_MEMORY_SCOPE_AGENT); }
__device__ __forceinline__ unsigned xb_xcc_id() { return (unsigned)__builtin_amdgcn_s_getreg((3 << 11) | 20) & 0xFu; }
#define XB_SPIN(cond, bar) do { unsigned _sp = 0; while (cond) { __builtin_amdgcn_s_sleep(1); \
    if ((++_sp & 255u) == 0u) { if (xb_ld(&(bar)[XB_TMO])) break; if (_sp > XB_SPIN_CAP) { atomicAdd(&(bar)[XB_TMO], 1u); break; } } } } while (0)

struct XcdBarrier {
    unsigned* bar; unsigned x;
    volatile LAS unsigned* st;
};

__device__ __forceinline__ XcdBarrier xcd_barrier_post(unsigned* bar, volatile LAS unsigned* st) {
    XcdBarrier b; b.bar = bar; b.x = xb_xcc_id(); b.st = st;
    if (threadIdx.x == 0) (void)xb_add(&bar[XB_XCNT(b.x)], 1u);
    return b;
}
__device__ __forceinline__ void xcd_barrier_complete(unsigned* bar, unsigned x, unsigned& nloc, unsigned& nx) {
    const unsigned G = gridDim.x * gridDim.y * gridDim.z;
    unsigned sum, cnt, mine, sp = 0u;
    for (;;) {
        sum = 0u; cnt = 0u; mine = 0u;
#pragma unroll
        for (unsigned j = 0; j < 16; ++j) { const unsigned c = xb_ld(&bar[XB_XCNT(j)]); sum += c; cnt += (c > 0u) ? 1u : 0u; mine = (j == x) ? c : mine; }
        if (sum == G) break;
        __builtin_amdgcn_s_sleep(1);
        if ((++sp & 255u) == 0u) { if (xb_ld(&bar[XB_TMO])) break; if (sp > XB_SPIN_CAP) { atomicAdd(&bar[XB_TMO], 1u); break; } }
    }
    nloc = mine > 0u ? mine : 1u; nx = cnt > 0u ? cnt : 1u;
}

__device__ __forceinline__ void xcd_barrier(const XcdBarrier& b) {
    asm volatile("s_waitcnt vmcnt(0)" ::: "memory");
    __syncthreads();
    if (threadIdx.x == 0) {
        unsigned* bar = b.bar;
        __builtin_amdgcn_s_waitcnt(0);
        unsigned nloc = b.st[0], nx = b.st[1];
        if (nloc == 0u) { xcd_barrier_complete(bar, b.x, nloc, nx); b.st[0] = nloc; b.st[1] = nx; }
        const unsigned old = xb_add(&bar[XB_XSUB(b.x)], 1u);
        const unsigned gen = old / nloc;
        if (old + 1u == (gen + 1u) * nloc) {
            __builtin_amdgcn_fence(__ATOMIC_RELEASE, "agent");
            asm volatile("s_waitcnt vmcnt(0)" ::: "memory");
            const unsigned og = xb_add(&bar[XB_TOP], 1u);
            const unsigned tg = og / nx;
            if (og + 1u == (tg + 1u) * nx) xb_add(&bar[XB_TOPGEN], 1u);
            else XB_SPIN(xb_ld(&bar[XB_TOPGEN]) == tg, bar);
            __builtin_amdgcn_fence(__ATOMIC_ACQUIRE, "agent");
            xb_add(&bar[XB_XGEN(b.x)], 1u);
            asm volatile("s_waitcnt vmcnt(0)" ::: "memory");
        } else {
            XB_SPIN(xb_ld(&bar[XB_XGEN(b.x)]) == gen, bar);
            __builtin_amdgcn_fence(__ATOMIC_ACQUIRE, "agent");
            asm volatile("s_waitcnt vmcnt(0)" ::: "memory");
        }
    }
    __syncthreads();
}


constexpr int NPH = 2 + 9 * DEPTH;
#ifndef PHM
#define PHM 1023
#endif
#ifndef DUPM
#define DUPM 0
#endif
#ifndef XSYNC
#define XSYNC 0
#endif
__device__ __forceinline__ XcdBarrier make_bar(unsigned char* lds_raw) {
    CParams* kp = (CParams*)__builtin_amdgcn_kernarg_segment_ptr(); asm volatile("" : "+s"(kp));
    XcdBarrier b; b.bar = (unsigned*)kp->ws; b.x = xb_xcc_id(); b.st = (volatile LAS unsigned*)(lds_raw + (LDS_BYTES - 16)); return b;
}
__global__ void __launch_bounds__(NT, 2) mega(Params Pv) {
    extern __shared__ __attribute__((aligned(16))) unsigned char lds_raw[];
    { volatile LAS unsigned* xst = (volatile LAS unsigned*)(lds_raw + (LDS_BYTES - 16));
      if (threadIdx.x == 0) { xst[0] = 0u; xst[1] = 0u; }
      __syncthreads();
      (void)xcd_barrier_post((unsigned*)Pv.ws, xst); }
#pragma unroll 1
    for (int ph = 0; ph < NPH; ++ph) {
#if DUPM
        const int nrep = (ph >= 2 && ((DUPM >> ((ph - 2) % 9)) & 1)) ? 2 : ((ph < 2 && ((DUPM >> (10 + ph)) & 1)) ? 2 : 1);
        for (int rep = 0; rep < nrep; ++rep) {
#else
        {
#endif
        CParams* kp = (CParams*)__builtin_amdgcn_kernarg_segment_ptr(); asm volatile("" : "+s"(kp));
        CParams& P = *kp;
        float* ldsf = (float*)lds_raw;
        PG8_LAS unsigned char* ldsg = (PG8_LAS unsigned char*)lds_raw;
        const int G = gridDim.x, bid = blockIdx.x;
        if (ph == 0 && (PHM & 1)) { ph_mod(P, ldsf); ph_filt_hidden(P); __syncthreads(); ph_convert(P, 0, ldsf); }
        else if (ph == 1 && (PHM & 2)) { ph_rowpass(P, 0, 0); ph_filt_final(P, ldsf); }
        else {
            const int l = (ph - 2) / 9, s = (ph - 2) % 9;
            const float* mod = (const float*)(P.ws + WS_MOD);
            if (s == 0 && (PHM & 4)) {
                pg8::Gemm g{(const bf16_t*)(P.ws + WS_H), (const bf16_t*)(P.ws + WS_WIN), M, NPAD, D}; pg8::StaticOrder S; S.init(M, NPAD, G, bid);
                pg8::EpiProj E{(bf16_t*)(P.ws + WS_PROJ), (bf16_t*)(P.ws + WS_LACT)};
                pg8::gemm_phase<pg8::EpiProj, pg8::StaticOrder, true, true>(ldsg, g, S, E);
            } else if (s == 1 && (PHM & 8)) {
                pg8::Gemm g{(const bf16_t*)(P.ws + WS_LACT), (const bf16_t*)(P.ws + WS_WL), M, NL, KL}; pg8::StaticOrder S; S.init(M, NL, G, bid);
                pg8::EpiLora E{(float*)(P.ws + WS_RW) + 4 * AS, AS, P.in[10] + l * 2048, P.in[12] + l * 2048};
                pg8::gemm_phase<pg8::EpiLora, pg8::StaticOrder, true, true>(ldsg, g, S, E);
                __syncthreads();
                ph_convprep(P, l, ldsf);
            } else if (s == 2 && (PHM & 16)) { ph_scan_hyena(P, l, ldsf); }
            else if (s == 3 && (PHM & 32)) { ph_combine(P, l, ldsf); }
            else if ((s == 4 || s == 7) && (PHM & 64)) {
                pg8::Gemm g{(const bf16_t*)(P.ws + (s == 4 ? WS_MIX : WS_PROJ)), (const bf16_t*)(P.ws + (s == 4 ? WS_WOUT : WS_W2)), M, D, s == 4 ? D : DFF}; pg8::StaticOrder S; S.init(M, D, G, bid);
                pg8::EpiRes E{P.out, mod + (size_t)l * 5 * 12288 + (s == 4 ? 2 : 5) * 2048, ALPHA};
                pg8::gemm_phase<pg8::EpiRes, pg8::StaticOrder, true, true>(ldsg, g, S, E);
            } else if (s == 5 && (PHM & 128)) { ph_rowpass(P, 1, l); }
            else if (s == 6 && (PHM & 256)) {
                pg8::Gemm g{(const bf16_t*)(P.ws + WS_H), (const bf16_t*)(P.ws + WS_W1), M, DFF, D}; pg8::StaticOrder S; S.init(M, DFF, G, bid);
                pg8::EpiRelu2 E{(bf16_t*)(P.ws + WS_PROJ), DFF};
                pg8::gemm_phase<pg8::EpiRelu2, pg8::StaticOrder, true, true>(ldsg, g, S, E);
            } else if (PHM & 512) { ph_rowpass(P, 2, l); if (l + 1 < DEPTH) ph_convert(P, l + 1, ldsf); }
        }
#if DUPM
        if (ph + 1 < NPH || rep + 1 < nrep) { if (ph == 0 && rep == 0) cg::this_grid().sync(); else xcd_barrier(make_bar(lds_raw)); }
#else
        if (ph + 1 < NPH) { if (ph == 0) cg::this_grid().sync(); else xcd_barrier(make_bar(lds_raw)); }
#endif
        if (ph == 1) for (int xs = 0; xs < XSYNC; ++xs) xcd_barrier(make_bar(lds_raw));
        }
    }
}

#ifndef MK_MULTI
#define MK_MULTI 0
#endif
extern "C" void kernel_launch(void* const* d_in, const int* in_sizes, int n_in, void* d_out, int out_size, void* d_ws, size_t ws_size, hipStream_t stream) {
    static int grid = 0;
    if (grid == 0) {
        int dev = 0, cus = 0, per_cu = 0;
        if (n_in != 33 || ws_size < WS_END) { fprintf(stderr, "kernel_launch: unexpected n_in %d or ws_size %zu (< %zu)\n", n_in, ws_size, (size_t)WS_END); grid = -1; return; }
        hipGetDevice(&dev);
        hipDeviceGetAttribute(&cus, hipDeviceAttributeMultiprocessorCount, dev);
        if (hipFuncSetAttribute((const void*)mega, hipFuncAttributeMaxDynamicSharedMemorySize, LDS_BYTES) != hipSuccess) { fprintf(stderr, "hipFuncSetAttribute failed\n"); grid = -1; return; }
        if (hipOccupancyMaxActiveBlocksPerMultiprocessor(&per_cu, (const void*)mega, NT, LDS_BYTES) != hipSuccess || per_cu < 1) { fprintf(stderr, "occupancy query failed (%d)\n", per_cu); grid = -1; return; }
        grid = cus;
    }
    if (grid < 0) return;
    Params p{};
    for (int i = 0; i < 33; ++i) p.in[i] = (const float*)d_in[i];
    p.out = (float*)d_out; p.ws = (unsigned char*)d_ws;
    if (hipMemsetAsync(d_ws, 0, 16384, stream) != hipSuccess) { fprintf(stderr, "memset failed\n"); return; }
    p.ph_lo = 0; p.ph_hi = NPH;
    void* args[] = {&p};
    hipError_t e = hipLaunchCooperativeKernel((const void*)mega, dim3(grid), dim3(NT), args, LDS_BYTES, stream);
    if (e != hipSuccess) fprintf(stderr, "cooperative launch failed: %s (grid %d)\n", hipGetErrorString(e), grid);
}
```
